# Optimizing an MI355X kernel written in HIP

```python
import math
import jax, jax.numpy as jnp
from jax import lax
import numpy as np

D_MODEL = 2048
BATCH = 4
SEQ = 2048
DEPTH = 2

HEAD_DIM = 128
Q_BLOCK = 128
ROPE_THETA = 500000.0
ROT_FRACTION_DIV = 4
NORM_EPS = 1e-6
N_BRANCH = 4
BRANCH_WIDTH = 512

N_HEADS_A = 4
DIFF_DIM = HEAD_DIM // 2
N_HEADS_B = 4
Q_LORA = 512
KV_LORA = 512
NOPE_DIM = 128
ROPE_DIM_B = 64
V_DIM_B = 128
DIL_PAIRS = ((128, 1), (512, 4), (2048, 16))
N_DIL_GROUPS = 3
HEADS_PER_GROUP = 4
N_HEADS_C = N_DIL_GROUPS * HEADS_PER_GROUP
N_HEADS_D = 4
D_FF = 5632
N_EXPERTS = 8
TOP_K = 2
D_FF_EXPERT = 5632
N_DENSE = (DEPTH + 1) // 2
N_MOE = DEPTH // 2

A_COLS = 3 * N_HEADS_A * HEAD_DIM
B_COLS = Q_LORA + KV_LORA + ROPE_DIM_B
C_COLS = 3 * N_HEADS_C * HEAD_DIM
D_COLS = 3 * N_HEADS_D * HEAD_DIM
GATE_COLS = N_BRANCH * D_MODEL
IN_COLS = A_COLS + B_COLS + C_COLS + D_COLS + GATE_COLS

kernel_name = 'hybrid_gated_mixer_block'


def rms_norm(x, gain):
    xf = x.astype(jnp.float32)
    y = xf * lax.rsqrt(jnp.mean(xf * xf, axis=-1, keepdims=True) + NORM_EPS)
    return (y * gain.astype(jnp.float32)).astype(x.dtype)


def rope_partial(x, rot_dim):
    seq = x.shape[1]
    pos = jnp.arange(seq, dtype=jnp.float32)
    inv_freq = ROPE_THETA ** (-jnp.arange(0, rot_dim, 2, dtype=jnp.float32) / rot_dim)
    ang = pos[:, None] * inv_freq[None, :]
    cos = jnp.cos(ang)[:, None, :]
    sin = jnp.sin(ang)[:, None, :]
    half = rot_dim // 2
    xf = x.astype(jnp.float32)
    x1 = xf[..., :half]
    x2 = xf[..., half:rot_dim]
    out = jnp.concatenate([x1 * cos - x2 * sin, x1 * sin + x2 * cos, xf[..., rot_dim:]], axis=-1)
    return out.astype(x.dtype)


def to_blocks(t):
    b, s = t.shape[:2]
    return jnp.moveaxis(t.reshape((b, s // Q_BLOCK, Q_BLOCK) + t.shape[2:]), 1, 0)


def from_blocks(t):
    nb, b, qb = t.shape[:3]
    return jnp.moveaxis(t, 0, 1).reshape((b, nb * qb) + t.shape[3:])


def block_starts(seq):
    return jnp.arange(seq // Q_BLOCK, dtype=jnp.int32) * Q_BLOCK


def causal_probs(qb, k, start, scale):
    s = jnp.einsum('bqhd,bkhd->bhqk', qb, k).astype(jnp.float32) * scale
    qpos = start + jnp.arange(Q_BLOCK, dtype=jnp.int32)
    kpos = jnp.arange(k.shape[1], dtype=jnp.int32)
    s = jnp.where(kpos[None, :] <= qpos[:, None], s, -jnp.inf)
    return jax.nn.softmax(s, axis=-1)


def diff_attention(qa, ka, va, lam_q1, lam_k1, lam_q2, lam_k2, gain, lam_init):
    b, s = qa.shape[:2]
    rot = DIFF_DIM // ROT_FRACTION_DIV
    q1 = rope_partial(qa[..., :DIFF_DIM], rot)
    q2 = rope_partial(qa[..., DIFF_DIM:], rot)
    k1 = rope_partial(ka[..., :DIFF_DIM], rot)
    k2 = rope_partial(ka[..., DIFF_DIM:], rot)
    lam = (jnp.exp(jnp.sum(lam_q1.astype(jnp.float32) * lam_k1.astype(jnp.float32)))
           - jnp.exp(jnp.sum(lam_q2.astype(jnp.float32) * lam_k2.astype(jnp.float32)))
           + lam_init)
    scale = 1.0 / math.sqrt(DIFF_DIM)

    def blk(args):
        q1b, q2b, start = args
        p = causal_probs(q1b, k1, start, scale) - lam * causal_probs(q2b, k2, start, scale)
        return jnp.einsum('bhqk,bkhd->bqhd', p.astype(va.dtype), va)

    out = from_blocks(lax.map(blk, (to_blocks(q1), to_blocks(q2), block_starts(s))))
    out = rms_norm(out, gain) * (1.0 - lam_init)
    return out.reshape(b, s, N_HEADS_A * HEAD_DIM)


def mla_attention(c_q, c_kv, k_rope_in, dq_norm, dkv_norm, w_uq, w_ukv):
    b, s = c_q.shape[:2]
    q = (rms_norm(c_q, dq_norm) @ w_uq).reshape(b, s, N_HEADS_B, NOPE_DIM + ROPE_DIM_B)
    kv = (rms_norm(c_kv, dkv_norm) @ w_ukv).reshape(b, s, N_HEADS_B, NOPE_DIM + V_DIM_B)
    q = jnp.concatenate([q[..., :NOPE_DIM], rope_partial(q[..., NOPE_DIM:], ROPE_DIM_B)], axis=-1)
    k_rope = rope_partial(k_rope_in[:, :, None, :], ROPE_DIM_B)
    k = jnp.concatenate([kv[..., :NOPE_DIM],
                         jnp.broadcast_to(k_rope, (b, s, N_HEADS_B, ROPE_DIM_B))], axis=-1)
    v = kv[..., NOPE_DIM:]
    scale = 1.0 / math.sqrt(NOPE_DIM + ROPE_DIM_B)

    def blk(args):
        qb, start = args
        p = causal_probs(qb, k, start, scale)
        return jnp.einsum('bhqk,bkhd->bqhd', p.astype(v.dtype), v)

    out = from_blocks(lax.map(blk, (to_blocks(q), block_starts(s))))
    return out.reshape(b, s, N_HEADS_B * V_DIM_B)


def dilated_attention(qc, kc, vc):
    b, s = qc.shape[:2]
    rot = HEAD_DIM // ROT_FRACTION_DIV
    grp = (b, s, N_DIL_GROUPS, HEADS_PER_GROUP, HEAD_DIM)
    q = rope_partial(qc, rot).reshape(grp)
    k = rope_partial(kc, rot).reshape(grp)
    v = vc.reshape(grp)
    k_groups = [k[:, :, g] for g in range(N_DIL_GROUPS)]
    v_groups = [v[:, :, g] for g in range(N_DIL_GROUPS)]
    scale = 1.0 / math.sqrt(HEAD_DIM)

    def blk(args):
        qb, start = args
        qpos = start + jnp.arange(Q_BLOCK, dtype=jnp.int32)
        outs, lses = [], []
        for g, (window, dilation) in enumerate(DIL_PAIRS):
            n_keys = window // dilation + 1
            kidx = qpos[:, None] - dilation * jnp.arange(n_keys, dtype=jnp.int32)[None, :]
            valid = kidx >= 0
            kidx = jnp.maximum(kidx, 0)
            kg = k_groups[g][:, kidx]
            vg = v_groups[g][:, kidx]
            sc = jnp.einsum('bqhd,bqjhd->bhqj', qb[:, :, g], kg).astype(jnp.float32) * scale
            sc = jnp.where(valid[None, None], sc, -jnp.inf)
            m = jnp.max(sc, axis=-1, keepdims=True)
            e = jnp.exp(sc - m)
            den = jnp.sum(e, axis=-1, keepdims=True)
            outs.append(jnp.einsum('bhqj,bqjhd->bqhd', (e / den).astype(vg.dtype), vg))
            lses.append((m + jnp.log(den))[..., 0])
        w = jax.nn.softmax(jnp.stack(lses, axis=0), axis=0)
        w = jnp.transpose(w, (0, 1, 3, 2))[..., None]
        return jnp.sum(w.astype(qb.dtype) * jnp.stack(outs, axis=0), axis=0)

    out = from_blocks(lax.map(blk, (to_blocks(q), block_starts(s))))
    return out.reshape(b, s, HEADS_PER_GROUP * HEAD_DIM)


def stick_breaking_attention(qd, kd, vd):
    b, s = qd.shape[:2]
    scale = 1.0 / math.sqrt(HEAD_DIM)
    kpos = jnp.arange(s, dtype=jnp.int32)

    def blk(args):
        qb, start = args
        z = jnp.einsum('bqhd,bkhd->bhqk', qb, kd).astype(jnp.float32) * scale
        qpos = start + jnp.arange(Q_BLOCK, dtype=jnp.int32)
        strict = kpos[None, :] < qpos[:, None]
        log_not = jnp.where(strict, jax.nn.log_sigmoid(-z), 0.0)
        csum = jnp.cumsum(log_not, axis=-1)
        later = csum[..., -1:] - csum
        a = jnp.where(strict, jnp.exp(jax.nn.log_sigmoid(z) + later), 0.0)
        return jnp.einsum('bhqk,bkhd->bqhd', a.astype(vd.dtype), vd)

    out = from_blocks(lax.map(blk, (to_blocks(qd), block_starts(s))))
    return out.reshape(b, s, N_HEADS_D * HEAD_DIM)


def swiglu(h, w_in, w_out):
    gu = h @ w_in
    g, u = jnp.split(gu, 2, axis=-1)
    return (jax.nn.silu(g) * u) @ w_out


def moe_swiglu(h, w_router, w_moe_in, w_moe_out):
    b, s, d = h.shape
    hf = h.reshape(b * s, d)
    logits = (hf @ w_router).astype(jnp.float32)
    top_vals, top_idx = lax.top_k(logits, TOP_K)
    gates = jax.nn.softmax(top_vals, axis=-1)
    combine = jnp.sum(jax.nn.one_hot(top_idx, N_EXPERTS, dtype=jnp.float32) * gates[..., None], axis=1)
    combine = combine.astype(h.dtype)
    y = jnp.zeros_like(hf)
    for e in range(N_EXPERTS):
        y = y + combine[:, e:e + 1] * swiglu(hf, w_moe_in[e], w_moe_out[e])
    return y.reshape(b, s, d)


def setup_inputs(seed: int = 0) -> dict:
    key = jax.random.key(seed)
    ks = jax.random.split(key, 24)

    def nrm(k, shape, scale):
        return jax.random.normal(k, shape, jnp.float32) * scale

    def gain(k, shape):
        return 1.0 + 0.01 * jax.random.normal(k, shape, jnp.float32)

    return {
        'x': nrm(ks[0], (BATCH, SEQ, D_MODEL), 1.0),
        'norm_mix': gain(ks[1], (DEPTH, D_MODEL)),
        'w_in': nrm(ks[2], (DEPTH, D_MODEL, IN_COLS), D_MODEL ** -0.5),
        'dq_norm': gain(ks[3], (DEPTH, Q_LORA)),
        'dkv_norm': gain(ks[4], (DEPTH, KV_LORA)),
        'w_uq': nrm(ks[5], (DEPTH, Q_LORA, N_HEADS_B * (NOPE_DIM + ROPE_DIM_B)), Q_LORA ** -0.5),
        'w_ukv': nrm(ks[6], (DEPTH, KV_LORA, N_HEADS_B * (NOPE_DIM + V_DIM_B)), KV_LORA ** -0.5),
        'lam_q1': nrm(ks[7], (DEPTH, DIFF_DIM), 0.1),
        'lam_k1': nrm(ks[8], (DEPTH, DIFF_DIM), 0.1),
        'lam_q2': nrm(ks[9], (DEPTH, DIFF_DIM), 0.1),
        'lam_k2': nrm(ks[10], (DEPTH, DIFF_DIM), 0.1),
        'diff_norm': gain(ks[11], (DEPTH, HEAD_DIM)),
        'w_branch': nrm(ks[12], (DEPTH, N_BRANCH, BRANCH_WIDTH, D_MODEL), BRANCH_WIDTH ** -0.5),
        'w_out': nrm(ks[13], (DEPTH, D_MODEL, D_MODEL), D_MODEL ** -0.5),
        'norm_ffn': gain(ks[14], (DEPTH, D_MODEL)),
        'w_dense_in': nrm(ks[15], (N_DENSE, D_MODEL, 2 * D_FF), D_MODEL ** -0.5),
        'w_dense_out': nrm(ks[16], (N_DENSE, D_FF, D_MODEL), D_FF ** -0.5),
        'w_router': nrm(ks[17], (N_MOE, D_MODEL, N_EXPERTS), D_MODEL ** -0.5),
        'w_moe_in': nrm(ks[18], (N_MOE, N_EXPERTS, D_MODEL, 2 * D_FF_EXPERT), D_MODEL ** -0.5),
        'w_moe_out': nrm(ks[19], (N_MOE, N_EXPERTS, D_FF_EXPERT, D_MODEL), D_FF_EXPERT ** -0.5),
        'norm_final': gain(ks[20], (D_MODEL,)),
    }


def reference(x, norm_mix, w_in, dq_norm, dkv_norm, w_uq, w_ukv, lam_q1, lam_k1, lam_q2, lam_k2,
              diff_norm, w_branch, w_out, norm_ffn, w_dense_in, w_dense_out, w_router,
              w_moe_in, w_moe_out, norm_final):
    b, s, _ = x.shape
    split_points = [A_COLS, A_COLS + B_COLS, A_COLS + B_COLS + C_COLS,
                    A_COLS + B_COLS + C_COLS + D_COLS]
    for layer in range(DEPTH):
        h = rms_norm(x, norm_mix[layer])
        proj = h @ w_in[layer]
        pa, pb, pc, pd, pg = jnp.split(proj, split_points, axis=-1)

        qa, ka, va = [t.reshape(b, s, N_HEADS_A, HEAD_DIM) for t in jnp.split(pa, 3, axis=-1)]
        lam_init = 0.8 - 0.6 * math.exp(-0.3 * layer)
        y_a = diff_attention(qa, ka, va, lam_q1[layer], lam_k1[layer], lam_q2[layer],
                             lam_k2[layer], diff_norm[layer], lam_init)

        c_q, c_kv, k_rope = jnp.split(pb, [Q_LORA, Q_LORA + KV_LORA], axis=-1)
        y_b = mla_attention(c_q, c_kv, k_rope, dq_norm[layer], dkv_norm[layer],
                            w_uq[layer], w_ukv[layer])

        qc, kc, vc = [t.reshape(b, s, N_HEADS_C, HEAD_DIM) for t in jnp.split(pc, 3, axis=-1)]
        y_c = dilated_attention(qc, kc, vc)

        qd, kd, vd = [t.reshape(b, s, N_HEADS_D, HEAD_DIM) for t in jnp.split(pd, 3, axis=-1)]
        y_d = stick_breaking_attention(qd, kd, vd)

        gates = jax.nn.sigmoid(pg.astype(jnp.float32)).astype(x.dtype).reshape(b, s, N_BRANCH, D_MODEL)
        merged = jnp.zeros_like(x)
        for i, y_i in enumerate((y_a, y_b, y_c, y_d)):
            merged = merged + gates[:, :, i] * (y_i @ w_branch[layer, i])
        x = x + merged @ w_out[layer]

        h = rms_norm(x, norm_ffn[layer])
        if layer % 2 == 0:
            x = x + swiglu(h, w_dense_in[layer // 2], w_dense_out[layer // 2])
        else:
            x = x + moe_swiglu(h, w_router[layer // 2], w_moe_in[layer // 2], w_moe_out[layer // 2])
    return rms_norm(x, norm_final)
```

```cpp
#include <hip/hip_runtime.h>
#include <cstdio>
#include <cstdint>

typedef unsigned short bf16;
typedef short bf16x8 __attribute__((ext_vector_type(8)));
typedef float f32x16 __attribute__((ext_vector_type(16)));
typedef float f32x4 __attribute__((ext_vector_type(4)));
typedef float f32x8v __attribute__((ext_vector_type(8)));
typedef float f32x2v __attribute__((ext_vector_type(2)));
typedef unsigned u32x4 __attribute__((ext_vector_type(4)));

constexpr int BATCH = 4, SEQ = 2048, T = BATCH * SEQ, DM = 2048, DEPTH = 2;
constexpr int IN_COLS = 16960;
constexpr int OFF_QA = 0, OFF_KA = 512, OFF_VA = 1024, OFF_CQ = 1536, OFF_CKV = 2048, OFF_KR = 2560;
constexpr int OFF_QC = 2624, OFF_KC = 4160, OFF_VC = 5696, OFF_QD = 7232, OFF_KD = 7744, OFF_VD = 8256, OFF_G = 8768;
constexpr int DFF = 5632, NEXP = 8, ECAP = 8192;
constexpr float EPS = 1e-6f;
constexpr int VTP = T + 64;
constexpr float ROPE_THETA = 500000.0f;

constexpr size_t MiB = 1u << 20;
constexpr size_t WS_CTL = 0;
constexpr size_t CTL_BYTES = 1 * MiB;
constexpr size_t CTL_CNT = 4096;
constexpr size_t CTL_RSQ = 512 * 1024;
constexpr size_t WS_ROPE = 1 * MiB;
constexpr size_t ROPE_A = WS_ROPE, ROPE_C = ROPE_A + 2048 * 8 * 8, ROPE_M = ROPE_C + 2048 * 16 * 8;
constexpr size_t WS_XA = 2 * MiB;
constexpr size_t WS_H = WS_XA + 64 * MiB;
constexpr size_t WS_QA = WS_H + 32 * MiB;
constexpr size_t WS_KA = WS_QA + 8 * MiB;
constexpr size_t WS_QB = WS_KA + 8 * MiB;
constexpr size_t WS_KB = WS_QB + 12 * MiB;
constexpr size_t WS_QC = WS_KB + 12 * MiB;
constexpr size_t WS_KC = WS_QC + 24 * MiB;
constexpr size_t WS_QD = WS_KC + 24 * MiB;
constexpr size_t WS_KD = WS_QD + 8 * MiB;
constexpr size_t WS_VT = WS_KD + 8 * MiB;
constexpr size_t WS_VTB = WS_VT + 41 * MiB;
constexpr size_t WS_CQ = WS_VTB + 9 * MiB;
constexpr size_t WS_CKV = WS_CQ + 8 * MiB;
constexpr size_t WS_G = WS_CKV + 8 * MiB;
constexpr size_t WS_Y = WS_G + 128 * MiB;
constexpr size_t WS_MG = WS_Y + 32 * MiB;
constexpr size_t WS_MGB = WS_MG + 64 * MiB;
constexpr size_t WS_ACT = WS_MGB + 32 * MiB;
constexpr size_t WS_ROUTE = WS_ACT + 88 * MiB;
constexpr size_t WS_HS = WS_ROUTE + 1 * MiB;
constexpr size_t WS_ACTS = WS_HS + 256 * MiB;
constexpr size_t WS_OUTS = WS_ACTS + 704 * MiB;
constexpr size_t WS_WT = WS_OUTS + 256 * MiB;
constexpr size_t WS_RSQP = WS_WT + 768 * MiB;
constexpr size_t WS_END = WS_RSQP + 2 * MiB;
constexpr size_t WS_PROJ = WS_ACTS;
constexpr size_t WS_VN = WS_HS;
constexpr size_t WS_QBRAW = WS_HS + 64 * MiB;
constexpr size_t WS_KVRAW = WS_HS + 96 * MiB;
constexpr int VN_LD = 3584;

__device__ __forceinline__ float bf2f(bf16 v) { return __uint_as_float((unsigned)v << 16); }
__device__ __forceinline__ bf16 f2bf(float f) { unsigned u = __float_as_uint(f); return (bf16)((u + 0x7fffu + ((u >> 16) & 1u)) >> 16); }
__device__ __forceinline__ unsigned pk2(float lo, float hi) { return (unsigned)f2bf(lo) | ((unsigned)f2bf(hi) << 16); }
__device__ __forceinline__ float wave_sum(float v) {
#pragma unroll
    for (int o = 1; o < 64; o <<= 1) v += __shfl_xor(v, o);
    return v;
}
__device__ __forceinline__ float wave_max(float v) {
#pragma unroll
    for (int o = 1; o < 64; o <<= 1) v = fmaxf(v, __shfl_xor(v, o));
    return v;
}
__device__ __forceinline__ int crow(int r, int hi) { return (r & 3) + 8 * (r >> 2) + 4 * hi; }

__global__ void k_rope_tab(float2* tabA, float2* tabC, float2* tabM) {
    int idx = blockIdx.x * blockDim.x + threadIdx.x;
    if (idx >= 2048 * 56) return;
    int pos = idx / 56, r = idx % 56;
    int half, i; float2* dst;
    if (r < 8) { half = 8; i = r; dst = tabA + pos * 8 + i; }
    else if (r < 24) { half = 16; i = r - 8; dst = tabC + pos * 16 + i; }
    else { half = 32; i = r - 24; dst = tabM + pos * 32 + i; }
    float e = -(float)(2 * i) / (float)(2 * half);
    float inv = exp2f(e * log2f(ROPE_THETA));
    float ang = (float)pos * inv;
    double rev = (double)ang * 0.15915494309189535;
    rev -= floor(rev);
    float rf = (float)rev;
    *dst = make_float2(__builtin_amdgcn_cosf(rf), __builtin_amdgcn_sinf(rf));
}

template <bool OUT_F32>
__global__ __launch_bounds__(256) void k_rmsnorm(const float* __restrict__ x, const float* __restrict__ gain, void* out) {
    int row = blockIdx.x * 4 + (threadIdx.x >> 6), lane = threadIdx.x & 63;
    const f32x4* xr = (const f32x4*)(x + (size_t)row * DM);
    f32x4 v[8]; float s = 0.f;
#pragma unroll
    for (int j = 0; j < 8; ++j) { v[j] = xr[lane + 64 * j]; s += v[j].x * v[j].x + v[j].y * v[j].y + v[j].z * v[j].z + v[j].w * v[j].w; }
    float r = rsqrtf(wave_sum(s) * (1.f / DM) + EPS);
#pragma unroll
    for (int j = 0; j < 8; ++j) {
        f32x4 g = ((const f32x4*)gain)[lane + 64 * j];
        f32x4 y = {v[j].x * r * g.x, v[j].y * r * g.y, v[j].z * r * g.z, v[j].w * r * g.w};
        if (OUT_F32) ((f32x4*)((float*)out + (size_t)row * DM))[lane + 64 * j] = y;
        else { uint2 o = {pk2(y.x, y.y), pk2(y.z, y.w)}; ((uint2*)((bf16*)out + (size_t)row * DM))[lane + 64 * j] = o; }
    }
}

template <class Epi, bool DUAL>
__global__ __launch_bounds__(256) void k_gemm(const bf16* __restrict__ A, int lda, size_t strideA, const float* __restrict__ W, int ldw, size_t strideW,
                                              int N, int K, int dualOff, const int* mcount, Epi epi) {
    const int z = blockIdx.z;
    A += (size_t)z * strideA; W += (size_t)z * strideW;
    if (mcount && (int)blockIdx.y * 128 >= mcount[z]) return;
    const int wave = threadIdx.x >> 6, lane = threadIdx.x & 63, wr = wave >> 1, wc = wave & 1;
    const int m0 = blockIdx.y * 128 + wr * 64, n0 = blockIdx.x * 128 + wc * 64;
    const int r = lane & 31, h = lane >> 5;
    f32x16 acc[2][2], acc2[2][2];
#pragma unroll
    for (int i = 0; i < 2; ++i)
#pragma unroll
        for (int j = 0; j < 2; ++j)
#pragma unroll
            for (int e = 0; e < 16; ++e) { acc[i][j][e] = 0.f; acc2[i][j][e] = 0.f; }
    int ncol[2]; ncol[0] = min(n0 + r, N - 1); ncol[1] = min(n0 + 32 + r, N - 1);
    for (int k0 = 0; k0 < K; k0 += 16) {
        bf16x8 a[2], b[2], b2[2];
#pragma unroll
        for (int i = 0; i < 2; ++i) a[i] = *(const bf16x8*)(A + (size_t)(m0 + 32 * i + r) * lda + k0 + 8 * h);
#pragma unroll
        for (int j = 0; j < 2; ++j) {
            const float* wp = W + (size_t)(k0 + 8 * h) * ldw + ncol[j];
#pragma unroll
            for (int e = 0; e < 8; ++e) { b[j][e] = (short)f2bf(wp[(size_t)e * ldw]); if (DUAL) b2[j][e] = (short)f2bf(wp[(size_t)e * ldw + dualOff]); }
        }
#pragma unroll
        for (int i = 0; i < 2; ++i)
#pragma unroll
            for (int j = 0; j < 2; ++j) {
                acc[i][j] = __builtin_amdgcn_mfma_f32_32x32x16_bf16(a[i], b[j], acc[i][j], 0, 0, 0);
                if (DUAL) acc2[i][j] = __builtin_amdgcn_mfma_f32_32x32x16_bf16(a[i], b2[j], acc2[i][j], 0, 0, 0);
            }
    }
#pragma unroll
    for (int i = 0; i < 2; ++i)
#pragma unroll
        for (int j = 0; j < 2; ++j)
#pragma unroll
            for (int e = 0; e < 16; ++e) {
                int row = m0 + 32 * i + crow(e, h), col = n0 + 32 * j + r;
                if (col < N) epi(z, row, col, acc[i][j][e], acc2[i][j][e]);
            }
}

struct EpiStoreF32 { float* O; int ldo; int pad; __device__ void operator()(int, int row, int col, float v, float) const { O[(size_t)row * ldo + col] = v; } };
struct EpiBranch { const bf16* G; float* MG; bf16* MGB; int i; int pad;
    __device__ void operator()(int, int row, int col, float v, float) const {
        float m = bf2f(G[(size_t)row * 8192 + i * 2048 + col]) * v; size_t o = (size_t)row * DM + col;
        if (i > 0) m += MG[o];
        MG[o] = m; if (i == 3) MGB[o] = f2bf(m); } };
struct EpiResid { const float* Xin; float* Xout; __device__ void operator()(int, int row, int col, float v, float) const { size_t o = (size_t)row * DM + col; Xout[o] = Xin[o] + v; } };
struct EpiSwiglu { bf16* ACT; size_t strideZ; __device__ void operator()(int z, int row, int col, float g, float u) const {
        float s = g / (1.f + __expf(-g)); ACT[(size_t)z * strideZ + (size_t)row * DFF + col] = f2bf(s * u); } };
struct EpiStoreBf16Z { bf16* O; size_t strideZ; int ldo; int pad; __device__ void operator()(int z, int row, int col, float v, float) const { O[(size_t)z * strideZ + (size_t)row * ldo + col] = f2bf(v); } };

__device__ __forceinline__ float rope_val(const float* hb, int j, int half, const float2* tab, int pos) {
    if (j >= 2 * half) return hb[j];
    int i = j % half; float2 cs = tab[pos * half + i];
    float x1 = hb[i], x2 = hb[i + half];
    return j < half ? x1 * cs.x - x2 * cs.y : x1 * cs.y + x2 * cs.x;
}
__global__ __launch_bounds__(256) void k_prep(const float* __restrict__ P, unsigned char* ws) {
    const float2* tabA = (const float2*)(ws + ROPE_A); const float2* tabC = (const float2*)(ws + ROPE_C); const float2* tabM = (const float2*)(ws + ROPE_M);
    bf16* QA = (bf16*)(ws + WS_QA); bf16* KA = (bf16*)(ws + WS_KA); bf16* KB = (bf16*)(ws + WS_KB);
    bf16* QC = (bf16*)(ws + WS_QC); bf16* KC = (bf16*)(ws + WS_KC); bf16* QD = (bf16*)(ws + WS_QD); bf16* KD = (bf16*)(ws + WS_KD);
    bf16* VT = (bf16*)(ws + WS_VT); bf16* VN = (bf16*)(ws + WS_VN); bf16* G = (bf16*)(ws + WS_G);
    const int t = blockIdx.x, pos = t % SEQ;
    const float* p = P + (size_t)t * IN_COLS;
    for (int c = threadIdx.x; c < IN_COLS; c += 256) {
        if (c < OFF_VA) {
            int cc = c % 512, j = cc % 64; const float* hb = p + (c - j);
            float v = rope_val(hb, j, 8, tabA, pos);
            (c < OFF_KA ? QA : KA)[(size_t)t * 512 + cc] = f2bf(v);
        } else if (c < OFF_CQ) { int cc = c - OFF_VA; bf16 v = f2bf(p[c]); VT[(size_t)cc * VTP + t] = v; VN[(size_t)t * VN_LD + cc] = v; }
        else if (c < OFF_KR) {   }
        else if (c < OFF_QC) { int j = c - OFF_KR; float v = rope_val(p + OFF_KR, j, 32, tabM, pos); bf16 b = f2bf(v);
            for (int h = 0; h < 4; ++h) KB[(size_t)t * 768 + h * 192 + 128 + j] = b; }
        else if (c < OFF_VC) { int cc = (c - OFF_QC) % 1536, j = cc % 128; const float* hb = p + (c - j);
            float v = rope_val(hb, j, 16, tabC, pos);
            (c < OFF_KC ? QC : KC)[(size_t)t * 1536 + cc] = f2bf(v); }
        else if (c < OFF_QD) { int cc = c - OFF_VC; bf16 v = f2bf(p[c]); VT[(size_t)(512 + cc) * VTP + t] = v; VN[(size_t)t * VN_LD + 1024 + cc] = v; }
        else if (c < OFF_VD) { int cc = (c - OFF_QD) % 512; (c < OFF_KD ? QD : KD)[(size_t)t * 512 + cc] = f2bf(p[c]); }
        else if (c < OFF_G) { int cc = c - OFF_VD; bf16 v = f2bf(p[c]); VT[(size_t)(2048 + cc) * VTP + t] = v; VN[(size_t)t * VN_LD + 2560 + cc] = v; }
        else { int cc = c - OFF_G; G[(size_t)t * 8192 + cc] = f2bf(1.f / (1.f + __expf(-p[c]))); }
    }
}
__global__ __launch_bounds__(256) void k_mla_norm(const float* __restrict__ P, const float* __restrict__ gq, const float* __restrict__ gkv, bf16* CQ, bf16* CKV) {
    int task = blockIdx.x * 4 + (threadIdx.x >> 6), lane = threadIdx.x & 63;
    int t = task >> 1, which = task & 1;
    const float* p = P + (size_t)t * IN_COLS + (which ? OFF_CKV : OFF_CQ);
    const float* g = which ? gkv : gq; bf16* o = (which ? CKV : CQ) + (size_t)t * 512;
    float v[8], s = 0.f;
#pragma unroll
    for (int j = 0; j < 8; ++j) { v[j] = p[lane + 64 * j]; s += v[j] * v[j]; }
    float r = rsqrtf(wave_sum(s) * (1.f / 512) + EPS);
#pragma unroll
    for (int j = 0; j < 8; ++j) o[lane + 64 * j] = f2bf(v[j] * r * g[lane + 64 * j]);
}
__global__ __launch_bounds__(256) void k_mla_prep(unsigned char* ws) {
    const float* QR = (const float*)(ws + WS_QBRAW); const float* KV = (const float*)(ws + WS_KVRAW);
    const float2* tabM = (const float2*)(ws + ROPE_M);
    bf16* QB = (bf16*)(ws + WS_QB); bf16* KB = (bf16*)(ws + WS_KB); bf16* VTB = (bf16*)(ws + WS_VTB); bf16* VN = (bf16*)(ws + WS_VN);
    const int t = blockIdx.x, pos = t % SEQ;
    for (int c = threadIdx.x; c < 768 + 1024; c += 256) {
        if (c < 768) { int h = c / 192, j = c % 192; const float* hb = QR + (size_t)t * 768 + h * 192;
            float v = j < 128 ? hb[j] : rope_val(hb + 128, j - 128, 32, tabM, pos);
            QB[(size_t)t * 768 + c] = f2bf(v); }
        else { int cc = c - 768, h = cc / 256, j = cc % 256; float v = KV[(size_t)t * 1024 + cc];
            if (j < 128) KB[(size_t)t * 768 + h * 192 + j] = f2bf(v);
            else { bf16 b = f2bf(v); VTB[(size_t)(h * 128 + j - 128) * VTP + t] = b; VN[(size_t)t * VN_LD + 512 + h * 128 + j - 128] = b; } }
    }
}

__device__ __forceinline__ float dot_row(const float* qf, const bf16* kp, int dqk) {
    float s = 0.f;
    for (int d = 0; d < dqk; d += 8) { u32x4 w = *(const u32x4*)(kp + d);
#pragma unroll
        for (int e = 0; e < 4; ++e) { s += qf[d + 2 * e] * __uint_as_float(w[e] << 16) + qf[d + 2 * e + 1] * __uint_as_float(w[e] & 0xffff0000u); } }
    return s;
}
__device__ __forceinline__ float2 softmax_row(const bf16* qp, int dqk, const bf16* kbase, int kld, float scale, int nk, const bf16* vbase, float* sc, float* qf, int lane) {
    __syncthreads();
    for (int j = lane; j < dqk; j += 64) qf[j] = bf2f(qp[j]);
    __syncthreads();
    float m = -1e30f;
    for (int k = lane; k < nk; k += 64) { float s = dot_row(qf, kbase + (size_t)k * kld, dqk) * scale; sc[k] = s; m = fmaxf(m, s); }
    m = wave_max(m); float l = 0.f;
    __syncthreads();
    for (int k = lane; k < nk; k += 64) { float p = __expf(sc[k] - m); sc[k] = p; l += p; }
    __syncthreads();
    l = wave_sum(l); float inv = 1.f / l;
    float o0 = 0.f, o1 = 0.f;
    for (int k = 0; k < nk; ++k) { float p = sc[k]; unsigned w = *(const unsigned*)(vbase + (size_t)k * VN_LD + 2 * lane);
        o0 += p * __uint_as_float(w << 16); o1 += p * __uint_as_float(w & 0xffff0000u); }
    return make_float2(o0 * inv, o1 * inv);
}
template <int TYPE>
__global__ __launch_bounds__(256) void k_attn_simple(unsigned char* ws, const float* lq1, const float* lk1, const float* lq2, const float* lk2, const float* dgain, float lam_init) {
    __shared__ float s_sc[4][2048]; __shared__ float s_q[4][192];
    const int wave = threadIdx.x >> 6, lane = threadIdx.x & 63;
    float* sc = s_sc[wave]; float* qf = s_q[wave];
    const int task = blockIdx.x * 4 + wave, t = task >> 2, h = task & 3, b = t / SEQ, pos = t % SEQ;
    const bf16* VN = (const bf16*)(ws + WS_VN) + (size_t)b * SEQ * VN_LD;
    bf16* Y = (bf16*)(ws + WS_Y);
    if (TYPE == 0) {
        float lam = __expf(wave_sum(lq1[lane] * lk1[lane])) - __expf(wave_sum(lq2[lane] * lk2[lane])) + lam_init;
        const bf16* QA = (const bf16*)(ws + WS_QA) + (size_t)t * 512 + h * 128; const bf16* KA = (const bf16*)(ws + WS_KA) + (size_t)b * SEQ * 512 + h * 128;
        float2 o1 = softmax_row(QA, 64, KA, 512, 0.125f, pos + 1, VN + h * 128, sc, qf, lane);
        float2 o2 = softmax_row(QA + 64, 64, KA + 64, 512, 0.125f, pos + 1, VN + h * 128, sc, qf, lane);
        float a0 = o1.x - lam * o2.x, a1 = o1.y - lam * o2.y;
        float r = rsqrtf(wave_sum(a0 * a0 + a1 * a1) * (1.f / 128) + EPS) * (1.f - lam_init);
        *(unsigned*)(Y + (size_t)t * 512 + h * 128 + 2 * lane) = pk2(a0 * r * dgain[2 * lane], a1 * r * dgain[2 * lane + 1]);
    } else if (TYPE == 1) {
        const bf16* QB = (const bf16*)(ws + WS_QB) + (size_t)t * 768 + h * 192; const bf16* KB = (const bf16*)(ws + WS_KB) + (size_t)b * SEQ * 768 + h * 192;
        float2 o = softmax_row(QB, 192, KB, 768, 0.07216878364870323f, pos + 1, VN + 512 + h * 128, sc, qf, lane);
        *(unsigned*)(Y + (size_t)(T + t) * 512 + h * 128 + 2 * lane) = pk2(o.x, o.y);
    } else if (TYPE == 2) {
        const bf16* QC = (const bf16*)(ws + WS_QC) + (size_t)t * 1536; const bf16* KC = (const bf16*)(ws + WS_KC) + (size_t)b * SEQ * 1536;
        float m = -1e30f;
        for (int g = 0; g < 3; ++g) {
            for (int j = lane; j < 128; j += 64) qf[j] = bf2f(QC[(g * 4 + h) * 128 + j]);
            for (int j = lane; j < 129; j += 64) { int kidx = pos - (1 << (2 * g)) * j; float s = -__builtin_inff();
                if (kidx >= 0) { s = dot_row(qf, KC + (size_t)kidx * 1536 + (g * 4 + h) * 128, 128) * 0.08838834764831845f; }
                sc[g * 129 + j] = s; m = fmaxf(m, s); }
        }
        m = wave_max(m); float l = 0.f;
        for (int e = lane; e < 387; e += 64) { float p = __expf(sc[e] - m); sc[e] = p; l += p; }
        l = wave_sum(l); float inv = 1.f / l; float o0 = 0.f, o1 = 0.f;
        for (int g = 0; g < 3; ++g) for (int j = 0; j < 129; ++j) { int kidx = pos - (1 << (2 * g)) * j; if (kidx < 0) break; float p = sc[g * 129 + j];
            unsigned w = *(const unsigned*)(VN + (size_t)kidx * VN_LD + 1024 + (g * 4 + h) * 128 + 2 * lane);
            o0 += p * __uint_as_float(w << 16); o1 += p * __uint_as_float(w & 0xffff0000u); }
        *(unsigned*)(Y + (size_t)(2 * T + t) * 512 + h * 128 + 2 * lane) = pk2(o0 * inv, o1 * inv);
    } else {
        const bf16* QD = (const bf16*)(ws + WS_QD) + (size_t)t * 512 + h * 128; const bf16* KD = (const bf16*)(ws + WS_KD) + (size_t)b * SEQ * 512 + h * 128;
        for (int j = lane; j < 128; j += 64) qf[j] = bf2f(QD[j]);
        for (int k = lane; k < pos; k += 64) sc[k] = dot_row(qf, KD + (size_t)k * 512, 128) * 0.08838834764831845f;
        float carry = 0.f;
        for (int c0 = 0; c0 < pos; c0 += 64) { int k = pos - 1 - (c0 + lane); float z = k >= 0 ? sc[k] : 0.f;
            float sp = log1pf(__expf(-fabsf(z)));
            float lsig = fminf(z, 0.f) - sp, lnot = k >= 0 ? (fminf(-z, 0.f) - sp) : 0.f;
            float pre = lnot;
#pragma unroll
            for (int o = 1; o < 64; o <<= 1) { float u = __shfl_up(pre, o); if (lane >= o) pre += u; }
            float later = carry + pre - lnot;
            if (k >= 0) sc[k] = __expf(lsig + later);
            carry += __shfl(pre, 63); }
        float o0 = 0.f, o1 = 0.f;
        for (int k = 0; k < pos; ++k) { float p = sc[k]; unsigned w = *(const unsigned*)(VN + (size_t)k * VN_LD + 2560 + h * 128 + 2 * lane);
            o0 += p * __uint_as_float(w << 16); o1 += p * __uint_as_float(w & 0xffff0000u); }
        *(unsigned*)(Y + (size_t)(3 * T + t) * 512 + h * 128 + 2 * lane) = pk2(o0, o1);
    }
}

__global__ __launch_bounds__(256) void k_router(const float* __restrict__ X, const float* __restrict__ gain, const float* __restrict__ Wr, int* cnt, int* route, bf16* HS) {
    int t = blockIdx.x * 4 + (threadIdx.x >> 6), lane = threadIdx.x & 63;
    const float* xr = X + (size_t)t * DM;
    float v[32], s = 0.f;
#pragma unroll
    for (int j = 0; j < 32; ++j) { v[j] = xr[lane + 64 * j]; s += v[j] * v[j]; }
    float r = rsqrtf(wave_sum(s) * (1.f / DM) + EPS);
    float lg[8];
#pragma unroll
    for (int e = 0; e < 8; ++e) lg[e] = 0.f;
#pragma unroll
    for (int j = 0; j < 32; ++j) { v[j] = v[j] * r * gain[lane + 64 * j]; const float* w = Wr + (size_t)(lane + 64 * j) * 8;
#pragma unroll
        for (int e = 0; e < 8; ++e) lg[e] += v[j] * w[e]; }
#pragma unroll
    for (int e = 0; e < 8; ++e) lg[e] = wave_sum(lg[e]);
    int e1 = 0; float b1 = lg[0];
#pragma unroll
    for (int e = 1; e < 8; ++e) if (lg[e] > b1) { b1 = lg[e]; e1 = e; }
    int e2 = -1; float b2 = -__builtin_inff();
#pragma unroll
    for (int e = 0; e < 8; ++e) if (e != e1 && lg[e] > b2) { b2 = lg[e]; e2 = e; }
    float g2 = __expf(b2 - b1); float g1 = 1.f / (1.f + g2); g2 = g2 * g1;
    int s1 = 0, s2 = 0;
    if (lane == 0) { s1 = atomicAdd(cnt + e1, 1); s2 = atomicAdd(cnt + e2, 1);
        int* ro = route + (size_t)t * 8; ro[0] = e1; ro[1] = s1; ro[2] = __float_as_int(g1); ro[3] = e2; ro[4] = s2; ro[5] = __float_as_int(g2); }
    s1 = __shfl(s1, 0); s2 = __shfl(s2, 0);
    bf16* o1 = HS + ((size_t)e1 * ECAP + s1) * DM; bf16* o2 = HS + ((size_t)e2 * ECAP + s2) * DM;
#pragma unroll
    for (int j = 0; j < 32; ++j) { bf16 b = f2bf(v[j]); o1[lane + 64 * j] = b; o2[lane + 64 * j] = b; }
}
__global__ __launch_bounds__(256) void k_moe_combine(float* X, const int* route, const bf16* OUTS) {
    int t = blockIdx.x; const int* ro = route + (size_t)t * 8;
    int e1 = ro[0], s1 = ro[1], e2 = ro[3], s2 = ro[4]; float g1 = __int_as_float(ro[2]), g2 = __int_as_float(ro[5]);
    const bf16* a = OUTS + ((size_t)e1 * ECAP + s1) * DM; const bf16* b = OUTS + ((size_t)e2 * ECAP + s2) * DM;
    for (int c = threadIdx.x; c < DM; c += 256) X[(size_t)t * DM + c] += g1 * bf2f(a[c]) + g2 * bf2f(b[c]);
}


namespace pg8 {
#define PG8_LAS __attribute__((address_space(3)))
typedef unsigned short bf16_t;
typedef short bf16x8 __attribute__((ext_vector_type(8)));
typedef float f32x4 __attribute__((ext_vector_type(4)));
typedef unsigned u32x4 __attribute__((ext_vector_type(4)));
constexpr int BM = 256, BK = 64, HALF = 128, HTB = HALF * BK * 2  , STAGE_BYTES = 8 * HTB, NXCD = 8, WGM = 8;

__host__ __device__ __forceinline__ int lds_byte(int r, int c) { const int st = (r >> 4) * 2 + (c >> 5), rr = r & 15, cc = c & 31, ob = rr * 64 + cc * 2; return st * 1024 + (ob ^ (((ob >> 9) & 1) << 5)); }
__host__ __device__ __forceinline__ void stage_rc(int b, int& R, int& C) { const int st = b / 1024, sb = b % 1024, swz = sb ^ (((sb >> 9) & 1) << 5); R = (st >> 1) * 16 + swz / 64; C = (st & 1) * 32 + (swz % 64) / 2; }
__host__ __device__ __forceinline__ int perm32(int rho) { const int n = rho >> 4, i = rho & 15; return 8 * (i >> 2) + 4 * n + (i & 3); }

struct Unit { int pm, pn, kind; const char* a; const char* b; };


typedef float f32x2_t __attribute__((ext_vector_type(2))); typedef __bf16 bf16x2_t __attribute__((ext_vector_type(2)));
__device__ __forceinline__ unsigned cvt_pk_bf16(float lo, float hi) { f32x2_t v = {lo, hi}; bf16x2_t b = __builtin_convertvector(v, bf16x2_t); return __builtin_bit_cast(unsigned, b); }
typedef int v8i_t __attribute__((ext_vector_type(8))); typedef int v4i_t __attribute__((ext_vector_type(4)));
template <bool F8> struct FragT;
template <> struct FragT<false> { bf16x8 k[2]; };
template <> struct FragT<true> { v8i_t v; };
template <bool F8> __device__ __forceinline__ void frag_load(FragT<F8>& f, const PG8_LAS unsigned char* p) {
    if constexpr (F8) { const v4i_t lo = *(const PG8_LAS v4i_t*)p, hi = *(const PG8_LAS v4i_t*)(p + 1024); f.v = __builtin_shufflevector(lo, hi, 0, 1, 2, 3, 4, 5, 6, 7); }
    else { f.k[0] = *(const PG8_LAS bf16x8*)p; f.k[1] = *(const PG8_LAS bf16x8*)(p + 1024); }
}
template <bool F8> __device__ __forceinline__ f32x4 frag_mma(const FragT<F8>& w, const FragT<F8>& a, f32x4 c) {
    if constexpr (F8) {
#if defined(__HIP_DEVICE_COMPILE__)
        asm volatile("v_mfma_f32_16x16x128_f8f6f4 %0, %1, %2, %0" : "+v"(c) : "v"(w.v), "v"(a.v));
#endif
        return c; }
    else { c = __builtin_amdgcn_mfma_f32_16x16x32_bf16(w.k[0], a.k[0], c, 0, 0, 0); return __builtin_amdgcn_mfma_f32_16x16x32_bf16(w.k[1], a.k[1], c, 0, 0, 0); }
}
template <class Epi, class Sched, bool ALIGN_EPI = false, bool SP2 = false, bool F8 = false, bool HALF_N = false>
__device__ __forceinline__ void gemm_phase(PG8_LAS unsigned char* lds, const int K, const Sched& S, const Epi& E) {
    int tid = threadIdx.x; asm volatile("" : "+v"(tid));
    const int wid = __builtin_amdgcn_readfirstlane(tid >> 6), lane = tid & 63, wr = wid >> 2, wc = wid & 3, fr = lane & 15, fq = lane >> 4;
    const int nt = K / BK;
    unsigned voffA[2], voffB[2];
#pragma unroll
    for (int i = 0; i < 2; ++i) { int R, C; stage_rc(tid * 16 + i * 8192, R, C); const int Rb = Epi::PERM ? ((R & ~31) + perm32(R & 31)) : R;
        voffA[i] = (unsigned)(R * K + C) * 2u; voffB[i] = (unsigned)(Rb * K + C) * 2u; }
    const size_t kstep = (size_t)(BK * 2);
    const size_t hstep = (size_t)HALF * K * 2;
    const unsigned ldsw = (unsigned)wid * 1024u;
    const int aoff = lds_byte(wr * 64 + fr, fq * 8), boff = lds_byte(wc * 32 + fr, fq * 8);
#define PG8_SA(b, h) (((b) * 2 + (h)) * HTB)
#define PG8_SB(b, h) ((4 + (b) * 2 + (h)) * HTB)
#define PG8_STAGE(bufoff, gbase, voff) do { _Pragma("unroll") for (int _i = 0; _i < 2; ++_i) \
        __builtin_amdgcn_global_load_lds((const unsigned*)((const char*)(gbase) + (voff)[_i]), (PG8_LAS unsigned*)(lds + (bufoff) + ldsw + _i * 8192), 16, 0, 0); } while (0)
#define PG8_LDA(dst, b, h) do { _Pragma("unroll") for (int m = 0; m < 4; ++m) frag_load<F8>(dst[m], lds + PG8_SA(b, h) + aoff + m * 2048); } while (0)
#define PG8_LDB(dst, b, h) do { _Pragma("unroll") for (int n = 0; n < 2; ++n) frag_load<F8>(dst[n], lds + PG8_SB(b, h) + boff + n * 2048); } while (0)
#define PG8_MMA(ai, bj, At, Bt) do { __builtin_amdgcn_s_setprio(1); _Pragma("unroll") for (int m = 0; m < 4; ++m) _Pragma("unroll") for (int n = 0; n < 2; ++n) \
        acc[ai][bj][m][n] = frag_mma<F8>(Bt[n], At[m], acc[ai][bj][m][n]); __builtin_amdgcn_s_setprio(0); } while (0)
#define PG8_WAIT_V(n) asm volatile("s_waitcnt vmcnt(" #n ")" ::: "memory")
#define PG8_WAIT_VX do { if constexpr (HALF_N) PG8_WAIT_V(6); else PG8_WAIT_V(8); } while (0)
#define PG8_WAIT_L(n) asm volatile("s_waitcnt lgkmcnt(" #n ")" ::: "memory")
#define PG8_BAR __builtin_amdgcn_s_barrier()
#define PG8_SCHED __builtin_amdgcn_sched_barrier(0)
    Unit cur, nxt; int ui = 0;
    if (!S.next(0, cur)) return;
    f32x4 acc[2][2][4][2];
#pragma unroll
    for (int a = 0; a < 2; ++a)
#pragma unroll
        for (int b = 0; b < 2; ++b)
#pragma unroll
            for (int m = 0; m < 4; ++m)
#pragma unroll
                for (int n = 0; n < 2; ++n) acc[a][b][m][n] = (f32x4){0.f, 0.f, 0.f, 0.f};
    FragT<F8> At[4], B0[2], B1[2];
    const char* cA = cur.a; const char* cB = cur.b;
    S.a_ready(cur);
    if constexpr (SP2) {
        static_assert(!HALF_N || SP2, "HALF_N: SP2 loop only");
        PG8_STAGE(PG8_SB(0, 0), cB, voffB); if constexpr (!HALF_N) PG8_STAGE(PG8_SB(0, 1), cB + hstep, voffB); PG8_STAGE(PG8_SA(0, 0), cA, voffA); PG8_STAGE(PG8_SA(0, 1), cA + hstep, voffA);
        if (wr == 1) PG8_BAR;
        PG8_WAIT_V(2); PG8_BAR;
        PG8_STAGE(PG8_SB(1, 0), cB + kstep, voffB); PG8_STAGE(PG8_SA(1, 0), cA + kstep, voffA); if constexpr (!HALF_N) PG8_STAGE(PG8_SB(1, 1), cB + hstep + kstep, voffB);
        if constexpr (HALF_N) PG8_WAIT_V(4); else PG8_WAIT_V(6); PG8_BAR;
    } else {
        PG8_STAGE(PG8_SB(0, 0), cB, voffB); PG8_STAGE(PG8_SA(0, 0), cA, voffA); PG8_STAGE(PG8_SB(0, 1), cB + hstep, voffB); PG8_STAGE(PG8_SA(0, 1), cA + hstep, voffA);
        if (wr == 1) PG8_BAR;
        PG8_WAIT_V(4); PG8_BAR;
        PG8_STAGE(PG8_SB(1, 0), cB + kstep, voffB); PG8_STAGE(PG8_SA(1, 0), cA + kstep, voffA); PG8_STAGE(PG8_SB(1, 1), cB + hstep + kstep, voffB);
        PG8_WAIT_V(6); PG8_BAR;
    }
    for (;;) {
        const bool has_next = S.next(ui + 1, nxt);
        const char* nA = has_next ? nxt.a : cA; const char* nB = has_next ? nxt.b : cB;
        for (int t = 0; t < nt; t += 2) {
            const bool last = (t == nt - 2);
            const char* a1 = cA + (size_t)(t + 1) * kstep;
            const char* a2 = last ? nA : cA + (size_t)(t + 2) * kstep; const char* b2 = last ? nB : cB + (size_t)(t + 2) * kstep;
            const char* a3 = a2 + kstep; const char* b3 = b2 + kstep;
            if (last && has_next) S.a_ready(nxt);
            if constexpr (SP2) {
            PG8_LDB(B0, 0, 0); if constexpr (!HALF_N) PG8_LDB(B1, 0, 1); PG8_SCHED; PG8_LDA(At, 0, 0); PG8_STAGE(PG8_SA(1, 1), a1 + hstep, voffA);
            PG8_WAIT_VX; PG8_WAIT_L(0); PG8_BAR; PG8_MMA(0, 0, At, B0); if constexpr (!HALF_N) PG8_MMA(0, 1, At, B1); PG8_BAR; PG8_SCHED;
            PG8_LDA(At, 0, 1); PG8_STAGE(PG8_SB(0, 0), b2, voffB); if constexpr (!HALF_N) PG8_STAGE(PG8_SB(0, 1), b2 + hstep, voffB); PG8_STAGE(PG8_SA(0, 0), a2, voffA);
            PG8_WAIT_VX; PG8_WAIT_L(0); PG8_BAR; PG8_MMA(1, 0, At, B0); if constexpr (!HALF_N) PG8_MMA(1, 1, At, B1); PG8_BAR; PG8_SCHED;
            PG8_LDB(B0, 1, 0); if constexpr (!HALF_N) PG8_LDB(B1, 1, 1); PG8_SCHED; PG8_LDA(At, 1, 0); PG8_STAGE(PG8_SA(0, 1), a2 + hstep, voffA);
            PG8_WAIT_VX; PG8_WAIT_L(0); PG8_BAR; PG8_MMA(0, 0, At, B0); if constexpr (!HALF_N) PG8_MMA(0, 1, At, B1); PG8_BAR; PG8_SCHED;
            PG8_LDA(At, 1, 1); PG8_STAGE(PG8_SB(1, 0), b3, voffB); if constexpr (!HALF_N) PG8_STAGE(PG8_SB(1, 1), b3 + hstep, voffB); PG8_STAGE(PG8_SA(1, 0), a3, voffA);
            PG8_WAIT_VX; PG8_WAIT_L(0); PG8_BAR; PG8_MMA(1, 0, At, B0); if constexpr (!HALF_N) PG8_MMA(1, 1, At, B1); PG8_BAR; PG8_SCHED;
            } else {
            PG8_LDB(B0, 0, 0); PG8_SCHED; PG8_LDA(At, 0, 0); PG8_STAGE(PG8_SA(1, 1), a1 + hstep, voffA);
            PG8_WAIT_L(8); PG8_BAR; PG8_WAIT_L(0); PG8_MMA(0, 0, At, B0); PG8_BAR; PG8_SCHED;
            PG8_LDB(B1, 0, 1); PG8_STAGE(PG8_SB(0, 0), b2, voffB);
            PG8_BAR; PG8_WAIT_L(0); PG8_MMA(0, 1, At, B1); PG8_BAR;
            PG8_LDA(At, 0, 1); PG8_STAGE(PG8_SA(0, 0), a2, voffA);
            PG8_BAR; PG8_WAIT_L(0); PG8_MMA(1, 0, At, B0); PG8_BAR; PG8_SCHED;
            PG8_STAGE(PG8_SB(0, 1), b2 + hstep, voffB);
            PG8_WAIT_V(6); PG8_BAR; PG8_MMA(1, 1, At, B1); PG8_BAR;
            PG8_LDB(B0, 1, 0); PG8_SCHED; PG8_LDA(At, 1, 0); PG8_STAGE(PG8_SA(0, 1), a2 + hstep, voffA);
            PG8_WAIT_L(8); PG8_BAR; PG8_WAIT_L(0); PG8_MMA(0, 0, At, B0); PG8_BAR; PG8_SCHED;
            PG8_LDB(B1, 1, 1); PG8_STAGE(PG8_SB(1, 0), b3, voffB);
            PG8_BAR; PG8_WAIT_L(0); PG8_MMA(0, 1, At, B1); PG8_BAR;
            PG8_LDA(At, 1, 1); PG8_STAGE(PG8_SA(1, 0), a3, voffA);
            PG8_BAR; PG8_WAIT_L(0); PG8_MMA(1, 0, At, B0); PG8_BAR; PG8_SCHED;
            PG8_STAGE(PG8_SB(1, 1), b3 + hstep, voffB);
            PG8_WAIT_V(6); PG8_BAR; PG8_MMA(1, 1, At, B1); PG8_BAR;
            }
        }
        if constexpr (F8) asm volatile("s_nop 7\n\ts_nop 7\n\ts_nop 7" ::: "memory");
        if constexpr (ALIGN_EPI) { if (wr == 0) PG8_BAR; }
        if constexpr (!Epi::AFTER_DRAIN) { E(acc, cur, wr, wc, fr, fq); S.done(cur); }
        if (!has_next) break;
#pragma unroll
        for (int a = 0; a < 2; ++a)
#pragma unroll
            for (int b = 0; b < (HALF_N ? 1 : 2); ++b)
#pragma unroll
                for (int m = 0; m < 4; ++m)
#pragma unroll
                    for (int n = 0; n < 2; ++n) acc[a][b][m][n] = (f32x4){0.f, 0.f, 0.f, 0.f};
        cur = nxt; cA = nA; cB = nB; ++ui;
        if constexpr (ALIGN_EPI) { if (wr == 1) PG8_BAR; }
    }
    PG8_WAIT_V(0);
    if constexpr (!ALIGN_EPI) { if (wr == 0) PG8_BAR; }
    PG8_BAR;
    if constexpr (Epi::AFTER_DRAIN) { E.fused(acc, cur, wr, wc, fr, fq, lds, wid, lane); S.done(cur); }
#undef PG8_SA
#undef PG8_SB
#undef PG8_STAGE
#undef PG8_LDA
#undef PG8_LDB
#undef PG8_MMA
#undef PG8_WAIT_V
#undef PG8_WAIT_VX
#undef PG8_WAIT_L
#undef PG8_BAR
#undef PG8_SCHED
}
}

#define LAS __attribute__((address_space(3)))
constexpr int NWAVES = 8, NTHR = 512;
constexpr int RING_BYTES = 131072, LDS_BYTES = 147456, MISC_OFF = RING_BYTES + 320;
constexpr int NT_IN = 57, NV_ROWS = 2560, NU_STD = 32 * NT_IN, NU_V = (NV_ROWS / 256) * 32;
constexpr size_t WT_IN  = 0;
constexpr size_t WT_INV = WT_IN  + (size_t)2 * NT_IN * 256 * DM * 2;
constexpr size_t WT_UQ  = WT_INV + (size_t)2 * NV_ROWS * DM * 2;
constexpr size_t WT_UKN = WT_UQ  + (size_t)2 * 768 * 512 * 2;
constexpr size_t WT_UKV = WT_UKN + (size_t)2 * 512 * 512 * 2;
constexpr size_t WT_BR  = WT_UKV + (size_t)2 * 512 * 512 * 2;
constexpr size_t WT_OUT = WT_BR  + (size_t)2 * 4 * DM * 512 * 2;
constexpr size_t WT_DI  = WT_OUT + (size_t)2 * DM * DM * 2;
constexpr size_t WT_DO  = WT_DI  + (size_t)2 * DFF * DM * 2;
constexpr size_t WT_MI  = WT_DO  + (size_t)DM * DFF * 2;
constexpr size_t WT_MO  = WT_MI  + (size_t)8 * 2 * DFF * DM * 2;
constexpr size_t WT_END = WT_MO  + (size_t)8 * DM * DFF * 2;
constexpr size_t WT_ING = WT_MI + (size_t)8 * 2 * DFF * DM;
static_assert(WT_ING + (size_t)2 * 8192 * DM <= WT_MO && WT_END <= 768 * MiB, "weight copies fit");
constexpr int NT_STD = 25, NU_A = 32 * NT_STD + NU_V;

struct FArgs { const float* in[21]; float* out; unsigned char* ws; int layer; int pad; };
__device__ __forceinline__ int bid_() { int b = blockIdx.x; asm volatile("" : "+s"(b)); return b; }
__device__ __forceinline__ int gdim_() { int g = gridDim.x; asm volatile("" : "+s"(g)); return g; }
__device__ __forceinline__ const float* in_ptr(const FArgs& a, int k) { asm volatile("" : "+s"(k)); return a.in[k]; }

struct MapIdent { int off; __device__ __forceinline__ int operator()(int n) const { return off + n; } };
__device__ __forceinline__ int rope_perm(int q, int half) { const int j = q >> 3, e = q & 7; return 4 * j + (e & 3) + (e >> 2) * half; }
struct MapInStd { __device__ __forceinline__ int operator()(int n) const {
    const int tile = n >> 8, p = n & 255;
    if (tile < 4) { const int c = (tile & 1) * 256 + p, q = c & 63, off = tile < 2 ? OFF_QA : OFF_KA; return off + (q < 16 ? (c - q) + rope_perm(q, 8) : c); }
    if (tile < 6) return OFF_CQ + (tile - 4) * 256 + p;
    if (tile < 8) return OFF_CKV + (tile - 6) * 256 + p;
    if (tile < 20) { const bool k = tile >= 14; const int c = (tile - (k ? 14 : 8)) * 256 + p, q = c & 127, off = k ? OFF_KC : OFF_QC; return off + (q < 32 ? (c - q) + rope_perm(q, 16) : c); }
    if (tile < 22) return OFF_QD + (tile - 20) * 256 + p;
    if (tile < 24) return OFF_KD + (tile - 22) * 256 + p;
    if (tile == 24) return p < 64 ? OFF_KR + rope_perm(p, 32) : -1;
    return OFF_G + (tile - 25) * 256 + p; } };
struct MapInV { __device__ __forceinline__ int operator()(int n) const { return n < 512 ? OFF_VA + n : (n < 2048 ? OFF_VC + (n - 512) : OFF_VD + (n - 2048)); } };
struct MapUq { __device__ __forceinline__ int operator()(int n) const { const int tile = n >> 8, p = n & 255;
    if (tile < 2) return (2 * tile + (p >> 7)) * 192 + (p & 127);
    return (p >> 6) * 192 + 128 + rope_perm(p & 63, 32); } };
struct MapUkv { int voff; __device__ __forceinline__ int operator()(int n) const { return (n >> 7) * 256 + voff + (n & 127); } };
struct MapFfnIn { __device__ __forceinline__ int operator()(int n) const { const int tile = n >> 8, p = n & 255; return p < 128 ? 128 * tile + p : DFF + 128 * tile + (p - 128); } };

struct CvtLd { f32x4 v[8]; int sc; int cb0; bool fast; };
template <class Map>
__device__ __forceinline__ void cvt_ld(CvtLd& L, const float* __restrict__ W, int ldw, int n0, int k0, const Map& map, int lane) {
    L.sc = map(n0 + (lane & 31));
    L.cb0 = __builtin_amdgcn_readfirstlane(L.sc) & ~31;
    L.fast = __all(L.sc >= 0 && (L.sc & ~31) == L.cb0);
    if (L.fast) { const int rg = lane >> 3, cq = lane & 7;
#pragma unroll
        for (int i = 0; i < 8; ++i) L.v[i] = __builtin_nontemporal_load((const f32x4*)(W + (size_t)(k0 + 8 * i + rg) * ldw + L.cb0 + 4 * cq)); }
}
__device__ __forceinline__ unsigned pk4_fp8(float a, float b, float c, float d) { int p = __builtin_amdgcn_cvt_pk_fp8_f32(a, b, 0, false); p = __builtin_amdgcn_cvt_pk_fp8_f32(c, d, p, true); return (unsigned)p; }
__device__ __forceinline__ int cvt_scr_fast(const CvtLd& L, int k0, const float* __restrict__ kscale, LAS float* scr, int lane) {
    const int rg = lane >> 3, cq = lane & 7;
#pragma unroll
    for (int i = 0; i < 8; ++i) { const int kk = 8 * i + rg; f32x4 x = L.v[i]; if (kscale) x = x * kscale[k0 + kk];
        LAS float* d = scr + kk * 33 + 4 * cq; d[0] = x[0]; d[1] = x[1]; d[2] = x[2]; d[3] = x[3]; }
    return L.sc - L.cb0;
}
template <bool F8>
__device__ __forceinline__ void cvt_out(int pcol, unsigned char* __restrict__ WT, int K, int n0, int k0, LAS float* scr, int lane) {
    asm volatile("s_waitcnt lgkmcnt(0)" ::: "memory");
    if (F8) {
        const int n = lane >> 1, hf = lane & 1; const int col = __shfl(pcol, n); const LAS float* s = scr + (32 * hf) * 33 + col;
        u32x4 o0, o1;
#pragma unroll
        for (int q = 0; q < 4; ++q) { o0[q] = pk4_fp8(s[(4 * q) * 33] * 64.f, s[(4 * q + 1) * 33] * 64.f, s[(4 * q + 2) * 33] * 64.f, s[(4 * q + 3) * 33] * 64.f);
            o1[q] = pk4_fp8(s[(16 + 4 * q) * 33] * 64.f, s[(17 + 4 * q) * 33] * 64.f, s[(18 + 4 * q) * 33] * 64.f, s[(19 + 4 * q) * 33] * 64.f); }
        unsigned char* dst = WT + (size_t)(n0 + n) * K + k0 + 32 * hf;
        *(u32x4*)dst = o0; *(u32x4*)(dst + 16) = o1;
    } else {
        const int c = lane & 7;
#pragma unroll
        for (int j = 0; j < 4; ++j) { const int n = (lane >> 3) + 8 * j; const int col = __shfl(pcol, n); const LAS float* s = scr + (8 * c) * 33 + col;
            u32x4 o; o.x = pk2(s[0 * 33], s[1 * 33]); o.y = pk2(s[2 * 33], s[3 * 33]); o.z = pk2(s[4 * 33], s[5 * 33]); o.w = pk2(s[6 * 33], s[7 * 33]);
            *(u32x4*)((bf16*)WT + (size_t)(n0 + n) * K + k0 + 8 * c) = o; }
    }
    asm volatile("s_waitcnt lgkmcnt(0)" ::: "memory");
}
template <bool F8>
__device__ __forceinline__ void cvt_st(const CvtLd& L, const float* __restrict__ W, int ldw, unsigned char* __restrict__ WT, int K, int n0, int k0, const float* __restrict__ kscale, LAS float* scr, int lane) {
    int pcol;
    if (L.fast) pcol = cvt_scr_fast(L, k0, kscale, scr, lane);
    else {
#pragma unroll 8
        for (int i = 0; i < 32; ++i) { const int kk = 2 * i + (lane >> 5); float v = L.sc >= 0 ? W[(size_t)(k0 + kk) * ldw + L.sc] : 0.f; if (kscale) v *= kscale[k0 + kk]; scr[kk * 33 + (lane & 31)] = v; }
        pcol = lane & 31;
    }
    cvt_out<F8>(pcol, WT, K, n0, k0, scr, lane);
}
struct CvtLdF { f32x4 v[8]; };
template <class Map>
__device__ __forceinline__ void cvt_ldF(CvtLdF& L, const float* __restrict__ W, int ldw, int n0, int k0, const Map& map, int lane) {
    const int sc = map(n0 + (lane & 31)), cb0 = __builtin_amdgcn_readfirstlane(sc) & ~31;
    const char* base = (const char*)(W + (size_t)k0 * ldw + cb0);
    const unsigned voff = (unsigned)((lane >> 3) * ldw + 4 * (lane & 7)) * 4u;
#pragma unroll
    for (int i = 0; i < 8; ++i) { const char* bi = base + (size_t)(8 * i) * ldw * 4; asm volatile("" : "+s"(bi)); L.v[i] = __builtin_nontemporal_load((const __attribute__((address_space(1))) f32x4*)(bi + voff)); }
}
#define GAS __attribute__((address_space(1)))
template <bool F8, class Map>
__device__ __forceinline__ void cvt_outF(const Map& map, unsigned char* __restrict__ WT, int K, int n0, int k0, LAS float* scr, int lane) {
    asm volatile("" ::: "memory");
    if (F8) {
        const int n = lane >> 1, hf = lane & 1, col = map(n0 + n) & 31; const LAS float* s = scr + (32 * hf) * 33 + col;
        float x[32];
#pragma unroll
        for (int k = 0; k < 32; ++k) x[k] = s[k * 33];
        asm volatile("" ::: "memory");
        u32x4 o0, o1;
#pragma unroll
        for (int q = 0; q < 4; ++q) { o0[q] = pk4_fp8(x[4 * q] * 64.f, x[4 * q + 1] * 64.f, x[4 * q + 2] * 64.f, x[4 * q + 3] * 64.f);
            o1[q] = pk4_fp8(x[16 + 4 * q] * 64.f, x[17 + 4 * q] * 64.f, x[18 + 4 * q] * 64.f, x[19 + 4 * q] * 64.f); }
        unsigned char* dst = WT + (size_t)(n0 + n) * K + k0 + 32 * hf;
        *(GAS u32x4*)dst = o0; *(GAS u32x4*)(dst + 16) = o1;
    } else {
        const int c = lane & 7; float x[4][8];
#pragma unroll
        for (int j = 0; j < 4; ++j) { const int n = (lane >> 3) + 8 * j, col = map(n0 + n) & 31; const LAS float* s = scr + (8 * c) * 33 + col;
#pragma unroll
            for (int i = 0; i < 8; ++i) x[j][i] = s[i * 33]; }
        asm volatile("" ::: "memory");
#pragma unroll
        for (int j = 0; j < 4; ++j) { const int n = (lane >> 3) + 8 * j;
            u32x4 o; o.x = pk2(x[j][0], x[j][1]); o.y = pk2(x[j][2], x[j][3]); o.z = pk2(x[j][4], x[j][5]); o.w = pk2(x[j][6], x[j][7]);
            *(GAS u32x4*)((bf16*)WT + (size_t)(n0 + n) * K + k0 + 8 * c) = o; }
    }
    asm volatile("" ::: "memory");
}
__device__ __forceinline__ void cvt_scr_fastF(const CvtLdF& L, LAS float* scr, int lane) {
    const int rg = lane >> 3, cq = lane & 7;
#pragma unroll
    for (int i = 0; i < 8; ++i) { const int kk = 8 * i + rg; const f32x4 x = L.v[i]; LAS float* d = scr + kk * 33 + 4 * cq; d[0] = x[0]; d[1] = x[1]; d[2] = x[2]; d[3] = x[3]; }
}
template <bool F8, class Map>
__device__ __forceinline__ void cvt_run(const float* W, size_t sstride, int ldw, unsigned char* WT, size_t dstride_bytes, int K, int Ndst, const Map& map, const float* kscale, int g0, int hi, int stride, LAS float* scr, int lane) {
    const int nblk = Ndst / 32, ipm = (K / 64) * nblk;
#define CVT_DESC(g, w_, t_, n0_, k0_) const int m_##g = (g) / ipm, r_##g = (g) - m_##g * ipm; const float* w_ = W + (size_t)m_##g * sstride; unsigned char* t_ = WT + (size_t)m_##g * dstride_bytes; const int n0_ = (r_##g % nblk) * 32, k0_ = (r_##g / nblk) * 64;
    CvtLd A, B;
    if (g0 < hi) { const int ga = g0; CVT_DESC(ga, w, t, n0, k0) (void)t; cvt_ld(A, w, ldw, n0, k0, map, lane); }
    if (g0 + stride < hi) { const int gb = g0 + stride; CVT_DESC(gb, w, t, n0, k0) (void)t; cvt_ld(B, w, ldw, n0, k0, map, lane); }
    for (int g = g0; g < hi; g += stride) {
        const CvtLd C = A; A = B;
        if (g + 2 * stride < hi) { const int gc = g + 2 * stride; CVT_DESC(gc, w, t, n0, k0) (void)t; cvt_ld(B, w, ldw, n0, k0, map, lane); }
        { const int gd = g; CVT_DESC(gd, w, t, n0, k0) cvt_st<F8>(C, w, ldw, t, K, n0, k0, kscale, scr, lane); }
    }
#undef CVT_DESC
}
template <bool F8, class Map>
__device__ __forceinline__ void cvt_run_pipe(const float* W, size_t sstride, int ldw, unsigned char* WT, size_t dstride_bytes, int K, int Ndst, const Map& map, int lo, int hi, int wave, LAS float* scr, int lane) {
    const int nblk = Ndst / 32, ipm = (K / 64) * nblk;
    const int n = (hi - lo) >> 3;
    if (n < 4) return;
#define ITEM_NK(r_) const int t_ = (((r_) >> 4) << 3) | ((r_) & 7), kp_ = t_ / nblk, n0_ = (t_ - kp_ * nblk) * 32, k0_ = (2 * kp_ + (((r_) >> 3) & 1)) * 64;
#define PLD(buf, gi) { const int g_ = __builtin_amdgcn_readfirstlane(gi); const int m_ = g_ / ipm, r_ = g_ - m_ * ipm; ITEM_NK(r_) cvt_ldF(buf, W + (size_t)m_ * sstride, ldw, n0_, k0_, map, lane); }
#define PST(buf, gi) { const int g_ = __builtin_amdgcn_readfirstlane(gi); const int m_ = g_ / ipm, r_ = g_ - m_ * ipm; ITEM_NK(r_) cvt_scr_fastF(buf, scr, lane); cvt_outF<F8>(map, WT + (size_t)m_ * dstride_bytes, K, n0_, k0_, scr, lane); }
    CvtLdF A, B, C, D;
#pragma unroll 1
    for (int g = lo + wave; g < hi; g += 32) {
        PLD(A, g) PLD(B, g + 8) PLD(C, g + 16) PLD(D, g + 24)
        PST(A, g) PST(B, g + 8) PST(C, g + 16) PST(D, g + 24)
    }
#undef PLD
#undef ITEM_NK
#undef PST
}
template <class Map>
__device__ __forceinline__ void cvt_job(const float* W, int ldw, bf16* WT, int K, int Ndst, const Map& map, const float* kscale, LAS float* scr, int lane, int gw, int NGW) {
    cvt_run<false>(W, 0, ldw, (unsigned char*)WT, 0, K, Ndst, map, kscale, gw, (K / 64) * (Ndst / 32), NGW, scr, lane);
}
template <class Map>
__device__ __forceinline__ void cvt_range(const float* W, size_t sstride, int ldw, bf16* WT, size_t dstride, int K, int Ndst, const Map& map, const float* kscale, int lo, int hi, LAS float* scr, int lane, int wave) {
    cvt_run<false>(W, sstride, ldw, (unsigned char*)WT, dstride * 2, K, Ndst, map, kscale, lo + wave, hi, NWAVES, scr, lane);
}
template <class Map>
__device__ __forceinline__ void cvt_range_f8(const float* W, size_t sstride, int ldw, unsigned char* WT, size_t dstride, int K, int Ndst, const Map& map, int lo, int hi, LAS float* scr, int lane, int wave) {
    cvt_run<true>(W, sstride, ldw, WT, dstride, K, Ndst, map, nullptr, lo + wave, hi, NWAVES, scr, lane);
}
template <class Map>
__device__ __forceinline__ void cvt_pipe(const float* W, size_t sstride, int ldw, bf16* WT, size_t dstride, int K, int Ndst, const Map& map, const float* kscale, int lo, int hi, LAS float* scr, int lane, int wave) {
    (void)kscale; cvt_run_pipe<false>(W, sstride, ldw, (unsigned char*)WT, dstride * 2, K, Ndst, map, lo, hi, wave, scr, lane);
}
template <class Map>
__device__ __forceinline__ void cvt_pipe_f8(const float* W, size_t sstride, int ldw, unsigned char* WT, size_t dstride, int K, int Ndst, const Map& map, int lo, int hi, LAS float* scr, int lane, int wave) {
    cvt_run_pipe<true>(W, sstride, ldw, WT, dstride, K, Ndst, map, lo, hi, wave, scr, lane);
}
__device__ __forceinline__ void phase_convert(const FArgs& a, LAS unsigned char* lds) {
    unsigned char* ws_ = a.ws;
    const int lane = threadIdx.x & 63, wave = threadIdx.x >> 6;
    LAS float* scr = (LAS float*)(lds + wave * 16384);
    const int gw = blockIdx.x * NWAVES + wave, NGW = gridDim.x * NWAVES;
    unsigned char* wt = ws_ + WS_WT;
    for (int idx = blockIdx.x * NTHR + threadIdx.x; idx < 2048 * 56; idx += gridDim.x * NTHR) {
        const int pos = idx / 56, r = idx % 56; int half, i; float2* dst;
        if (r < 8) { half = 8; i = r; dst = (float2*)(ws_ + ROPE_A) + pos * 8 + i; }
        else if (r < 24) { half = 16; i = r - 8; dst = (float2*)(ws_ + ROPE_C) + pos * 16 + i; }
        else { half = 32; i = r - 24; dst = (float2*)(ws_ + ROPE_M) + pos * 32 + i; }
        const float e = -(float)(2 * i) / (float)(2 * half), inv = exp2f(e * log2f(ROPE_THETA)), ang = (float)pos * inv;
        double rev = (double)ang * 0.15915494309189535; rev -= floor(rev); const float rf = (float)rev;
        *dst = make_float2(__builtin_amdgcn_cosf(rf), __builtin_amdgcn_sinf(rf));
    }
    {
        const float* w_in = a.in[2];
        cvt_job(w_in, IN_COLS, (bf16*)(wt + WT_IN), DM, NT_STD * 256, MapInStd{}, nullptr, scr, lane, gw, NGW);
        cvt_run<true>(w_in, 0, IN_COLS, wt + WT_ING, 0, DM, 8192, MapIdent{OFF_G}, nullptr, gw, (DM / 64) * (8192 / 32), NGW, scr, lane);
        cvt_job(w_in, IN_COLS, (bf16*)(wt + WT_INV), DM, NV_ROWS, MapInV{}, nullptr, scr, lane, gw, NGW);
        cvt_job(a.in[5], 768, (bf16*)(wt + WT_UQ), 512, 768, MapUq{}, a.in[3], scr, lane, gw, NGW);
        cvt_job(a.in[6], 1024, (bf16*)(wt + WT_UKN), 512, 512, MapUkv{0}, a.in[4], scr, lane, gw, NGW);
        cvt_job(a.in[6], 1024, (bf16*)(wt + WT_UKV), 512, 512, MapUkv{128}, a.in[4], scr, lane, gw, NGW);
#ifdef PROBE_CONV
        {
            const int wv = __builtin_amdgcn_readfirstlane(threadIdx.x >> 6);
            const int per = (3 * 11264 / 256) & ~31, lo = blockIdx.x * per, hi = lo + per;
            cvt_pipe_f8(a.in[18], (size_t)DM * 2 * DFF, 2 * DFF, wt + WT_MI, (size_t)2 * DFF * DM, DM, 2 * DFF, MapFfnIn{}, lo, hi, scr, lane, wv);
        }
#endif
#ifdef PROBE_PAT
        {
            const float* Wm = a.in[18]; f32x4 acc = {0.f, 0.f, 0.f, 0.f};
            typedef const __attribute__((address_space(1))) f32x4* gp4;
#if PROBE_PAT == 1
            const int nitem = 8 * 32 * 352;
            for (int g = gw; g < nitem; g += 4 * NGW) {
                f32x4 v[4][8];
#pragma unroll
                for (int j = 0; j < 4; ++j) { const int gi = g + j * NGW < nitem ? g + j * NGW : g; const int m = gi / (32 * 352), r = gi - m * (32 * 352), k0 = (r / 352) * 64, n0 = (r % 352) * 32;
                    const float* base = Wm + (size_t)m * 2048 * 11264 + (size_t)k0 * 11264 + n0;
#pragma unroll
                    for (int i = 0; i < 8; ++i) v[j][i] = __builtin_nontemporal_load((gp4)(base + (size_t)(8 * i + (lane >> 3)) * 11264 + 4 * (lane & 7))); }
#pragma unroll
                for (int j = 0; j < 4; ++j)
#pragma unroll
                    for (int i = 0; i < 8; ++i) acc += v[j][i];
            }
#else
            const int nblk = 8 * 32 * 44;
            for (int g = blockIdx.x; g < nblk; g += 4 * gridDim.x) {
                f32x4 v[4][8];
#pragma unroll
                for (int j = 0; j < 4; ++j) { const int gi = g + j * (int)gridDim.x < nblk ? g + j * (int)gridDim.x : g; const int m = gi / (32 * 44), r = gi - m * (32 * 44), k0 = (r / 44) * 64, n0 = (r % 44) * 256;
                    const float* base = Wm + (size_t)m * 2048 * 11264 + (size_t)(k0 + 8 * wave) * 11264 + n0;
#pragma unroll
                    for (int i = 0; i < 8; ++i) v[j][i] = __builtin_nontemporal_load((gp4)(base + (size_t)i * 11264 + 4 * lane)); }
#pragma unroll
                for (int j = 0; j < 4; ++j)
#pragma unroll
                    for (int i = 0; i < 8; ++i) acc += v[j][i];
            }
#endif
            if (acc[0] + acc[1] + acc[2] + acc[3] == 123456.789f) ((float*)(ws_ + WS_XA))[threadIdx.x] = acc[0];
        }
#endif
    }
}
constexpr int I_BR = 8 * 512, I_OUT = 2 * 2048, I_DI = 11264, I_DO = 5632, I_IN1 = 32 * (NT_STD * 256 / 32), I_ING1 = 32 * 256, I_INV1 = 2560, I_UQ1 = 192, I_UK1 = 128, I_MI = 11264, I_MO = 5632;
constexpr int C0_BR = 0, C0_OUT = C0_BR + I_BR, C0_DI = C0_OUT + I_OUT, C0_DO = C0_DI + I_DI, C0_IN1 = C0_DO + I_DO, C0_ING1 = C0_IN1 + I_IN1, C0_INV1 = C0_ING1 + I_ING1, C0_UQ1 = C0_INV1 + I_INV1, C0_UKN1 = C0_UQ1 + I_UQ1, C0_UKV1 = C0_UKN1 + I_UK1,
              C0_MI = C0_UKV1 + I_UK1, C0_MO = C0_MI + 3 * I_MI, CONV_N0 = C0_MO + 3 * I_MO;
constexpr int C1_MI = 0, C1_MO = C1_MI + 5 * I_MI, CONV_N1 = C1_MO + 5 * I_MO;
#define CONV_SEG(P0, P1) const int lo = (clo > (P0) ? clo : (P0)) - (P0), hi = (chi < (P1) ? chi : (P1)) - (P0); if (lo < hi)
__device__ __forceinline__ void conv_chunk(const FArgs& a, LAS unsigned char* lds, int set, int clo, int chi) {
    unsigned char* ws_ = a.ws; asm volatile("" : "+s"(ws_));
    int tid = threadIdx.x; asm volatile("" : "+v"(tid));
    const int lane = tid & 63, wave = __builtin_amdgcn_readfirstlane(tid >> 6);
    LAS float* scr = (LAS float*)(lds + wave * 16384);
    unsigned char* wt = ws_ + WS_WT;
    if (set == 0) {
        { CONV_SEG(C0_BR, C0_OUT) cvt_pipe(in_ptr(a, 12), (size_t)512 * DM, DM, (bf16*)(wt + WT_BR), (size_t)DM * 512, 512, DM, MapIdent{0}, nullptr, lo, hi, scr, lane, wave); }
        { CONV_SEG(C0_OUT, C0_DI) cvt_pipe(in_ptr(a, 13), (size_t)DM * DM, DM, (bf16*)(wt + WT_OUT), (size_t)DM * DM, DM, DM, MapIdent{0}, nullptr, lo, hi, scr, lane, wave); }
        { CONV_SEG(C0_DI, C0_DO) cvt_pipe(in_ptr(a, 15), 0, 2 * DFF, (bf16*)(wt + WT_DI), 0, DM, 2 * DFF, MapFfnIn{}, nullptr, lo, hi, scr, lane, wave); }
        { CONV_SEG(C0_DO, C0_IN1) cvt_pipe(in_ptr(a, 16), 0, DM, (bf16*)(wt + WT_DO), 0, DFF, DM, MapIdent{0}, nullptr, lo, hi, scr, lane, wave); }
        { CONV_SEG(C0_IN1, C0_ING1) cvt_range(in_ptr(a, 2) + (size_t)DM * IN_COLS, 0, IN_COLS, (bf16*)(wt + WT_IN) + (size_t)NT_IN * 256 * DM, 0, DM, NT_STD * 256, MapInStd{}, nullptr, lo, hi, scr, lane, wave); }
        { CONV_SEG(C0_ING1, C0_INV1) cvt_pipe_f8(in_ptr(a, 2) + (size_t)DM * IN_COLS, 0, IN_COLS, wt + WT_ING + (size_t)8192 * DM, 0, DM, 8192, MapIdent{OFF_G}, lo, hi, scr, lane, wave); }
        { CONV_SEG(C0_INV1, C0_UQ1) cvt_pipe(in_ptr(a, 2) + (size_t)DM * IN_COLS, 0, IN_COLS, (bf16*)(wt + WT_INV) + (size_t)NV_ROWS * DM, 0, DM, NV_ROWS, MapInV{}, nullptr, lo, hi, scr, lane, wave); }
        { CONV_SEG(C0_UQ1, C0_UKN1) cvt_range(in_ptr(a, 5) + (size_t)512 * 768, 0, 768, (bf16*)(wt + WT_UQ) + (size_t)768 * 512, 0, 512, 768, MapUq{}, in_ptr(a, 3) + 512, lo, hi, scr, lane, wave); }
        { CONV_SEG(C0_UKN1, C0_UKV1) cvt_range(in_ptr(a, 6) + (size_t)512 * 1024, 0, 1024, (bf16*)(wt + WT_UKN) + (size_t)512 * 512, 0, 512, 512, MapUkv{0}, in_ptr(a, 4) + 512, lo, hi, scr, lane, wave); }
        { CONV_SEG(C0_UKV1, C0_MI) cvt_range(in_ptr(a, 6) + (size_t)512 * 1024, 0, 1024, (bf16*)(wt + WT_UKV) + (size_t)512 * 512, 0, 512, 512, MapUkv{128}, in_ptr(a, 4) + 512, lo, hi, scr, lane, wave); }
        { CONV_SEG(C0_MI, C0_MO) cvt_pipe_f8(in_ptr(a, 18), (size_t)DM * 2 * DFF, 2 * DFF, wt + WT_MI, (size_t)2 * DFF * DM, DM, 2 * DFF, MapFfnIn{}, lo, hi, scr, lane, wave); }
        { CONV_SEG(C0_MO, CONV_N0) cvt_pipe_f8(in_ptr(a, 19), (size_t)DFF * DM, DM, wt + WT_MO, (size_t)DM * DFF, DFF, DM, MapIdent{0}, lo, hi, scr, lane, wave); }
    } else {
        { CONV_SEG(C1_MI, C1_MO) cvt_pipe_f8(in_ptr(a, 18) + (size_t)3 * DM * 2 * DFF, (size_t)DM * 2 * DFF, 2 * DFF, wt + WT_MI + (size_t)3 * 2 * DFF * DM, (size_t)2 * DFF * DM, DM, 2 * DFF, MapFfnIn{}, lo, hi, scr, lane, wave); }
        { CONV_SEG(C1_MO, CONV_N1) cvt_pipe_f8(in_ptr(a, 19) + (size_t)3 * DFF * DM, (size_t)DFF * DM, DM, wt + WT_MO + (size_t)3 * DM * DFF, (size_t)DM * DFF, DFF, DM, MapIdent{0}, lo, hi, scr, lane, wave); }
    }
}

__device__ __forceinline__ void tile_of(int L, int nM, int nN, int& pm, int& pn) {
    const int nwg = nM * nN; int wgid = L; { const int q = nwg / 8, r = nwg % 8, xcd = wgid % 8, off = wgid / 8; wgid = (xcd < r ? xcd * (q + 1) : r * (q + 1) + (xcd - r) * q) + off; }
    const int nig = 8 * nN, gid = wgid / nig, fm = gid * 8, gsz = (nM - fm) < 8 ? (nM - fm) : 8;
    pm = fm + ((wgid % nig) % gsz); pn = (wgid % nig) / gsz;
}
struct SchedBase { __device__ __forceinline__ void a_ready(const pg8::Unit&) const {} __device__ __forceinline__ void done(const pg8::Unit&) const {} };
struct GenSched : SchedBase { const char* A; const char* Bt; size_t tstep; int nM, nN, G, c;
    __device__ __forceinline__ bool next(int i, pg8::Unit& u) const { const int L = i * G + c; if (L >= nM * nN) return false; tile_of(L, nM, nN, u.pm, u.pn); u.kind = 0; u.a = A + (size_t)u.pm * tstep; u.b = Bt + (size_t)u.pn * tstep; return true; } };
struct InSched : SchedBase { const char* H; const char* W; const char* WV; int G, c;
    __device__ __forceinline__ bool next(int i, pg8::Unit& u) const { const int L = i * G + c; if (L >= NU_A) return false;
        if (L < 32 * NT_STD) { tile_of(L, 32, NT_STD, u.pm, u.pn); u.kind = 0; u.a = H + (size_t)u.pm * (256 * DM * 2); u.b = W + (size_t)u.pn * (256 * DM * 2); }
        else { tile_of(L - 32 * NT_STD, NV_ROWS / 256, 32, u.pm, u.pn); u.kind = 1; u.a = WV + (size_t)u.pm * (256 * DM * 2); u.b = H + (size_t)u.pn * (256 * DM * 2); } return true; } };
struct GateSched : SchedBase { const char* H8; const char* W8; int G, c;
    __device__ __forceinline__ bool next(int i, pg8::Unit& u) const {
        const int x = c & 7, j = c >> 3, n = j < 12 ? 3 : (j < 24 ? 5 : 4), st = j < 12 ? 3 * j : (j < 24 ? 36 + 5 * (j - 12) : 96 + 4 * (j - 24));
        if (i >= n || c >= 256) return false; const int e = st + i; u.pm = 4 * x + (e & 3); u.pn = e >> 2; u.kind = 0;
        u.a = H8 + (size_t)u.pm * (256 * DM); u.b = W8 + (size_t)u.pn * (256 * DM); return true; } };
struct MlaSched : SchedBase { const char* CQ; const char* CKV; const char* WQ; const char* WKN; const char* WKV; int G, c;
    __device__ __forceinline__ bool next(int i, pg8::Unit& u) const { int L = i * G + c; if (L >= 224) return false;
        constexpr size_t TS = 256 * 512 * 2;
        if (L < 96) { u.kind = 0; u.pm = L & 31; u.pn = L >> 5; u.a = CQ + u.pm * TS; u.b = WQ + u.pn * TS; }
        else if (L < 160) { L -= 96; u.kind = 1; u.pm = L & 31; u.pn = L >> 5; u.a = CKV + u.pm * TS; u.b = WKN + u.pn * TS; }
        else { L -= 160; u.kind = 2; u.pm = L >> 5; u.pn = L & 31; u.a = WKV + u.pm * TS; u.b = CKV + u.pn * TS; } return true; } };
struct BranchSched : SchedBase { const char* Y; const char* W; int G, c;
    __device__ __forceinline__ bool next(int i, pg8::Unit& u) const { const int tl = (i >> 2) * G + c; if (tl >= 256) return false; const int br = i & 3; int pm, pn; tile_of(tl, 32, 8, pm, pn); u.pm = br * 32 + pm; u.pn = br * 8 + pn; u.kind = br; u.a = Y + (size_t)u.pm * (256 * 512 * 2); u.b = W + (size_t)u.pn * (256 * 512 * 2); return true; } };
struct BranchSchedH : SchedBase { const char* Y; const char* W; int c;
    __device__ __forceinline__ bool next(int i, pg8::Unit& u) const { if (i >= 8 || c >= 256) return false; const int hf = i >> 2, br = i & 3; int pm, pn; tile_of(c, 32, 8, pm, pn);
        u.pm = pm; u.pn = pn; u.kind = br | (hf << 2); u.a = Y + (size_t)(br * 32 + pm) * (256 * 512 * 2); u.b = W + (size_t)(br * 2048 + pn * 256 + hf * 128) * (512 * 2); return true; } };
struct MoeSched : SchedBase { const char* A; const char* Bt; size_t tstep; int NT, G, c; int imax = 1 << 20; int pre[9];
    __device__ __forceinline__ void init(const int* cnt) { pre[0] = 0;
#pragma unroll
        for (int e = 0; e < 8; ++e) pre[e + 1] = pre[e] + ((__builtin_amdgcn_readfirstlane(cnt[e]) + 255) >> 8); }
    __device__ __forceinline__ bool next(int i, pg8::Unit& u) const { const int total = pre[8] * NT, q = (total + 7) >> 3, off = i * (G >> 3) + (c >> 3), L = (c & 7) * q + off; if (i >= imax || off >= q || L >= total) return false;
        int e = 0, base = 0, pe = pre[1];
#pragma unroll
        for (int k = 1; k < 8; ++k) { const int b = pre[k] * NT; if (L >= b) { e = k; base = b; pe = pre[k + 1] - pre[k]; } }
        const int idx = L - base; u.pm = e * 32 + idx % pe; u.pn = e * NT + idx / pe; u.kind = 0; u.a = A + (size_t)u.pm * tstep; u.b = Bt + (size_t)u.pn * tstep; return true; } };

struct MoeSchedTail : SchedBase { const char* A; const char* Bt; size_t tstep; int NT, G, c, fr; int pre[9];
    __device__ __forceinline__ bool next(int i, pg8::Unit& u) const { const int total = pre[8] * NT, q = (total + 7) >> 3, r = q - fr * (G >> 3), h = i * (G >> 3) + (c >> 3), off = fr * (G >> 3) + (h >> 1), L = (c & 7) * q + off;
        if (h >= 2 * r || L >= total) return false;
        int e = 0, base = 0, pe = pre[1];
#pragma unroll
        for (int k = 1; k < 8; ++k) { const int b = pre[k] * NT; if (L >= b) { e = k; base = b; pe = pre[k + 1] - pre[k]; } }
        const int idx = L - base; u.pm = e * 32 + idx % pe; u.pn = e * NT + idx / pe; u.kind = h & 1; u.a = A + (size_t)u.pm * tstep; u.b = Bt + (size_t)u.pn * tstep + (size_t)(h & 1) * (tstep >> 1); return true; } };

__device__ __forceinline__ u32x4 pack8(const f32x4& a, const f32x4& b) { u32x4 w; w.x = pg8::cvt_pk_bf16(a[0], a[1]); w.y = pg8::cvt_pk_bf16(a[2], a[3]); w.z = pg8::cvt_pk_bf16(b[0], b[1]); w.w = pg8::cvt_pk_bf16(b[2], b[3]); return w; }
__device__ __forceinline__ void store4(bf16* p, const f32x4& a) { uint2 w; w.x = pg8::cvt_pk_bf16(a[0], a[1]); w.y = pg8::cvt_pk_bf16(a[2], a[3]); *(uint2*)p = w; }
__device__ __forceinline__ void rope4(const float2* tab, f32x4& v0, f32x4& v1) {
    const f32x4 t0 = *(const f32x4*)tab, t1 = *(const f32x4*)(tab + 2);
    const f32x4 c = {t0[0], t0[2], t1[0], t1[2]}, s = {t0[1], t0[3], t1[1], t1[3]};
    const f32x4 a = v0 * c - v1 * s, b = v0 * s + v1 * c; v0 = a; v1 = b;
}
__device__ __forceinline__ void rope4t(const f32x4& t0, const f32x4& t1, f32x4& v0, f32x4& v1) {
    const f32x4 c = {t0[0], t0[2], t1[0], t1[2]}, sn = {t0[1], t0[3], t1[1], t1[3]};
    const f32x4 a = v0 * c - v1 * sn, b = v0 * sn + v1 * c; v0 = a; v1 = b;
}
__device__ __forceinline__ f32x4 sigmoid4(const f32x4& x) { f32x4 r;
#pragma unroll
    for (int e = 0; e < 4; ++e) r[e] = __builtin_amdgcn_rcpf(1.f + __builtin_amdgcn_exp2f(-1.4426950408889634f * x[e]));
    return r; }
__device__ __forceinline__ void bf8_to_f32(const u32x4& w, f32x4& a, f32x4& b) {
    a[0] = __uint_as_float(w.x << 16); a[1] = __uint_as_float(w.x & 0xffff0000u); a[2] = __uint_as_float(w.y << 16); a[3] = __uint_as_float(w.y & 0xffff0000u);
    b[0] = __uint_as_float(w.z << 16); b[1] = __uint_as_float(w.z & 0xffff0000u); b[2] = __uint_as_float(w.w << 16); b[3] = __uint_as_float(w.w & 0xffff0000u); }

struct EpiInproj { static constexpr bool PERM = true, AFTER_DRAIN = false; unsigned char* ws; float* rsq;
    __device__ __forceinline__ void operator()(const f32x4 (&acc)[2][2][4][2], const pg8::Unit& u, int wr, int wc, int fr, int fq) const {
        const int p0 = wc * 32 + 8 * fq;
        if (u.kind == 1) { bf16* VT = (bf16*)(ws + WS_VT); const int row0 = u.pm * 256 + wr * 64 + fr, col0 = u.pn * 256 + p0;
#pragma unroll
            for (int ai = 0; ai < 2; ++ai)
#pragma unroll
                for (int m = 0; m < 4; ++m) { bf16* rp = VT + (size_t)(row0 + ai * 128 + m * 16) * VTP + col0;
#pragma unroll
                    for (int bj = 0; bj < 2; ++bj) *(u32x4*)(rp + bj * 128) = pack8(acc[ai][bj][m][0], acc[ai][bj][m][1]); }
            return; }
        const int tile = u.pn, row0 = u.pm * 256 + wr * 64 + fr;
        if (tile < 4) { bf16* dst = (bf16*)(ws + (tile < 2 ? WS_QA : WS_KA)) + (tile & 1) * 256 + p0; const float2* tab = (const float2*)(ws + ROPE_A) + 4 * fq;
            const bool rot = ((wc & 1) == 0) && (fq < 2);
#pragma unroll
            for (int ai = 0; ai < 2; ++ai) { f32x4 t0[4], t1[4];
                if (rot) {
#pragma unroll
                    for (int m = 0; m < 4; ++m) { const f32x4* tp = (const f32x4*)(tab + ((row0 + ai * 128 + m * 16) & (SEQ - 1)) * 8); t0[m] = tp[0]; t1[m] = tp[1]; } }
#pragma unroll
                for (int m = 0; m < 4; ++m) { bf16* rp = dst + (size_t)(row0 + ai * 128 + m * 16) * 512;
#pragma unroll
                    for (int bj = 0; bj < 2; ++bj) { f32x4 v0 = acc[ai][bj][m][0], v1 = acc[ai][bj][m][1];
                        if (rot) { rope4t(t0[m], t1[m], v0, v1); bf16* bp = rp + bj * 128 - 8 * fq; store4(bp + 4 * fq, v0); store4(bp + 8 + 4 * fq, v1); }
                        else *(u32x4*)(rp + bj * 128) = pack8(v0, v1); } } }
        } else if (tile < 8) { const int which = (tile - 4) >> 1; bf16* dst = (bf16*)(ws + (which ? WS_CKV : WS_CQ)) + (tile & 1) * 256 + p0;
#pragma unroll
            for (int ai = 0; ai < 2; ++ai)
#pragma unroll
                for (int m = 0; m < 4; ++m) { const int row = row0 + ai * 128 + m * 16; bf16* rp = dst + (size_t)row * 512; float ss = 0.f;
#pragma unroll
                    for (int bj = 0; bj < 2; ++bj) { const f32x4 v0 = acc[ai][bj][m][0], v1 = acc[ai][bj][m][1];
                        ss += v0[0] * v0[0] + v0[1] * v0[1] + v0[2] * v0[2] + v0[3] * v0[3] + v1[0] * v1[0] + v1[1] * v1[1] + v1[2] * v1[2] + v1[3] * v1[3];
                        *(u32x4*)(rp + bj * 128) = pack8(v0, v1); }
                    ss += __shfl_xor(ss, 16); ss += __shfl_xor(ss, 32);
                    if (fq == 0) rsq[((size_t)row * 2 + which) * 8 + (tile & 1) * 4 + wc] = ss; }
        } else if (tile < 20) { const bool isk = tile >= 14; bf16* dst = (bf16*)(ws + (isk ? WS_KC : WS_QC)) + (tile - (isk ? 14 : 8)) * 256 + p0; const float2* tab = (const float2*)(ws + ROPE_C) + 4 * fq;
            const bool rot = (wc == 0);
#pragma unroll
            for (int ai = 0; ai < 2; ++ai) { f32x4 t0[4], t1[4];
                if (rot) {
#pragma unroll
                    for (int m = 0; m < 4; ++m) { const f32x4* tp = (const f32x4*)(tab + ((row0 + ai * 128 + m * 16) & (SEQ - 1)) * 16); t0[m] = tp[0]; t1[m] = tp[1]; } }
#pragma unroll
                for (int m = 0; m < 4; ++m) { bf16* rp = dst + (size_t)(row0 + ai * 128 + m * 16) * 1536;
#pragma unroll
                    for (int bj = 0; bj < 2; ++bj) { f32x4 v0 = acc[ai][bj][m][0], v1 = acc[ai][bj][m][1];
                        if (rot) { rope4t(t0[m], t1[m], v0, v1); bf16* bp = rp + bj * 128 - 8 * fq; store4(bp + 4 * fq, v0); store4(bp + 16 + 4 * fq, v1); }
                        else *(u32x4*)(rp + bj * 128) = pack8(v0, v1); } } }
        } else if (tile < 24) { bf16* dst = (bf16*)(ws + (tile < 22 ? WS_QD : WS_KD)) + (tile & 1) * 256 + p0;
#pragma unroll
            for (int ai = 0; ai < 2; ++ai)
#pragma unroll
                for (int m = 0; m < 4; ++m) { bf16* rp = dst + (size_t)(row0 + ai * 128 + m * 16) * 512;
#pragma unroll
                    for (int bj = 0; bj < 2; ++bj) *(u32x4*)(rp + bj * 128) = pack8(acc[ai][bj][m][0], acc[ai][bj][m][1]); }
        } else { if (wc < 2) { const int j = 4 * wc + fq; bf16* KB = (bf16*)(ws + WS_KB) + 128 + 4 * j; const float2* tab = (const float2*)(ws + ROPE_M) + 4 * j;
#pragma unroll
            for (int ai = 0; ai < 2; ++ai) { f32x4 t0[4], t1[4];
#pragma unroll
                for (int m = 0; m < 4; ++m) { const f32x4* tp = (const f32x4*)(tab + ((row0 + ai * 128 + m * 16) & (SEQ - 1)) * 32); t0[m] = tp[0]; t1[m] = tp[1]; }
#pragma unroll
                for (int m = 0; m < 4; ++m) { bf16* rp = KB + (size_t)(row0 + ai * 128 + m * 16) * 768;
                    f32x4 v0 = acc[ai][0][m][0], v1 = acc[ai][0][m][1]; rope4t(t0[m], t1[m], v0, v1);
#pragma unroll
                    for (int h = 0; h < 4; ++h) { store4(rp + h * 192, v0); store4(rp + h * 192 + 32, v1); } } } } }
    }
};

__device__ __forceinline__ float rsq_scale(const float* rsq, int tok, int which) { const f32x4 a = *(const f32x4*)(rsq + ((size_t)tok * 2 + which) * 8), b = *(const f32x4*)(rsq + ((size_t)tok * 2 + which) * 8 + 4);
    return rsqrtf((((a[0] + a[1]) + (a[2] + a[3])) + ((b[0] + b[1]) + (b[2] + b[3]))) * (1.f / 512) + EPS); }
struct EpiGate { static constexpr bool PERM = true, AFTER_DRAIN = false; bf16* G;
    __device__ __forceinline__ void operator()(const f32x4 (&acc)[2][2][4][2], const pg8::Unit& u, int wr, int wc, int fr, int fq) const {
        bf16* gp = G + ((size_t)(u.pm * 32 + u.pn) << 16) + (wr * 64 + fr) * 256 + wc * 32 + 8 * fq;
#pragma unroll
        for (int ai = 0; ai < 2; ++ai)
#pragma unroll
            for (int m = 0; m < 4; ++m) { bf16* rp = gp + (ai * 128 + m * 16) * 256;
#pragma unroll
                for (int bj = 0; bj < 2; ++bj) *(u32x4*)(rp + bj * 128) = pack8(sigmoid4(acc[ai][bj][m][0] * (1.f / 256)), sigmoid4(acc[ai][bj][m][1] * (1.f / 256))); }
    }
};
struct EpiMla { static constexpr bool PERM = true, AFTER_DRAIN = false; unsigned char* ws; const float* rsq;
    __device__ __forceinline__ void operator()(const f32x4 (&acc)[2][2][4][2], const pg8::Unit& u, int wr, int wc, int fr, int fq) const {
        const int p0 = wc * 32 + 8 * fq;
        if (u.kind == 2) { bf16* VTB = (bf16*)(ws + WS_VTB); const int row0 = u.pm * 256 + wr * 64 + fr, col0 = u.pn * 256 + p0;
#pragma unroll
            for (int bj = 0; bj < 2; ++bj) { const int t0 = col0 + bj * 128;
                const f32x4 sa = {rsq_scale(rsq, t0, 1), rsq_scale(rsq, t0 + 1, 1), rsq_scale(rsq, t0 + 2, 1), rsq_scale(rsq, t0 + 3, 1)};
                const f32x4 sb = {rsq_scale(rsq, t0 + 4, 1), rsq_scale(rsq, t0 + 5, 1), rsq_scale(rsq, t0 + 6, 1), rsq_scale(rsq, t0 + 7, 1)};
#pragma unroll
                for (int ai = 0; ai < 2; ++ai)
#pragma unroll
                    for (int m = 0; m < 4; ++m) *(u32x4*)(VTB + (size_t)(row0 + ai * 128 + m * 16) * VTP + col0 + bj * 128) = pack8(acc[ai][bj][m][0] * sa, acc[ai][bj][m][1] * sb); }
            return; }
        const int row0 = u.pm * 256 + wr * 64 + fr, tile = u.pn;
        bf16* dst = (bf16*)(ws + (u.kind == 0 ? WS_QB : WS_KB));
#pragma unroll
        for (int ai = 0; ai < 2; ++ai)
#pragma unroll
            for (int m = 0; m < 4; ++m) { const int row = row0 + ai * 128 + m * 16, pos = row & (SEQ - 1); const float r = rsq_scale(rsq, row, u.kind); bf16* rp = dst + (size_t)row * 768;
#pragma unroll
                for (int bj = 0; bj < 2; ++bj) { f32x4 v0 = acc[ai][bj][m][0] * r, v1 = acc[ai][bj][m][1] * r;
                    if (u.kind == 0 && tile == 2) { const int hb = 2 * bj + (wc >> 1), j = 4 * (wc & 1) + fq; rope4((const float2*)(ws + ROPE_M) + pos * 32 + 4 * j, v0, v1);
                        store4(rp + hb * 192 + 128 + 4 * j, v0); store4(rp + hb * 192 + 160 + 4 * j, v1); }
                    else *(u32x4*)(rp + (2 * tile + bj) * 192 + p0) = pack8(v0, v1); } }
    }
};
struct EpiBranchF { static constexpr bool PERM = true, AFTER_DRAIN = false; const bf16* G; bf16* MGT; bf16* MGB;
    __device__ __forceinline__ void operator()(const f32x4 (&acc)[2][2][4][2], const pg8::Unit& u, int wr, int wc, int fr, int fq) const {
        const int i = u.kind, pm = u.pm & 31, pn = u.pn & 7, lr = wr * 64 + fr, lc = wc * 32 + 8 * fq;
        const bf16* gt = G + ((size_t)(pm * 32 + i * 8 + pn) << 16) + lr * 256 + lc;
        bf16* mt = MGT + ((size_t)(pm * 8 + pn) << 16) + lr * 256 + lc;
#pragma unroll
        for (int ai = 0; ai < 2; ++ai) {
            u32x4 gw[4][2], ow[4][2];
#pragma unroll
            for (int m = 0; m < 4; ++m)
#pragma unroll
                for (int bj = 0; bj < 2; ++bj) { const int off = (ai * 128 + m * 16) * 256 + bj * 128;
                    gw[m][bj] = *(const u32x4*)(gt + off);
                    if (i > 0) ow[m][bj] = *(const u32x4*)(mt + off); }
#pragma unroll
            for (int m = 0; m < 4; ++m)
#pragma unroll
                for (int bj = 0; bj < 2; ++bj) { const int off = (ai * 128 + m * 16) * 256 + bj * 128;
                    f32x4 g0, g1; bf8_to_f32(gw[m][bj], g0, g1);
                    f32x4 v0 = acc[ai][bj][m][0] * g0, v1 = acc[ai][bj][m][1] * g1;
                    if (i > 0) { f32x4 o0, o1; bf8_to_f32(ow[m][bj], o0, o1); v0 += o0; v1 += o1; }
                    if (i < 3) *(u32x4*)(mt + off) = pack8(v0, v1);
                    else *(u32x4*)(MGB + (size_t)(pm * 256 + lr + ai * 128 + m * 16) * DM + pn * 256 + lc + bj * 128) = pack8(v0, v1); }
            asm volatile("" ::: "memory"); }
    }
};
struct EpiBranchH { static constexpr bool PERM = true, AFTER_DRAIN = false; const bf16* G; bf16* MGB; mutable u32x4 gp[2][4];
    __device__ __forceinline__ void operator()(f32x4 (&acc)[2][2][4][2], const pg8::Unit& u, int wr, int wc, int fr, int fq) const {
        typedef const __attribute__((address_space(1))) u32x4 gv4;
        const int br = u.kind & 3, hf = u.kind >> 2, lr = wr * 64 + fr, lc = hf * 128 + wc * 32 + 8 * fq;
        const __attribute__((address_space(1))) bf16* gb = (const __attribute__((address_space(1))) bf16*)G + ((size_t)(u.pm * 32 + br * 8 + u.pn) << 16);
        const unsigned lo = (unsigned)(lr * 256 + lc);
        if (br == 0) {
#pragma unroll
            for (int ai = 0; ai < 2; ++ai)
#pragma unroll
                for (int m = 0; m < 4; ++m) gp[ai][m] = *(gv4*)(gb + lo + (ai * 128 + m * 16) * 256); }
#pragma unroll
        for (int ai = 0; ai < 2; ++ai)
#pragma unroll
            for (int m = 0; m < 4; ++m) { f32x4 g0, g1; bf8_to_f32(gp[ai][m], g0, g1);
                if (br == 0) { acc[ai][1][m][0] = acc[ai][0][m][0] * g0; acc[ai][1][m][1] = acc[ai][0][m][1] * g1; }
                else { acc[ai][1][m][0] += acc[ai][0][m][0] * g0; acc[ai][1][m][1] += acc[ai][0][m][1] * g1; } }
        if (br < 3) {
#pragma unroll
            for (int ai = 0; ai < 2; ++ai)
#pragma unroll
                for (int m = 0; m < 4; ++m) gp[ai][m] = *(gv4*)(gb + ((size_t)8 << 16) + lo + (ai * 128 + m * 16) * 256);
        } else {
            __attribute__((address_space(1))) bf16* mb = (__attribute__((address_space(1))) bf16*)MGB + (size_t)(u.pm * 256) * DM + u.pn * 256;
            const unsigned mo = (unsigned)(lr * DM + lc);
#pragma unroll
            for (int ai = 0; ai < 2; ++ai)
#pragma unroll
                for (int m = 0; m < 4; ++m) *(__attribute__((address_space(1))) u32x4*)(mb + mo + (ai * 128 + m * 16) * DM) = pack8(acc[ai][1][m][0], acc[ai][1][m][1]); }
    }
};
struct EpiResidF { static constexpr bool PERM = false, AFTER_DRAIN = false; const float* Xin; float* Xout;
    __device__ __forceinline__ void operator()(const f32x4 (&acc)[2][2][4][2], const pg8::Unit& u, int wr, int wc, int fr, int fq) const {
        const int row0 = u.pm * 256 + wr * 64 + fr, col0 = u.pn * 256 + wc * 32 + 4 * fq;
#pragma unroll
        for (int ai = 0; ai < 2; ++ai) {
            f32x4 xi[4][2][2];
#pragma unroll
            for (int m = 0; m < 4; ++m)
#pragma unroll
                for (int bj = 0; bj < 2; ++bj)
#pragma unroll
                    for (int n = 0; n < 2; ++n) xi[m][bj][n] = *(const f32x4*)(Xin + (size_t)(row0 + ai * 128 + m * 16) * DM + col0 + bj * 128 + n * 16);
#pragma unroll
            for (int m = 0; m < 4; ++m)
#pragma unroll
                for (int bj = 0; bj < 2; ++bj)
#pragma unroll
                    for (int n = 0; n < 2; ++n) *(f32x4*)(Xout + (size_t)(row0 + ai * 128 + m * 16) * DM + col0 + bj * 128 + n * 16) = xi[m][bj][n] + acc[ai][bj][m][n];
            asm volatile("" ::: "memory"); }
    }
};
struct EpiSwigluF { static constexpr bool PERM = true, AFTER_DRAIN = false; bf16* ACT; int NT;
    __device__ __forceinline__ void operator()(const f32x4 (&acc)[2][2][4][2], const pg8::Unit& u, int wr, int wc, int fr, int fq) const {
        const int row0 = u.pm * 256 + wr * 64 + fr, col0 = (u.pn % NT) * 128 + wc * 32 + 8 * fq;
#pragma unroll
        for (int ai = 0; ai < 2; ++ai)
#pragma unroll
            for (int m = 0; m < 4; ++m) { const f32x4 g0 = acc[ai][0][m][0], g1 = acc[ai][0][m][1];
                const f32x4 a0 = g0 * sigmoid4(g0) * acc[ai][1][m][0], a1 = g1 * sigmoid4(g1) * acc[ai][1][m][1];
                *(u32x4*)(ACT + (size_t)(row0 + ai * 128 + m * 16) * DFF + col0) = pack8(a0, a1); }
    }
};
struct EpiSwigluF8 { static constexpr bool PERM = true, AFTER_DRAIN = false; unsigned char* ACT; int NT;
    __device__ __forceinline__ void operator()(const f32x4 (&acc)[2][2][4][2], const pg8::Unit& u, int wr, int wc, int fr, int fq) const {
        const int row0 = u.pm * 256 + wr * 64 + fr, col0 = (u.pn % NT) * 128 + wc * 32 + 8 * fq;
#pragma unroll
        for (int ai = 0; ai < 2; ++ai)
#pragma unroll
            for (int m = 0; m < 4; ++m) { const f32x4 g0 = acc[ai][0][m][0] * (1.f / 256), g1 = acc[ai][0][m][1] * (1.f / 256);
                f32x4 a0 = g0 * sigmoid4(g0) * acc[ai][1][m][0] * (4.f / 256), a1 = g1 * sigmoid4(g1) * acc[ai][1][m][1] * (4.f / 256);
#pragma unroll
                for (int e = 0; e < 4; ++e) { a0[e] = fminf(fmaxf(a0[e], -440.f), 440.f); a1[e] = fminf(fmaxf(a1[e], -440.f), 440.f); }
                const uint2 o = {pk4_fp8(a0[0], a0[1], a0[2], a0[3]), pk4_fp8(a1[0], a1[1], a1[2], a1[3])};
                *(uint2*)(ACT + (size_t)(row0 + ai * 128 + m * 16) * DFF + col0) = o; }
    }
};
struct EpiStoreF { static constexpr bool PERM = true, AFTER_DRAIN = false; bf16* O; int NT; float sc;
    __device__ __forceinline__ void operator()(const f32x4 (&acc)[2][2][4][2], const pg8::Unit& u, int wr, int wc, int fr, int fq) const {
        const int row0 = u.pm * 256 + wr * 64 + fr, col0 = (u.pn % NT) * 256 + wc * 32 + 8 * fq;
#pragma unroll
        for (int ai = 0; ai < 2; ++ai)
#pragma unroll
            for (int m = 0; m < 4; ++m) { bf16* rp = O + (size_t)(row0 + ai * 128 + m * 16) * DM + col0;
#pragma unroll
                for (int bj = 0; bj < 2; ++bj) *(u32x4*)(rp + bj * 128) = pack8(acc[ai][bj][m][0] * sc, acc[ai][bj][m][1] * sc); }
    }
};

struct EpiStoreFH { static constexpr bool PERM = true, AFTER_DRAIN = false; bf16* O; int NT; float sc;
    __device__ __forceinline__ void operator()(const f32x4 (&acc)[2][2][4][2], const pg8::Unit& u, int wr, int wc, int fr, int fq) const {
        const int row0 = u.pm * 256 + wr * 64 + fr, col0 = (u.pn % NT) * 256 + u.kind * 128 + wc * 32 + 8 * fq;
#pragma unroll
        for (int ai = 0; ai < 2; ++ai)
#pragma unroll
            for (int m = 0; m < 4; ++m) *(u32x4*)(O + (size_t)(row0 + ai * 128 + m * 16) * DM + col0) = pack8(acc[ai][0][m][0] * sc, acc[ai][0][m][1] * sc);
    }
};

__device__ __forceinline__ void phase_inproj(const FArgs& a, LAS unsigned char* lds, int layer) {
    unsigned char* ws_ = a.ws; asm volatile("" : "+s"(ws_));
    {   InSched S; S.H = (const char*)(ws_ + WS_H); S.W = (const char*)(ws_ + WS_WT + WT_IN) + (size_t)layer * NT_IN * 256 * DM * 2; S.WV = (const char*)(ws_ + WS_WT + WT_INV) + (size_t)layer * NV_ROWS * DM * 2; S.G = gdim_(); S.c = bid_();
        EpiInproj E{ws_, (float*)(ws_ + WS_RSQP) + (size_t)layer * T * 16};
        pg8::gemm_phase<EpiInproj, InSched, true, true>(lds, DM, S, E); }
    {   GateSched S; S.H8 = (const char*)(ws_ + WS_ACT); S.W8 = (const char*)(ws_ + WS_WT + WT_ING) + (size_t)layer * 8192 * DM; S.G = gdim_(); S.c = bid_();
        EpiGate E{(bf16*)(ws_ + WS_G)};
        pg8::gemm_phase<EpiGate, GateSched, true, true, true>(lds, DM / 2, S, E); }
}
__device__ __forceinline__ void phase_mlaup(const FArgs& a, LAS unsigned char* lds, int layer) {
    unsigned char* ws_ = a.ws; asm volatile("" : "+s"(ws_));
    MlaSched S; S.CQ = (const char*)(ws_ + WS_CQ); S.CKV = (const char*)(ws_ + WS_CKV);
    S.WQ = (const char*)(ws_ + WS_WT + WT_UQ) + (size_t)layer * 768 * 512 * 2; S.WKN = (const char*)(ws_ + WS_WT + WT_UKN) + (size_t)layer * 512 * 512 * 2; S.WKV = (const char*)(ws_ + WS_WT + WT_UKV) + (size_t)layer * 512 * 512 * 2; S.G = gdim_(); S.c = bid_();
    EpiMla E{ws_, (const float*)(ws_ + WS_RSQP) + (size_t)layer * T * 16};
    pg8::gemm_phase<EpiMla, MlaSched, true, true>(lds, 512, S, E);
}
__device__ __forceinline__ void phase_branch(const FArgs& a, LAS unsigned char* lds, int layer) {
    unsigned char* ws_ = a.ws; asm volatile("" : "+s"(ws_));
    BranchSchedH S; S.Y = (const char*)(ws_ + WS_Y); S.W = (const char*)(ws_ + WS_WT + WT_BR) + (size_t)layer * 4 * DM * 512 * 2; S.c = bid_();
    EpiBranchH E; E.G = (const bf16*)(ws_ + WS_G); E.MGB = (bf16*)(ws_ + WS_MGB);
    pg8::gemm_phase<EpiBranchH, BranchSchedH, true, true, false, true>(lds, 512, S, E);
}
__device__ __forceinline__ void phase_outproj(const FArgs& a, LAS unsigned char* lds, int layer) {
    unsigned char* ws_ = a.ws; asm volatile("" : "+s"(ws_));
    GenSched S; S.A = (const char*)(ws_ + WS_MGB); S.Bt = (const char*)(ws_ + WS_WT + WT_OUT) + (size_t)layer * DM * DM * 2; S.tstep = (size_t)256 * DM * 2; S.nM = 32; S.nN = 8; S.G = gdim_(); S.c = bid_();
    EpiResidF E{layer == 0 ? a.in[0] : (const float*)(ws_ + WS_XA), (float*)(ws_ + WS_XA)};
    pg8::gemm_phase<EpiResidF, GenSched, true, true>(lds, DM, S, E);
}
__device__ __forceinline__ void phase_ffn_in(const FArgs& a, LAS unsigned char* lds) {
    unsigned char* ws_ = a.ws; asm volatile("" : "+s"(ws_));
    GenSched S; S.A = (const char*)(ws_ + WS_H); S.Bt = (const char*)(ws_ + WS_WT + WT_DI); S.tstep = (size_t)256 * DM * 2; S.nM = 32; S.nN = 44; S.G = gdim_(); S.c = bid_();
    EpiSwigluF E{(bf16*)(ws_ + WS_ACT), 44};
    pg8::gemm_phase<EpiSwigluF, GenSched, true, true>(lds, DM, S, E);
}
__device__ __forceinline__ void phase_ffn_out(const FArgs& a, LAS unsigned char* lds) {
    unsigned char* ws_ = a.ws; asm volatile("" : "+s"(ws_));
    GenSched S; S.A = (const char*)(ws_ + WS_ACT); S.Bt = (const char*)(ws_ + WS_WT + WT_DO); S.tstep = (size_t)256 * DFF * 2; S.nM = 32; S.nN = 8; S.G = gdim_(); S.c = bid_();
    EpiResidF E{(const float*)(ws_ + WS_XA), (float*)(ws_ + WS_XA)};
    pg8::gemm_phase<EpiResidF, GenSched, true, true>(lds, DFF, S, E);
}
__device__ __forceinline__ void phase_moe_in(const FArgs& a, LAS unsigned char* lds) {
    unsigned char* ws_ = a.ws; asm volatile("" : "+s"(ws_));
    MoeSched S; S.A = (const char*)(ws_ + WS_HS); S.Bt = (const char*)(ws_ + WS_WT + WT_MI); S.tstep = (size_t)256 * DM; S.NT = 44; S.G = gdim_(); S.c = bid_(); S.init((const int*)(ws_ + WS_CTL + CTL_CNT));
    EpiSwigluF8 E{ws_ + WS_ACTS, 44};
    pg8::gemm_phase<EpiSwigluF8, MoeSched, true, true, true>(lds, DM / 2, S, E);
}
__device__ __forceinline__ void phase_moe_out(const FArgs& a, LAS unsigned char* lds) {
    unsigned char* ws_ = a.ws; asm volatile("" : "+s"(ws_));
    MoeSched S; S.A = (const char*)(ws_ + WS_ACTS); S.Bt = (const char*)(ws_ + WS_WT + WT_MO); S.tstep = (size_t)256 * DFF; S.NT = 8; S.G = gdim_(); S.c = bid_(); S.init((const int*)(ws_ + WS_CTL + CTL_CNT));
    EpiStoreF E{(bf16*)(ws_ + WS_OUTS), 8, 1.f / 256};
    const int q = (S.pre[8] * 8 + 7) >> 3, fr = q >> 5, r = q - (fr << 5);
    const bool split = r > 0 && r <= 16;
    if (split) S.imax = fr;
    pg8::gemm_phase<EpiStoreF, MoeSched, true, true, true>(lds, DFF / 2, S, E);
    if (split) {
        MoeSchedTail Tl; Tl.A = S.A; Tl.Bt = S.Bt; Tl.tstep = S.tstep; Tl.NT = 8; Tl.G = S.G; Tl.c = S.c; Tl.fr = fr;
#pragma unroll
        for (int k = 0; k < 9; ++k) Tl.pre[k] = S.pre[k];
        EpiStoreFH EH{(bf16*)(ws_ + WS_OUTS), 8, 1.f / 256};
        pg8::gemm_phase<EpiStoreFH, MoeSchedTail, true, true, true, true>(lds, DFF / 2, Tl, EH);
    }
}

#ifndef MK_MULTI
#define PHASE_KERNEL(name, call)
#else
#define PHASE_KERNEL(name, call) __global__ void __launch_bounds__(NTHR, 2) name(FArgs a) { extern __shared__ __attribute__((aligned(16))) unsigned char lds_raw[]; LAS unsigned char* lds = (LAS unsigned char*)lds_raw; call; }
#endif
PHASE_KERNEL(kf_convert, phase_convert(a, lds))
PHASE_KERNEL(kf_inproj, phase_inproj(a, lds, a.layer))
PHASE_KERNEL(kf_mlaup, phase_mlaup(a, lds, a.layer))
PHASE_KERNEL(kf_branch, phase_branch(a, lds, a.layer))
PHASE_KERNEL(kf_outproj, phase_outproj(a, lds, a.layer))
PHASE_KERNEL(kf_ffn_in, phase_ffn_in(a, lds))
PHASE_KERNEL(kf_ffn_out, phase_ffn_out(a, lds))
PHASE_KERNEL(kf_moe_in, phase_moe_in(a, lds))
PHASE_KERNEL(kf_moe_out, phase_moe_out(a, lds))
__device__ __forceinline__ f32x16 mfma32(const bf16x8& a, const bf16x8& b, const f32x16& c) { return __builtin_amdgcn_mfma_f32_32x32x16_bf16(a, b, c, 0, 0, 0); }
__device__ __forceinline__ float ex2(float x) { return __builtin_amdgcn_exp2f(x); }
__device__ __forceinline__ float max_xor32(float v) { auto rr = __builtin_amdgcn_permlane32_swap(__float_as_uint(v), __float_as_uint(v), false, false); return fmaxf(__uint_as_float(rr[0]), __uint_as_float(rr[1])); }
__device__ __forceinline__ float lg2(float x) { return __builtin_amdgcn_logf(x); }
__device__ __forceinline__ bf16x8 pack8v(const f32x16& p, int s) {
    u32x4 w; w.x = pg8::cvt_pk_bf16(p[8 * s + 0], p[8 * s + 1]); w.y = pg8::cvt_pk_bf16(p[8 * s + 2], p[8 * s + 3]); w.z = pg8::cvt_pk_bf16(p[8 * s + 4], p[8 * s + 5]); w.w = pg8::cvt_pk_bf16(p[8 * s + 6], p[8 * s + 7]);
    return __builtin_bit_cast(bf16x8, w); }
constexpr int VS = 144;
template <int DQK, int MODE>
__device__ __forceinline__ void attn_pass(LAS unsigned char* lds, const bf16* __restrict__ Qp, int ldq, const bf16* __restrict__ Kp, int ldk, const bf16* __restrict__ VTp,
                                          int q0, int tile_lo, int tile_hi, int win, int dmask, float C, f32x16 (&O)[4], float& m, float& l) {
    constexpr int KS = DQK * 2 + 16, NKC = DQK / 8, CK = NKC / 8, BUFSZ = 64 * KS + 128 * VS, NKS = DQK / 16;
    int tid = threadIdx.x; asm volatile("" : "+v"(tid));
    const int wave = __builtin_amdgcn_readfirstlane(tid >> 6), lane = tid & 63, r = lane & 31, h = lane >> 5;
    const int qpos = q0 + 32 * wave + r, qw_min = q0 + 32 * wave, qw_max = qw_min + 31;
    const int kap = (r & 19) | ((r & 4) << 1) | ((r & 8) >> 1);
    typedef const __attribute__((address_space(1))) bf16 gbf16;
    gbf16* Qg = (gbf16*)Qp; gbf16* Kg = (gbf16*)Kp; gbf16* VTg = (gbf16*)VTp;
    bf16x8 qf[NKS];
#pragma unroll
    for (int ks = 0; ks < NKS; ++ks) qf[ks] = *(const __attribute__((address_space(1))) bf16x8*)(Qg + (size_t)(32 * wave + r) * ldq + 16 * ks + 8 * h);
    int krow[CK], kcc[CK];
#pragma unroll
    for (int i = 0; i < CK; ++i) { const int c = tid + 512 * i; krow[i] = c / NKC; kcc[i] = c % NKC; }
    const int vrow0 = tid >> 3, vcc = tid & 7;
    u32x4 kst[CK], vst[2];
    const int ntile = tile_hi - tile_lo;
    if (ntile <= 0) return;
    float carry = 0.f; bool seen = false;
    f32x16 madd;
#pragma unroll
    for (int e = 0; e < 16; ++e) madd[e] = (MODE == 1 && ((qpos - 8 * h - (e & 7) - 16 * (e >> 3)) & dmask) != 0) ? -__builtin_inff() : 0.f;
    LAS int* dflag = (LAS int*)(lds + 73728);
#define ATT_LOADS(key0_) do { _Pragma("unroll") for (int i = 0; i < CK; ++i) kst[i] = *(const __attribute__((address_space(1))) u32x4*)(Kg + (size_t)((key0_) + krow[i]) * ldk + kcc[i] * 8); \
        _Pragma("unroll") for (int i = 0; i < 2; ++i) vst[i] = *(const __attribute__((address_space(1))) u32x4*)(VTg + (size_t)(vrow0 + 64 * i) * VTP + (key0_) + vcc * 8); } while (0)
#define ATT_WRITE(buf_) do { LAS unsigned char* Kn_ = lds + (buf_) * BUFSZ; _Pragma("unroll") for (int i = 0; i < CK; ++i) *(LAS u32x4*)(Kn_ + krow[i] * KS + kcc[i] * 16) = kst[i]; \
        _Pragma("unroll") for (int i = 0; i < 2; ++i) *(LAS u32x4*)(Kn_ + 64 * KS + (vrow0 + 64 * i) * VS + vcc * 16) = vst[i]; } while (0)
#define ATT_KEY0(step_) ((MODE == 2 ? tile_hi - 1 - (step_) : tile_lo + (step_)) * 64)
    ATT_LOADS(ATT_KEY0(0)); ATT_WRITE(0);
    if (ntile > 1) ATT_LOADS(ATT_KEY0(1));
    __syncthreads();
    for (int step = 0; step < ntile; ++step) {
        const int key0 = ATT_KEY0(step);
        LAS unsigned char* Kb = lds + (step & 1) * BUFSZ; LAS unsigned char* Vb = Kb + 64 * KS;
        if (step + 1 < ntile) { ATT_WRITE((step + 1) & 1); if (step + 2 < ntile) ATT_LOADS(ATT_KEY0(step + 2)); }
        bool active, needmask;
        if (MODE == 0) { active = key0 <= qw_max; needmask = key0 + 63 > qw_min; }
        else if (MODE == 1) { active = key0 <= qw_max && key0 + 63 >= qw_min - win; needmask = true; }
        else { active = key0 < qw_max; needmask = key0 + 63 >= qw_min; }
        if (MODE == 2 && active) seen = true;
        if (active) {
            f32x16 p0, p1;
#pragma unroll
            for (int e = 0; e < 16; ++e) { p0[e] = 0.f; p1[e] = 0.f; }
            {   constexpr int GK = 2, NG = NKS / GK; bf16x8 kf[NKS][2];
#define ATT_LDK(g_) _Pragma("unroll") for (int ks = (g_) * GK; ks < (g_) * GK + GK; ++ks) { kf[ks][0] = *(const LAS bf16x8*)(Kb + kap * KS + ks * 32 + h * 16); kf[ks][1] = *(const LAS bf16x8*)(Kb + (32 + kap) * KS + ks * 32 + h * 16); }
                ATT_LDK(0)
#pragma unroll
                for (int g = 0; g < NG; ++g) { if (g + 1 < NG) { ATT_LDK(g + 1) }
                    __builtin_amdgcn_sched_barrier(0);
#pragma unroll
                    for (int ks = g * GK; ks < g * GK + GK; ++ks) { p0 = mfma32(kf[ks][0], qf[ks], p0); p1 = mfma32(kf[ks][1], qf[ks], p1); }
                    __builtin_amdgcn_sched_barrier(0); }
#undef ATT_LDK
            }
            const int d0 = qpos - key0 - 8 * h;
            if (MODE != 2) {
                bool bnd = key0 + 63 > qw_min; if (MODE == 1) bnd = bnd || (qw_max - key0 > win);
                if (bnd) {
                    asm volatile("" ::: "memory");
#pragma unroll
                    for (int e = 0; e < 16; ++e) { const int dl0 = d0 - (e & 7) - 16 * (e >> 3), dl1 = dl0 - 32; bool v0, v1;
                        if (MODE == 0) { v0 = dl0 >= 0; v1 = dl1 >= 0; } else { v0 = (unsigned)dl0 <= (unsigned)win && (dl0 & dmask) == 0; v1 = (unsigned)dl1 <= (unsigned)win && (dl1 & dmask) == 0; }
                        p0[e] = v0 ? p0[e] : -__builtin_inff(); p1[e] = v1 ? p1[e] : -__builtin_inff(); }
                    p0 = p0 * C; p1 = p1 * C;
                } else if (MODE == 1) { p0 = p0 * C + madd; p1 = p1 * C + madd; }
                else { p0 = p0 * C; p1 = p1 * C; }
                float mc[4];
#pragma unroll
                for (int c = 0; c < 4; ++c) mc[c] = fmaxf(fmaxf(p0[c], p1[c]), fmaxf(p0[c + 4], p1[c + 4]));
#pragma unroll
                for (int c = 0; c < 4; ++c) { mc[c] = fmaxf(fmaxf(p0[c + 8], p1[c + 8]), mc[c]); mc[c] = fmaxf(fmaxf(p0[c + 12], p1[c + 12]), mc[c]); }
                const float mt = max_xor32(fmaxf(fmaxf(mc[0], mc[1]), fmaxf(mc[2], mc[3])));
                float mn = m, alpha = 1.f; const bool resc = !__all(mt - m <= 11.5f);
                if (resc) { mn = fmaxf(m, mt); alpha = ex2(m - mn); m = mn; }
                p0 = p0 - mn; p1 = p1 - mn;
#pragma unroll
                for (int e = 0; e < 16; ++e) { p0[e] = ex2(p0[e]); p1[e] = ex2(p1[e]); }
                const f32x16 t16 = p0 + p1; const f32x8v t8 = t16.lo + t16.hi; const f32x4 t4 = t8.lo + t8.hi; const f32x2v t2 = t4.lo + t4.hi;
                const float ps = t2.x + t2.y;
                l = l * alpha + ps;
                if (resc) {
#pragma unroll
                    for (int d = 0; d < 4; ++d) O[d] = O[d] * alpha; }
            } else {
                float R[4];
#pragma unroll
                for (int rr = 0; rr < 4; ++rr) { float suf = 0.f;
#pragma unroll
                    for (int j = 7; j >= 0; --j) { const int e = 8 * (rr & 1) + j; const int dl = d0 - j - 16 * (rr & 1) - 32 * (rr >> 1);
                        const float z = (rr < 2 ? p0[e] : p1[e]) * C; const bool v = !needmask || dl > 0;
                        const float sp = lg2(1.f + ex2(-fabsf(z))), lsig = fminf(z, 0.f) - sp, lnot = v ? lsig - z : 0.f;
                        const float val = v ? lsig + suf : -__builtin_inff();
                        if (rr < 2) p0[e] = val; else p1[e] = val;
                        suf += lnot; }
                    R[rr] = suf; }
                float Rp[4];
#pragma unroll
                for (int rr = 0; rr < 4; ++rr) Rp[rr] = __shfl_xor(R[rr], 32);
                float tail = carry;
#pragma unroll
                for (int rr = 3; rr >= 0; --rr) { const float t = tail + (h == 0 ? Rp[rr] : 0.f);
#pragma unroll
                    for (int j = 0; j < 8; ++j) { const int e = 8 * (rr & 1) + j; if (rr < 2) p0[e] = ex2(p0[e] + t); else p1[e] = ex2(p1[e] + t); }
                    tail += R[rr] + Rp[rr]; }
                carry = tail;
            }
            bf16x8 pf[4]; pf[0] = pack8v(p0, 0); pf[1] = pack8v(p0, 1); pf[2] = pack8v(p1, 0); pf[3] = pack8v(p1, 1);
            {   bf16x8 vf[4][4];
#define ATT_LDV(d_) _Pragma("unroll") for (int ks = 0; ks < 4; ++ks) vf[d_][ks] = *(const LAS bf16x8*)(Vb + (32 * (d_) + r) * VS + ks * 32 + h * 16);
                ATT_LDV(0)
#pragma unroll
                for (int d = 0; d < 4; ++d) { if (d + 1 < 4) { ATT_LDV(d + 1) }
                    __builtin_amdgcn_sched_barrier(0);
#pragma unroll
                    for (int ks = 0; ks < 4; ++ks) O[d] = mfma32(vf[d][ks], pf[ks], O[d]);
                    __builtin_amdgcn_sched_barrier(0); }
#undef ATT_LDV
            }
        }
        if (MODE == 2) { const int fl = (seen && __all(carry < -160.f)) ? 1 : 0; if (lane == 0) dflag[(step & 1) * 8 + wave] = fl; }
        __syncthreads();
        if (MODE == 2) { int alld = 1;
#pragma unroll
            for (int w = 0; w < 8; ++w) alld &= dflag[(step & 1) * 8 + w];
            if (__builtin_amdgcn_readfirstlane(alld)) { __syncthreads(); break; } }
    }
}
#undef ATT_LOADS
#undef ATT_WRITE
#undef ATT_KEY0
__device__ __forceinline__ void o_zero(f32x16 (&O)[4]) {
#pragma unroll
    for (int d = 0; d < 4; ++d)
#pragma unroll
        for (int e = 0; e < 16; ++e) O[d][e] = 0.f; }
__device__ __forceinline__ void o_store(const f32x16 (&O)[4], float sc, bf16* yrow, int h) {
#pragma unroll
    for (int d = 0; d < 4; ++d)
#pragma unroll
        for (int g = 0; g < 4; ++g) { const f32x4 v = {O[d][4 * g] * sc, O[d][4 * g + 1] * sc, O[d][4 * g + 2] * sc, O[d][4 * g + 3] * sc}; store4(yrow + 32 * d + 8 * g + 4 * h, v); } }

template <int TYPE>
__device__ __forceinline__ void attn_unit(const FArgs& a, LAS unsigned char* lds, int layer, int b, int hd, int qb) {
    unsigned char* ws = a.ws; asm volatile("" : "+s"(ws));
    int tid_ = threadIdx.x; asm volatile("" : "+v"(tid_));
    const int lane = tid_ & 63, wave = __builtin_amdgcn_readfirstlane(tid_ >> 6), r = lane & 31, h = lane >> 5;
    const int q0 = qb * 256, tok0 = b * SEQ;
    const int nt_c = (q0 + 256) / 64;
    bf16* yrow = (bf16*)(ws + WS_Y) + (size_t)TYPE * T * 512 + (size_t)(tok0 + q0 + 32 * wave + r) * 512 + hd * 128;
    constexpr float L2E = 1.4426950408889634f;
    f32x16 O[4]; float m, l;
    if (TYPE == 0) {
        const bf16* Qp = (const bf16*)(ws + WS_QA) + (size_t)(tok0 + q0) * 512 + hd * 128; const bf16* Kp = (const bf16*)(ws + WS_KA) + (size_t)tok0 * 512 + hd * 128;
        const bf16* VTp = (const bf16*)(ws + WS_VT) + (size_t)(hd * 128) * VTP + tok0;
        o_zero(O); m = -1e30f; l = 0.f;
        attn_pass<64, 0>(lds, Qp, 512, Kp, 512, VTp, q0, 0, nt_c, 0, 0, 0.125f * L2E, O, m, l);
        o_store(O, 1.f / (l + __shfl_xor(l, 32)), yrow, h);
        o_zero(O); m = -1e30f; l = 0.f;
        attn_pass<64, 0>(lds, Qp + 64, 512, Kp + 64, 512, VTp, q0, 0, nt_c, 0, 0, 0.125f * L2E, O, m, l);
        const float* lq1 = a.in[7] + layer * 64; const float* lk1 = a.in[8] + layer * 64; const float* lq2 = a.in[9] + layer * 64; const float* lk2 = a.in[10] + layer * 64;
        const float lam_init = 0.8f - 0.6f * __expf(-0.3f * (float)layer);
        const float lam = __expf(wave_sum(lq1[lane] * lk1[lane])) - __expf(wave_sum(lq2[lane] * lk2[lane])) + lam_init;
        const float inv2 = lam / (l + __shfl_xor(l, 32)); float ss = 0.f;
#pragma unroll
        for (int d = 0; d < 4; ++d)
#pragma unroll
            for (int g = 0; g < 4; ++g) { const uint2 w = *(const uint2*)(yrow + 32 * d + 8 * g + 4 * h);
                const float a0 = __uint_as_float(w.x << 16) - O[d][4 * g] * inv2, a1 = __uint_as_float(w.x & 0xffff0000u) - O[d][4 * g + 1] * inv2;
                const float a2 = __uint_as_float(w.y << 16) - O[d][4 * g + 2] * inv2, a3 = __uint_as_float(w.y & 0xffff0000u) - O[d][4 * g + 3] * inv2;
                O[d][4 * g] = a0; O[d][4 * g + 1] = a1; O[d][4 * g + 2] = a2; O[d][4 * g + 3] = a3; ss += (a0 * a0 + a1 * a1) + (a2 * a2 + a3 * a3); }
        ss += __shfl_xor(ss, 32);
        const float rn = rsqrtf(ss * (1.f / 128) + EPS) * (1.f - lam_init);
        const float* gain = a.in[11] + layer * 128;
#pragma unroll
        for (int d = 0; d < 4; ++d)
#pragma unroll
            for (int g = 0; g < 4; ++g) { const f32x4 gv = *(const f32x4*)(gain + 32 * d + 8 * g + 4 * h);
                const f32x4 v = {O[d][4 * g] * rn * gv[0], O[d][4 * g + 1] * rn * gv[1], O[d][4 * g + 2] * rn * gv[2], O[d][4 * g + 3] * rn * gv[3]}; store4(yrow + 32 * d + 8 * g + 4 * h, v); }
    } else if (TYPE == 1) {
        const bf16* Qp = (const bf16*)(ws + WS_QB) + (size_t)(tok0 + q0) * 768 + hd * 192; const bf16* Kp = (const bf16*)(ws + WS_KB) + (size_t)tok0 * 768 + hd * 192;
        const bf16* VTp = (const bf16*)(ws + WS_VTB) + (size_t)(hd * 128) * VTP + tok0;
        o_zero(O); m = -1e30f; l = 0.f;
        attn_pass<192, 0>(lds, Qp, 768, Kp, 768, VTp, q0, 0, nt_c, 0, 0, 0.07216878364870323f * L2E, O, m, l);
        o_store(O, 1.f / (l + __shfl_xor(l, 32)), yrow, h);
    } else if (TYPE == 2) {
        o_zero(O); m = -1e30f; l = 0.f;
#pragma unroll 1
        for (int g = 0; g < 3; ++g) { const int hc = g * 4 + hd, win = g == 0 ? 128 : (g == 1 ? 512 : 2048), dm = g == 0 ? 0 : (g == 1 ? 3 : 15);
            const bf16* Qp = (const bf16*)(ws + WS_QC) + (size_t)(tok0 + q0) * 1536 + hc * 128; const bf16* Kp = (const bf16*)(ws + WS_KC) + (size_t)tok0 * 1536 + hc * 128;
            const bf16* VTp = (const bf16*)(ws + WS_VT) + (size_t)(512 + hc * 128) * VTP + tok0;
            const int lo = q0 - win > 0 ? (q0 - win) / 64 : 0;
            attn_pass<128, 1>(lds, Qp, 1536, Kp, 1536, VTp, q0, lo, nt_c, win, dm, 0.08838834764831845f * L2E, O, m, l); }
        o_store(O, 1.f / (l + __shfl_xor(l, 32)), yrow, h);
    } else {
        const bf16* Qp = (const bf16*)(ws + WS_QD) + (size_t)(tok0 + q0) * 512 + hd * 128; const bf16* Kp = (const bf16*)(ws + WS_KD) + (size_t)tok0 * 512 + hd * 128;
        const bf16* VTp = (const bf16*)(ws + WS_VT) + (size_t)(2048 + hd * 128) * VTP + tok0;
        o_zero(O); m = 0.f; l = 0.f;
        attn_pass<128, 2>(lds, Qp, 512, Kp, 512, VTp, q0, 0, nt_c, 0, 0, 0.08838834764831845f * L2E, O, m, l);
        o_store(O, 1.f, yrow, h);
    }
}
__device__ __forceinline__ void phase_attn(const FArgs& a, LAS unsigned char* lds, int layer) {
    const int x = bid_() & 7;
    unsigned* qctr = (unsigned*)(a.ws + WS_CTL) + 2048 + 512 * layer + 64 * x;
    volatile LAS int* slot = (volatile LAS int*)(lds + MISC_OFF + 64);
#pragma unroll 1
    for (;;) {
        if (threadIdx.x == 0) *slot = (int)atomicAdd(qctr, 1u);
        __syncthreads();
        const int v = __builtin_amdgcn_readfirstlane(*slot);
        __syncthreads();
        if (v >= 64) break;
        int qb, ty, bh;
        if (v < 48) { const int qi = v / 6, rem = v - 6 * qi; qb = 7 - qi; bh = x + 8 * (rem & 1); const int t3 = rem >> 1; ty = t3 == 0 ? 1 : (t3 == 1 ? 0 : 2); }
        else { const int d = v - 48; qb = 7 - (d >> 1); bh = x + 8 * (d & 1); ty = 3; }
        const int b = bh >> 2, hd = bh & 3, u = v * 8 + x;
        const int N = layer == 0 ? CONV_N0 : CONV_N1, clo = (int)(((long)u * N) >> 9) & ~31, chi = (int)(((long)(u + 1) * N) >> 9) & ~31;
        if (v & 1) { conv_chunk(a, lds, layer, clo, chi); __syncthreads(); }
        if (ty == 0) attn_unit<2>(a, lds, layer, b, hd, qb);
        else if (ty == 1) attn_unit<0>(a, lds, layer, b, hd, qb);
        else if (ty == 2) attn_unit<1>(a, lds, layer, b, hd, qb);
        else attn_unit<3>(a, lds, layer, b, hd, qb);
        if (!(v & 1)) { __syncthreads(); conv_chunk(a, lds, layer, clo, chi); }
    }
}
PHASE_KERNEL(kf_attn, phase_attn(a, lds, a.layer))

typedef unsigned gu32_t;
constexpr int CW_BAR = 4096;
#define XB_TMO      128
#define XB_XCNT(j)  (256  + 64 * (j))
#define XB_XSUB(j)  (1280 + 64 * (j))
#define XB_XGEN(j)  (2304 + 64 * (j))
#define XB_TOP      3328
#define XB_TOPGEN   3392
#define XCD_BAR_WORDS 3456
#define XB_SPIN_CAP (1u << 18)

__device__ __forceinline__ unsigned xb_ld(unsigned* p)              { return __hip_atomic_load(p, __ATOMIC_RELAXED, __HIP_MEMORY_SCOPE_AGENT); }
__device__ __forceinline__ unsigned xb_add(unsigned* p, unsigned v) { return __hip_atomic_fetch_add(p, v, __ATOMIC_RELAXED, __HIP_MEMORY_SCOPE_AGENT); }
__device__ __forceinline__ unsigned xb_xcc_id() { return (unsigned)__builtin_amdgcn_s_getreg((3 << 11) | 20) & 0xFu; }
#define XB_SPIN(cond, bar) do { unsigned _sp = 0; while (cond) { __builtin_amdgcn_s_sleep(1); \
    if ((++_sp & 255u) == 0u) { if (xb_ld(&(bar)[XB_TMO])) break; if (_sp > XB_SPIN_CAP) { atomicAdd(&(bar)[XB_TMO], 1u); break; } } } } while (0)

struct XcdBarrier {
    unsigned* bar; unsigned x;
    volatile LAS unsigned* st;
};

__device__ __forceinline__ XcdBarrier xcd_barrier_post(unsigned* bar, volatile LAS unsigned* st) {
    XcdBarrier b; b.bar = bar; b.x = xb_xcc_id(); b.st = st;
    if (threadIdx.x == 0) (void)xb_add(&bar[XB_XCNT(b.x)], 1u);
    return b;
}
__device__ __forceinline__ void xcd_barrier_complete(unsigned* bar, unsigned x, unsigned& nloc, unsigned& nx) {
    const unsigned G = gridDim.x * gridDim.y * gridDim.z;
    unsigned sum, cnt, mine, sp = 0u;
    for (;;) {
        sum = 0u; cnt = 0u; mine = 0u;
#pragma unroll
        for (unsigned j = 0; j < 16; ++j) { const unsigned c = xb_ld(&bar[XB_XCNT(j)]); sum += c; cnt += (c > 0u) ? 1u : 0u; mine = (j == x) ? c : mine; }
        if (sum == G) break;
        __builtin_amdgcn_s_sleep(1);
        if ((++sp & 255u) == 0u) { if (xb_ld(&bar[XB_TMO])) break; if (sp > XB_SPIN_CAP) { atomicAdd(&bar[XB_TMO], 1u); break; } }
    }
    nloc = mine > 0u ? mine : 1u; nx = cnt > 0u ? cnt : 1u;
}

__device__ __forceinline__ void xcd_barrier(const XcdBarrier& b) {
    asm volatile("s_waitcnt vmcnt(0)" ::: "memory");
    __syncthreads();
    if (threadIdx.x == 0) {
        unsigned* bar = b.bar;
        __builtin_amdgcn_s_waitcnt(0);
        unsigned nloc = b.st[0], nx = b.st[1];
        if (nloc == 0u) { xcd_barrier_complete(bar, b.x, nloc, nx); b.st[0] = nloc; b.st[1] = nx; }
        const unsigned old = xb_add(&bar[XB_XSUB(b.x)], 1u);
        const unsigned gen = old / nloc;
        if (old + 1u == (gen + 1u) * nloc) {
            __builtin_amdgcn_fence(__ATOMIC_RELEASE, "agent");
            asm volatile("s_waitcnt vmcnt(0)" ::: "memory");
            const unsigned og = xb_add(&bar[XB_TOP], 1u);
            const unsigned tg = og / nx;
            if (og + 1u == (tg + 1u) * nx) xb_add(&bar[XB_TOPGEN], 1u);
            else XB_SPIN(xb_ld(&bar[XB_TOPGEN]) == tg, bar);
            __builtin_amdgcn_fence(__ATOMIC_ACQUIRE, "agent");
            xb_add(&bar[XB_XGEN(b.x)], 1u);
            asm volatile("s_waitcnt vmcnt(0)" ::: "memory");
        } else {
            XB_SPIN(xb_ld(&bar[XB_XGEN(b.x)]) == gen, bar);
            __builtin_amdgcn_fence(__ATOMIC_ACQUIRE, "agent");
            asm volatile("s_waitcnt vmcnt(0)" ::: "memory");
        }
    }
    __syncthreads();
}

__device__ __forceinline__ void phase_norm(const float* __restrict__ X, const float* __restrict__ gain, bf16* __restrict__ H, unsigned char* __restrict__ H8 = nullptr) {
    int tid = threadIdx.x; asm volatile("" : "+v"(tid));
    const int lane = tid & 63, gw = blockIdx.x * NWAVES + (tid >> 6), NGW = gridDim.x * NWAVES;
    for (int row = gw; row < T; row += NGW) {
        const f32x4* xr = (const f32x4*)(X + (size_t)row * DM);
        f32x4 v[8]; float s = 0.f;
#pragma unroll
        for (int j = 0; j < 8; ++j) { v[j] = xr[lane + 64 * j]; s += v[j].x * v[j].x + v[j].y * v[j].y + v[j].z * v[j].z + v[j].w * v[j].w; }
        const float r = rsqrtf(wave_sum(s) * (1.f / DM) + EPS);
#pragma unroll
        for (int j = 0; j < 8; ++j) { const f32x4 g = ((const f32x4*)gain)[lane + 64 * j];
            const float y0 = v[j].x * r * g.x, y1 = v[j].y * r * g.y, y2 = v[j].z * r * g.z, y3 = v[j].w * r * g.w;
            uint2 o = {pg8::cvt_pk_bf16(y0, y1), pg8::cvt_pk_bf16(y2, y3)}; ((uint2*)(H + (size_t)row * DM))[lane + 64 * j] = o;
            if (H8) ((unsigned*)(H8 + (size_t)row * DM))[lane + 64 * j] = pk4_fp8(4.f * y0, 4.f * y1, 4.f * y2, 4.f * y3); }
    }
}
__device__ __forceinline__ void phase_router(const float* __restrict__ X, const float* __restrict__ gain, const float* __restrict__ Wr, int* cnt, int* route, bf16* HS) {
    int tid = threadIdx.x; asm volatile("" : "+v"(tid));
    const int lane = tid & 63, gw = blockIdx.x * NWAVES + (tid >> 6), NGW = gridDim.x * NWAVES;
    for (int t = gw; t < T; t += NGW) {
        const f32x4* xr = (const f32x4*)(X + (size_t)t * DM); const f32x4* gr = (const f32x4*)gain;
        float s = 0.f;
#pragma unroll
        for (int j = 0; j < 8; ++j) { const f32x4 v = xr[lane + 64 * j]; s += v.x * v.x + v.y * v.y + v.z * v.z + v.w * v.w; }
        const float r = rsqrtf(wave_sum(s) * (1.f / DM) + EPS);
        float lg[8];
#pragma unroll
        for (int e = 0; e < 8; ++e) lg[e] = 0.f;
#pragma unroll 2
        for (int j = 0; j < 8; ++j) { const f32x4 x = xr[lane + 64 * j], g = gr[lane + 64 * j]; const float hv[4] = {x.x * r * g.x, x.y * r * g.y, x.z * r * g.z, x.w * r * g.w};
            const f32x4* w = (const f32x4*)(Wr + (size_t)(4 * (lane + 64 * j)) * 8);
#pragma unroll
            for (int q = 0; q < 4; ++q) { const f32x4 w0 = w[2 * q], w1 = w[2 * q + 1];
                lg[0] += hv[q] * w0[0]; lg[1] += hv[q] * w0[1]; lg[2] += hv[q] * w0[2]; lg[3] += hv[q] * w0[3]; lg[4] += hv[q] * w1[0]; lg[5] += hv[q] * w1[1]; lg[6] += hv[q] * w1[2]; lg[7] += hv[q] * w1[3]; } }
#pragma unroll
        for (int e = 0; e < 8; ++e) lg[e] = wave_sum(lg[e]);
        int e1 = 0; float b1 = lg[0];
#pragma unroll
        for (int e = 1; e < 8; ++e) if (lg[e] > b1) { b1 = lg[e]; e1 = e; }
        int e2 = -1; float b2 = -__builtin_inff();
#pragma unroll
        for (int e = 0; e < 8; ++e) if (e != e1 && lg[e] > b2) { b2 = lg[e]; e2 = e; }
        float g2 = __expf(b2 - b1); const float g1 = 1.f / (1.f + g2); g2 = g2 * g1;
        int s1 = 0, s2 = 0;
        if (lane == 0) { s1 = atomicAdd(cnt + e1, 1); s2 = atomicAdd(cnt + e2, 1);
            int* ro = route + (size_t)t * 8; ro[0] = e1; ro[1] = s1; ro[2] = __float_as_int(g1); ro[3] = e2; ro[4] = s2; ro[5] = __float_as_int(g2); }
        s1 = __shfl(s1, 0); s2 = __shfl(s2, 0);
        unsigned* o1 = (unsigned*)((unsigned char*)HS + ((size_t)e1 * ECAP + s1) * DM); unsigned* o2 = (unsigned*)((unsigned char*)HS + ((size_t)e2 * ECAP + s2) * DM);
#pragma unroll 2
        for (int j = 0; j < 8; ++j) { const f32x4 x = xr[lane + 64 * j], g = gr[lane + 64 * j];
            const float r4 = 4.f * r; const unsigned o = pk4_fp8(x.x * r4 * g.x, x.y * r4 * g.y, x.z * r4 * g.z, x.w * r4 * g.w); o1[lane + 64 * j] = o; o2[lane + 64 * j] = o; }
    }
}
__device__ __forceinline__ void phase_combine_final(const float* __restrict__ X, const int* __restrict__ route, const bf16* __restrict__ OUTS, const float* __restrict__ gain, float* __restrict__ out) {
    int tid = threadIdx.x; asm volatile("" : "+v"(tid));
    const int lane = tid & 63, gw = blockIdx.x * NWAVES + (tid >> 6), NGW = gridDim.x * NWAVES;
    for (int t = gw; t < T; t += NGW) {
        const int* ro = route + (size_t)t * 8; const int e1 = ro[0], s1 = ro[1], e2 = ro[3], s2 = ro[4]; const float g1 = __int_as_float(ro[2]), g2 = __int_as_float(ro[5]);
        const uint2* pa = (const uint2*)(OUTS + ((size_t)e1 * ECAP + s1) * DM); const uint2* pb = (const uint2*)(OUTS + ((size_t)e2 * ECAP + s2) * DM);
        const f32x4* xr = (const f32x4*)(X + (size_t)t * DM);
        f32x4 v[8]; float s = 0.f;
#pragma unroll
        for (int j = 0; j < 8; ++j) { const f32x4 x = xr[lane + 64 * j]; const uint2 wa = pa[lane + 64 * j], wb = pb[lane + 64 * j];
            v[j].x = x.x + g1 * __uint_as_float(wa.x << 16) + g2 * __uint_as_float(wb.x << 16); v[j].y = x.y + g1 * __uint_as_float(wa.x & 0xffff0000u) + g2 * __uint_as_float(wb.x & 0xffff0000u);
            v[j].z = x.z + g1 * __uint_as_float(wa.y << 16) + g2 * __uint_as_float(wb.y << 16); v[j].w = x.w + g1 * __uint_as_float(wa.y & 0xffff0000u) + g2 * __uint_as_float(wb.y & 0xffff0000u);
            s += v[j].x * v[j].x + v[j].y * v[j].y + v[j].z * v[j].z + v[j].w * v[j].w; }
        const float r = rsqrtf(wave_sum(s) * (1.f / DM) + EPS);
#pragma unroll
        for (int j = 0; j < 8; ++j) { const f32x4 g = ((const f32x4*)gain)[lane + 64 * j]; const f32x4 y = {v[j].x * r * g.x, v[j].y * r * g.y, v[j].z * r * g.z, v[j].w * r * g.w};
            ((f32x4*)(out + (size_t)t * DM))[lane + 64 * j] = y; }
    }
}

__global__ void __launch_bounds__(NTHR, 2) mega_fwd(FArgs a) {
    extern __shared__ __attribute__((aligned(16))) unsigned char lds_raw[];
    LAS unsigned char* lds = (LAS unsigned char*)lds_raw;
    for (int u = threadIdx.x; u < (LDS_BYTES - RING_BYTES) / 4; u += NTHR) ((LAS unsigned*)(lds + RING_BYTES))[u] = 0u;
    __syncthreads();
    volatile LAS unsigned* MISC = (volatile LAS unsigned*)(lds + MISC_OFF);
    unsigned char* ws = a.ws;
    (void)xcd_barrier_post((unsigned*)(ws + WS_CTL) + CW_BAR, MISC + 8);
#define GRID_BAR() do { XcdBarrier bb_; unsigned* bp_ = (unsigned*)(a.ws + WS_CTL) + CW_BAR; asm volatile("" : "+s"(bp_));   \
    bb_.bar = bp_; bb_.x = xb_xcc_id(); bb_.st = (volatile LAS unsigned*)(lds + MISC_OFF) + 8; xcd_barrier(bb_); } while (0)
    float* XA = (float*)(ws + WS_XA); bf16* H = (bf16*)(ws + WS_H);
    phase_convert(a, lds);
    phase_norm(a.in[0], a.in[1], H, ws + WS_ACT);
    GRID_BAR();
#pragma unroll 1
    for (int layer = 0; layer < DEPTH; ++layer) {
        phase_inproj(a, lds, layer);   GRID_BAR();
        phase_mlaup(a, lds, layer);    GRID_BAR();
        phase_attn(a, lds, layer);     GRID_BAR();
        phase_branch(a, lds, layer);   GRID_BAR();
        phase_outproj(a, lds, layer);  GRID_BAR();
        if (layer == 0) {
            phase_norm(XA, a.in[14], H);            GRID_BAR();
            phase_ffn_in(a, lds);                   GRID_BAR();
            phase_ffn_out(a, lds);                  GRID_BAR();
            phase_norm(XA, a.in[1] + DM, H, ws + WS_ACT);        GRID_BAR();
        } else {
            phase_router(XA, a.in[14] + DM, a.in[17], (int*)(ws + WS_CTL + CTL_CNT), (int*)(ws + WS_ROUTE), (bf16*)(ws + WS_HS));  GRID_BAR();
            phase_moe_in(a, lds);                   GRID_BAR();
            phase_moe_out(a, lds);                  GRID_BAR();
            phase_combine_final(XA, (const int*)(ws + WS_ROUTE), (const bf16*)(ws + WS_OUTS), a.in[20], a.out);
        }
    }
}
__global__ __launch_bounds__(256) void k_vt_to_vn(unsigned char* ws) {
    const bf16* VT = (const bf16*)(ws + WS_VT); const bf16* VTB = (const bf16*)(ws + WS_VTB); bf16* VN = (bf16*)(ws + WS_VN);
    const int t = blockIdx.x;
    for (int c = threadIdx.x; c < 3072; c += 256) { bf16 v;
        if (c < 512) v = VT[(size_t)c * VTP + t]; else if (c < 1024) v = VTB[(size_t)(c - 512) * VTP + t]; else v = VT[(size_t)(c - 512) * VTP + t];
        VN[(size_t)t * VN_LD + c] = v; }
}


__global__ __launch_bounds__(256) void k_diag(const unsigned char* ws, const unsigned char* ref, float* sums) {
    const size_t seg_lo[9] = {WS_QA, WS_KA, WS_QB, WS_KB, WS_QC, WS_KC, WS_QD, WS_VT, WS_G};
    const size_t seg_hi[9] = {WS_KA, WS_QB, WS_KB, WS_QC, WS_KC, WS_QD, WS_VT, WS_CQ, WS_Y};
    for (int sgi = 0; sgi < 9; ++sgi) {
        size_t lo, hi;
        switch (sgi) { case 0: lo = WS_QA; hi = WS_KA; break; case 1: lo = WS_KA; hi = WS_QB; break; case 2: lo = WS_QB; hi = WS_KB; break; case 3: lo = WS_KB; hi = WS_QC; break;
            case 4: lo = WS_QC; hi = WS_KC; break; case 5: lo = WS_KC; hi = WS_QD; break; case 6: lo = WS_QD; hi = WS_VT; break; case 7: lo = WS_VT; hi = WS_CQ; break; default: lo = WS_G; hi = WS_Y; break; }
        const bf16* a = (const bf16*)(ws + lo); const bf16* b = (const bf16*)(ref + (lo - WS_QA)); const size_t n = (hi - lo) / 2;
        float d2 = 0.f, r2 = 0.f;
        for (size_t i = (size_t)blockIdx.x * 256 + threadIdx.x; i < n; i += (size_t)gridDim.x * 256) { float x = bf2f(a[i]), y = bf2f(b[i]); d2 += (x - y) * (x - y); r2 += y * y; }
        d2 = wave_sum(d2); r2 = wave_sum(r2);
        if ((threadIdx.x & 63) == 0) { atomicAdd(sums + 2 * sgi, d2); atomicAdd(sums + 2 * sgi + 1, r2); }
    }
    (void)seg_lo; (void)seg_hi;
}
__global__ __launch_bounds__(256) void k_diag_out(const float* sums, float* out, int n) {
    int first = 0, count = 0;
    for (int sgi = 0; sgi < 9; ++sgi) { float d2 = sums[2 * sgi], r2 = sums[2 * sgi + 1]; bool bad = !(d2 <= 1e-3f * r2); if (bad) { ++count; if (!first) first = sgi + 1; } }
    float rel = sqrtf(sums[16] / sums[17]); const float c = sqrtf(fminf(98.f, rintf(100.f * rel))); (void)first; (void)count;
    for (int i = blockIdx.x * 256 + threadIdx.x; i < n; i += gridDim.x * 256) out[i] = c;
}
#ifndef F_IN
#define F_IN 1
#endif
#ifndef F_ATT
#define F_ATT 15
#endif
#ifndef F_BR
#define F_BR 1
#endif
#ifndef F_OUT
#define F_OUT 1
#endif
#ifndef F_FFN
#define F_FFN 1
#endif
#ifndef F_MOE
#define F_MOE 1
#endif
template <class KT> static void launch_phase(KT k, const FArgs& a, int layer, hipStream_t stream) { FArgs b = a; b.layer = layer; hipLaunchKernelGGL(k, dim3(256), dim3(NTHR), LDS_BYTES, stream, b); }
extern "C" void kernel_launch(void* const* d_in, const int* in_sizes, int n_in, void* d_out, int out_size, void* d_ws, size_t ws_size, hipStream_t stream) {
    if (n_in != 21 || ws_size < WS_END) { fprintf(stderr, "kernel_launch: bad args n_in %d ws %zu need %zu\n", n_in, ws_size, (size_t)WS_END); return; }
    static bool inited = false;
#ifdef MK_MULTI
    if (!inited) { inited = true;
        (void)hipFuncSetAttribute((const void*)kf_convert, hipFuncAttributeMaxDynamicSharedMemorySize, LDS_BYTES);
        (void)hipFuncSetAttribute((const void*)kf_inproj, hipFuncAttributeMaxDynamicSharedMemorySize, LDS_BYTES);
        (void)hipFuncSetAttribute((const void*)kf_mlaup, hipFuncAttributeMaxDynamicSharedMemorySize, LDS_BYTES);
        (void)hipFuncSetAttribute((const void*)kf_branch, hipFuncAttributeMaxDynamicSharedMemorySize, LDS_BYTES);
        (void)hipFuncSetAttribute((const void*)kf_outproj, hipFuncAttributeMaxDynamicSharedMemorySize, LDS_BYTES);
        (void)hipFuncSetAttribute((const void*)kf_ffn_in, hipFuncAttributeMaxDynamicSharedMemorySize, LDS_BYTES);
        (void)hipFuncSetAttribute((const void*)kf_ffn_out, hipFuncAttributeMaxDynamicSharedMemorySize, LDS_BYTES);
        (void)hipFuncSetAttribute((const void*)kf_moe_in, hipFuncAttributeMaxDynamicSharedMemorySize, LDS_BYTES);
        (void)hipFuncSetAttribute((const void*)kf_moe_out, hipFuncAttributeMaxDynamicSharedMemorySize, LDS_BYTES);
        (void)hipFuncSetAttribute((const void*)kf_attn, hipFuncAttributeMaxDynamicSharedMemorySize, LDS_BYTES);
    }
#endif
    const float* x = (const float*)d_in[0]; const float* norm_mix = (const float*)d_in[1]; const float* w_in = (const float*)d_in[2];
    const float* dq_norm = (const float*)d_in[3]; const float* dkv_norm = (const float*)d_in[4]; const float* w_uq = (const float*)d_in[5]; const float* w_ukv = (const float*)d_in[6];
    const float* lam_q1 = (const float*)d_in[7]; const float* lam_k1 = (const float*)d_in[8]; const float* lam_q2 = (const float*)d_in[9]; const float* lam_k2 = (const float*)d_in[10];
    const float* diff_norm = (const float*)d_in[11]; const float* w_branch = (const float*)d_in[12]; const float* w_out = (const float*)d_in[13]; const float* norm_ffn = (const float*)d_in[14];
    const float* w_dense_in = (const float*)d_in[15]; const float* w_dense_out = (const float*)d_in[16]; const float* w_router = (const float*)d_in[17];
    const float* w_moe_in = (const float*)d_in[18]; const float* w_moe_out = (const float*)d_in[19]; const float* norm_final = (const float*)d_in[20];
    unsigned char* ws = (unsigned char*)d_ws;
    (void)hipMemsetAsync(ws + WS_CTL, 0, CTL_BYTES, stream);
    FArgs fa{}; for (int i = 0; i < 21; ++i) fa.in[i] = (const float*)d_in[i]; fa.out = (float*)d_out; fa.ws = ws; fa.layer = 0; fa.pad = F_ATT;
    float* XA = (float*)(ws + WS_XA); bf16* H = (bf16*)(ws + WS_H); float* PROJ = (float*)(ws + WS_PROJ);
    bf16* CQ = (bf16*)(ws + WS_CQ); bf16* CKV = (bf16*)(ws + WS_CKV); bf16* G = (bf16*)(ws + WS_G); bf16* Y = (bf16*)(ws + WS_Y);
    float* MG = (float*)(ws + WS_MG); bf16* MGB = (bf16*)(ws + WS_MGB); bf16* ACT = (bf16*)(ws + WS_ACT);
    int* cnt = (int*)(ws + WS_CTL + CTL_CNT); int* route = (int*)(ws + WS_ROUTE); bf16* HS = (bf16*)(ws + WS_HS); bf16* ACTS = (bf16*)(ws + WS_ACTS); bf16* OUTS = (bf16*)(ws + WS_OUTS);
#ifndef MK_MULTI
    {   static int ok = 0;
        if (!ok) { ok = 1; if (hipFuncSetAttribute((const void*)mega_fwd, hipFuncAttributeMaxDynamicSharedMemorySize, LDS_BYTES) != hipSuccess) { fprintf(stderr, "kernel_launch: hipFuncSetAttribute failed\n"); ok = -1; }
            int dev = 0, cus = 0, per_cu = 0; (void)hipGetDevice(&dev); (void)hipDeviceGetAttribute(&cus, hipDeviceAttributeMultiprocessorCount, dev);
            (void)hipOccupancyMaxActiveBlocksPerMultiprocessor(&per_cu, (const void*)mega_fwd, NTHR, LDS_BYTES);
            if (cus != 256 || per_cu < 1) { fprintf(stderr, "kernel_launch: needs 256 CUs with one resident workgroup each (cus %d, per_cu %d)\n", cus, per_cu); }
            (void)hipGetLastError(); }
        hipLaunchKernelGGL(mega_fwd, dim3(256), dim3(NTHR), LDS_BYTES, stream, fa);
        return;
    }
#else
    launch_phase(kf_convert, fa, 0, stream);
#if defined(DIAG_IN)
    {   const int layer = 0;
        k_rope_tab<<<(2048 * 56 + 255) / 256, 256, 0, stream>>>((float2*)(ws + ROPE_A), (float2*)(ws + ROPE_C), (float2*)(ws + ROPE_M));
        k_rmsnorm<false><<<T / 4, 256, 0, stream>>>(x, norm_mix + layer * DM, H);
        k_gemm<EpiStoreF32, false><<<dim3((IN_COLS + 127) / 128, T / 128, 1), 256, 0, stream>>>(H, DM, 0, w_in + (size_t)layer * DM * IN_COLS, IN_COLS, 0, IN_COLS, DM, 0, nullptr, EpiStoreF32{PROJ, IN_COLS, 0});
        k_prep<<<T, 256, 0, stream>>>(PROJ, ws);
        k_mla_norm<<<T * 2 / 4, 256, 0, stream>>>(PROJ, dq_norm + layer * 512, dkv_norm + layer * 512, CQ, CKV);
        k_gemm<EpiStoreF32, false><<<dim3(768 / 128, T / 128, 1), 256, 0, stream>>>(CQ, 512, 0, w_uq + (size_t)layer * 512 * 768, 768, 0, 768, 512, 0, nullptr, EpiStoreF32{(float*)(ws + WS_QBRAW), 768, 0});
        k_gemm<EpiStoreF32, false><<<dim3(1024 / 128, T / 128, 1), 256, 0, stream>>>(CKV, 512, 0, w_ukv + (size_t)layer * 512 * 1024, 1024, 0, 1024, 512, 0, nullptr, EpiStoreF32{(float*)(ws + WS_KVRAW), 1024, 0});
        k_mla_prep<<<T, 256, 0, stream>>>(ws);
        (void)hipMemcpyAsync(ws + WS_ACTS, ws + WS_QA, WS_Y - WS_QA, hipMemcpyDeviceToDevice, stream);
        (void)hipMemsetAsync(ws + WS_QA, 0x55, WS_Y - WS_QA, stream);
        launch_phase(kf_inproj, fa, layer, stream);
        launch_phase(kf_mlaup, fa, layer, stream);
        k_diag<<<1024, 256, 0, stream>>>(ws, ws + WS_ACTS, (float*)(ws + WS_CTL + 8192));
        k_diag_out<<<1024, 256, 0, stream>>>((const float*)(ws + WS_CTL + 8192), (float*)d_out, out_size);
        return;
    }
#endif
    for (int layer = 0; layer < DEPTH; ++layer) {
        const float* Xin = layer == 0 ? x : XA;
        k_rmsnorm<false><<<T / 4, 256, 0, stream>>>(Xin, norm_mix + layer * DM, H);
        if (F_IN) {
            launch_phase(kf_inproj, fa, layer, stream);
            launch_phase(kf_mlaup, fa, layer, stream);
            k_vt_to_vn<<<T, 256, 0, stream>>>(ws);
        } else {
            k_gemm<EpiStoreF32, false><<<dim3((IN_COLS + 127) / 128, T / 128, 1), 256, 0, stream>>>(H, DM, 0, w_in + (size_t)layer * DM * IN_COLS, IN_COLS, 0, IN_COLS, DM, 0, nullptr, EpiStoreF32{PROJ, IN_COLS, 0});
            k_prep<<<T, 256, 0, stream>>>(PROJ, ws);
            k_mla_norm<<<T * 2 / 4, 256, 0, stream>>>(PROJ, dq_norm + layer * 512, dkv_norm + layer * 512, CQ, CKV);
            k_gemm<EpiStoreF32, false><<<dim3(768 / 128, T / 128, 1), 256, 0, stream>>>(CQ, 512, 0, w_uq + (size_t)layer * 512 * 768, 768, 0, 768, 512, 0, nullptr, EpiStoreF32{(float*)(ws + WS_QBRAW), 768, 0});
            k_gemm<EpiStoreF32, false><<<dim3(1024 / 128, T / 128, 1), 256, 0, stream>>>(CKV, 512, 0, w_ukv + (size_t)layer * 512 * 1024, 1024, 0, 1024, 512, 0, nullptr, EpiStoreF32{(float*)(ws + WS_KVRAW), 1024, 0});
            k_mla_prep<<<T, 256, 0, stream>>>(ws);
        }
        if (F_ATT) launch_phase(kf_attn, fa, layer, stream);
        {
        float lam_init = 0.8f - 0.6f * expf(-0.3f * (float)layer);
        if (!(F_ATT & 1)) k_attn_simple<0><<<T, 256, 0, stream>>>(ws, lam_q1 + layer * 64, lam_k1 + layer * 64, lam_q2 + layer * 64, lam_k2 + layer * 64, diff_norm + layer * 128, lam_init);
        if (!(F_ATT & 2)) k_attn_simple<1><<<T, 256, 0, stream>>>(ws, nullptr, nullptr, nullptr, nullptr, nullptr, 0.f);
        if (!(F_ATT & 4)) k_attn_simple<2><<<T, 256, 0, stream>>>(ws, nullptr, nullptr, nullptr, nullptr, nullptr, 0.f);
        if (!(F_ATT & 8)) k_attn_simple<3><<<T, 256, 0, stream>>>(ws, nullptr, nullptr, nullptr, nullptr, nullptr, 0.f);
        }
        if (F_BR) launch_phase(kf_branch, fa, layer, stream);
        else for (int i = 0; i < 4; ++i)
            k_gemm<EpiBranch, false><<<dim3(DM / 128, T / 128, 1), 256, 0, stream>>>(Y + (size_t)i * T * 512, 512, 0, w_branch + ((size_t)layer * 4 + i) * 512 * DM, DM, 0, DM, 512, 0, nullptr, EpiBranch{G, MG, MGB, i, 0});
        if (F_OUT) launch_phase(kf_outproj, fa, layer, stream);
        else k_gemm<EpiResid, false><<<dim3(DM / 128, T / 128, 1), 256, 0, stream>>>(MGB, DM, 0, w_out + (size_t)layer * DM * DM, DM, 0, DM, DM, 0, nullptr, EpiResid{Xin, XA});
        if (layer % 2 == 0) {
            k_rmsnorm<false><<<T / 4, 256, 0, stream>>>(XA, norm_ffn + layer * DM, H);
            if (F_FFN) { launch_phase(kf_ffn_in, fa, layer, stream); launch_phase(kf_ffn_out, fa, layer, stream); }
            else {
            k_gemm<EpiSwiglu, true><<<dim3(DFF / 128, T / 128, 1), 256, 0, stream>>>(H, DM, 0, w_dense_in + (size_t)(layer / 2) * DM * 2 * DFF, 2 * DFF, 0, DFF, DM, DFF, nullptr, EpiSwiglu{ACT, 0});
            k_gemm<EpiResid, false><<<dim3(DM / 128, T / 128, 1), 256, 0, stream>>>(ACT, DFF, 0, w_dense_out + (size_t)(layer / 2) * DFF * DM, DM, 0, DM, DFF, 0, nullptr, EpiResid{XA, XA});
            }
        } else {
            k_router<<<T / 4, 256, 0, stream>>>(XA, norm_ffn + layer * DM, w_router + (size_t)(layer / 2) * DM * NEXP, cnt, route, HS);
            if (F_MOE) { launch_phase(kf_moe_in, fa, layer, stream); launch_phase(kf_moe_out, fa, layer, stream); }
            else {
            k_gemm<EpiSwiglu, true><<<dim3(DFF / 128, ECAP / 128, NEXP), 256, 0, stream>>>(HS, DM, (size_t)ECAP * DM, w_moe_in + (size_t)(layer / 2) * NEXP * DM * 2 * DFF, 2 * DFF, (size_t)DM * 2 * DFF, DFF, DM, DFF, cnt, EpiSwiglu{ACTS, (size_t)ECAP * DFF});
            k_gemm<EpiStoreBf16Z, false><<<dim3(DM / 128, ECAP / 128, NEXP), 256, 0, stream>>>(ACTS, DFF, (size_t)ECAP * DFF, w_moe_out + (size_t)(layer / 2) * NEXP * DFF * DM, DM, (size_t)DFF * DM, DM, DFF, 0, cnt, EpiStoreBf16Z{OUTS, (size_t)ECAP * DM, DM, 0});
            }
            k_moe_combine<<<T, 256, 0, stream>>>(XA, route, OUTS);
        }
    }
    k_rmsnorm<true><<<T / 4, 256, 0, stream>>>(XA, norm_final, d_out);
#endif
}
```

```cpp
#include <hip/hip_runtime.h>
#include <cstdio>
#include <cstdint>

typedef unsigned short bf16;
typedef short bf16x8 __attribute__((ext_vector_type(8)));
typedef float f32x16 __attribute__((ext_vector_type(16)));
typedef float f32x4 __attribute__((ext_vector_type(4)));
typedef float f32x8v __attribute__((ext_vector_type(8)));
typedef float f32x2v __attribute__((ext_vector_type(2)));
typedef unsigned u32x4 __attribute__((ext_vector_type(4)));

constexpr int BATCH = 4, SEQ = 2048, T = BATCH * SEQ, DM = 2048, DEPTH = 2;
constexpr int IN_COLS = 16960;
constexpr int OFF_QA = 0, OFF_KA = 512, OFF_VA = 1024, OFF_CQ = 1536, OFF_CKV = 2048, OFF_KR = 2560;
constexpr int OFF_QC = 2624, OFF_KC = 4160, OFF_VC = 5696, OFF_QD = 7232, OFF_KD = 7744, OFF_VD = 8256, OFF_G = 8768;
constexpr int DFF = 5632, NEXP = 8, ECAP = 8192;
constexpr float EPS = 1e-6f;
constexpr int VTP = T + 64;
constexpr float ROPE_THETA = 500000.0f;

constexpr size_t MiB = 1u << 20;
constexpr size_t WS_CTL = 0;
constexpr size_t CTL_BYTES = 1 * MiB;
constexpr size_t CTL_CNT = 4096;
constexpr size_t CTL_RSQ = 512 * 1024;
constexpr size_t WS_ROPE = 1 * MiB;
constexpr size_t ROPE_A = WS_ROPE, ROPE_C = ROPE_A + 2048 * 8 * 8, ROPE_M = ROPE_C + 2048 * 16 * 8;
constexpr size_t WS_XA = 2 * MiB;
constexpr size_t WS_H = WS_XA + 64 * MiB;
constexpr size_t WS_QA = WS_H + 32 * MiB;
constexpr size_t WS_KA = WS_QA + 8 * MiB;
constexpr size_t WS_QB = WS_KA + 8 * MiB;
constexpr size_t WS_KB = WS_QB + 12 * MiB;
constexpr size_t WS_QC = WS_KB + 12 * MiB;
constexpr size_t WS_KC = WS_QC + 24 * MiB;
constexpr size_t WS_QD = WS_KC + 24 * MiB;
constexpr size_t WS_KD = WS_QD + 8 * MiB;
constexpr size_t WS_VT = WS_KD + 8 * MiB;
constexpr size_t WS_VTB = WS_VT + 41 * MiB;
constexpr size_t WS_CQ = WS_VTB + 9 * MiB;
constexpr size_t WS_CKV = WS_CQ + 8 * MiB;
constexpr size_t WS_G = WS_CKV + 8 * MiB;
constexpr size_t WS_Y = WS_G + 128 * MiB;
constexpr size_t WS_MG = WS_Y + 32 * MiB;
constexpr size_t WS_MGB = WS_MG + 64 * MiB;
constexpr size_t WS_ACT = WS_MGB + 32 * MiB;
constexpr size_t WS_ROUTE = WS_ACT + 88 * MiB;
constexpr size_t WS_HS = WS_ROUTE + 1 * MiB;
constexpr size_t WS_ACTS = WS_HS + 256 * MiB;
constexpr size_t WS_OUTS = WS_ACTS + 704 * MiB;
constexpr size_t WS_WT = WS_OUTS + 256 * MiB;
constexpr size_t WS_RSQP = WS_WT + 768 * MiB;
constexpr size_t WS_END = WS_RSQP + 2 * MiB;
constexpr size_t WS_PROJ = WS_ACTS;
constexpr size_t WS_VN = WS_HS;
constexpr size_t WS_QBRAW = WS_HS + 64 * MiB;
constexpr size_t WS_KVRAW = WS_HS + 96 * MiB;
constexpr int VN_LD = 3584;

__device__ __forceinline__ float bf2f(bf16 v) { return __uint_as_float((unsigned)v << 16); }
__device__ __forceinline__ bf16 f2bf(float f) { unsigned u = __float_as_uint(f); return (bf16)((u + 0x7fffu + ((u >> 16) & 1u)) >> 16); }
__device__ __forceinline__ unsigned pk2(float lo, float hi) { return (unsigned)f2bf(lo) | ((unsigned)f2bf(hi) << 16); }
__device__ __forceinline__ float wave_sum(float v) {
#pragma unroll
    for (int o = 1; o < 64; o <<= 1) v += __shfl_xor(v, o);
    return v;
}
__device__ __forceinline__ float wave_max(float v) {
#pragma unroll
    for (int o = 1; o < 64; o <<= 1) v = fmaxf(v, __shfl_xor(v, o));
    return v;
}
__device__ __forceinline__ int crow(int r, int hi) { return (r & 3) + 8 * (r >> 2) + 4 * hi; }

__global__ void k_rope_tab(float2* tabA, float2* tabC, float2* tabM) {
    int idx = blockIdx.x * blockDim.x + threadIdx.x;
    if (idx >= 2048 * 56) return;
    int pos = idx / 56, r = idx % 56;
    int half, i; float2* dst;
    if (r < 8) { half = 8; i = r; dst = tabA + pos * 8 + i; }
    else if (r < 24) { half = 16; i = r - 8; dst = tabC + pos * 16 + i; }
    else { half = 32; i = r - 24; dst = tabM + pos * 32 + i; }
    float e = -(float)(2 * i) / (float)(2 * half);
    float inv = exp2f(e * log2f(ROPE_THETA));
    float ang = (float)pos * inv;
    double rev = (double)ang * 0.15915494309189535;
    rev -= floor(rev);
    float rf = (float)rev;
    *dst = make_float2(__builtin_amdgcn_cosf(rf), __builtin_amdgcn_sinf(rf));
}

template <bool OUT_F32>
__global__ __launch_bounds__(256) void k_rmsnorm(const float* __restrict__ x, const float* __restrict__ gain, void* out) {
    int row = blockIdx.x * 4 + (threadIdx.x >> 6), lane = threadIdx.x & 63;
    const f32x4* xr = (const f32x4*)(x + (size_t)row * DM);
    f32x4 v[8]; float s = 0.f;
#pragma unroll
    for (int j = 0; j < 8; ++j) { v[j] = xr[lane + 64 * j]; s += v[j].x * v[j].x + v[j].y * v[j].y + v[j].z * v[j].z + v[j].w * v[j].w; }
    float r = rsqrtf(wave_sum(s) * (1.f / DM) + EPS);
#pragma unroll
    for (int j = 0; j < 8; ++j) {
        f32x4 g = ((const f32x4*)gain)[lane + 64 * j];
        f32x4 y = {v[j].x * r * g.x, v[j].y * r * g.y, v[j].z * r * g.z, v[j].w * r * g.w};
        if (OUT_F32) ((f32x4*)((float*)out + (size_t)row * DM))[lane + 64 * j] = y;
        else { uint2 o = {pk2(y.x, y.y), pk2(y.z, y.w)}; ((uint2*)((bf16*)out + (size_t)row * DM))[lane + 64 * j] = o; }
    }
}

template <class Epi, bool DUAL>
__global__ __launch_bounds__(256) void k_gemm(const bf16* __restrict__ A, int lda, size_t strideA, const float* __restrict__ W, int ldw, size_t strideW,
                                              int N, int K, int dualOff, const int* mcount, Epi epi) {
    const int z = blockIdx.z;
    A += (size_t)z * strideA; W += (size_t)z * strideW;
    if (mcount && (int)blockIdx.y * 128 >= mcount[z]) return;
    const int wave = threadIdx.x >> 6, lane = threadIdx.x & 63, wr = wave >> 1, wc = wave & 1;
    const int m0 = blockIdx.y * 128 + wr * 64, n0 = blockIdx.x * 128 + wc * 64;
    const int r = lane & 31, h = lane >> 5;
    f32x16 acc[2][2], acc2[2][2];
#pragma unroll
    for (int i = 0; i < 2; ++i)
#pragma unroll
        for (int j = 0; j < 2; ++j)
#pragma unroll
            for (int e = 0; e < 16; ++e) { acc[i][j][e] = 0.f; acc2[i][j][e] = 0.f; }
    int ncol[2]; ncol[0] = min(n0 + r, N - 1); ncol[1] = min(n0 + 32 + r, N - 1);
    for (int k0 = 0; k0 < K; k0 += 16) {
        bf16x8 a[2], b[2], b2[2];
#pragma unroll
        for (int i = 0; i < 2; ++i) a[i] = *(const bf16x8*)(A + (size_t)(m0 + 32 * i + r) * lda + k0 + 8 * h);
#pragma unroll
        for (int j = 0; j < 2; ++j) {
            const float* wp = W + (size_t)(k0 + 8 * h) * ldw + ncol[j];
#pragma unroll
            for (int e = 0; e < 8; ++e) { b[j][e] = (short)f2bf(wp[(size_t)e * ldw]); if (DUAL) b2[j][e] = (short)f2bf(wp[(size_t)e * ldw + dualOff]); }
        }
#pragma unroll
        for (int i = 0; i < 2; ++i)
#pragma unroll
            for (int j = 0; j < 2; ++j) {
                acc[i][j] = __builtin_amdgcn_mfma_f32_32x32x16_bf16(a[i], b[j], acc[i][j], 0, 0, 0);
                if (DUAL) acc2[i][j] = __builtin_amdgcn_mfma_f32_32x32x16_bf16(a[i], b2[j], acc2[i][j], 0, 0, 0);
            }
    }
#pragma unroll
    for (int i = 0; i < 2; ++i)
#pragma unroll
        for (int j = 0; j < 2; ++j)
#pragma unroll
            for (int e = 0; e < 16; ++e) {
                int row = m0 + 32 * i + crow(e, h), col = n0 + 32 * j + r;
                if (col < N) epi(z, row, col, acc[i][j][e], acc2[i][j][e]);
            }
}

struct EpiStoreF32 { float* O; int ldo; int pad; __device__ void operator()(int, int row, int col, float v, float) const { O[(size_t)row * ldo + col] = v; } };
struct EpiBranch { const bf16* G; float* MG; bf16* MGB; int i; int pad;
    __device__ void operator()(int, int row, int col, float v, float) const {
        float m = bf2f(G[(size_t)row * 8192 + i * 2048 + col]) * v; size_t o = (size_t)row * DM + col;
        if (i > 0) m += MG[o];
        MG[o] = m; if (i == 3) MGB[o] = f2bf(m); } };
struct EpiResid { const float* Xin; float* Xout; __device__ void operator()(int, int row, int col, float v, float) const { size_t o = (size_t)row * DM + col; Xout[o] = Xin[o] + v; } };
struct EpiSwiglu { bf16* ACT; size_t strideZ; __device__ void operator()(int z, int row, int col, float g, float u) const {
        float s = g / (1.f + __expf(-g)); ACT[(size_t)z * strideZ + (size_t)row * DFF + col] = f2bf(s * u); } };
struct EpiStoreBf16Z { bf16* O; size_t strideZ; int ldo; int pad; __device__ void operator()(int z, int row, int col, float v, float) const { O[(size_t)z * strideZ + (size_t)row * ldo + col] = f2bf(v); } };

__device__ __forceinline__ float rope_val(const float* hb, int j, int half, const float2* tab, int pos) {
    if (j >= 2 * half) return hb[j];
    int i = j % half; float2 cs = tab[pos * half + i];
    float x1 = hb[i], x2 = hb[i + half];
    return j < half ? x1 * cs.x - x2 * cs.y : x1 * cs.y + x2 * cs.x;
}
__global__ __launch_bounds__(256) void k_prep(const float* __restrict__ P, unsigned char* ws) {
    const float2* tabA = (const float2*)(ws + ROPE_A); const float2* tabC = (const float2*)(ws + ROPE_C); const float2* tabM = (const float2*)(ws + ROPE_M);
    bf16* QA = (bf16*)(ws + WS_QA); bf16* KA = (bf16*)(ws + WS_KA); bf16* KB = (bf16*)(ws + WS_KB);
    bf16* QC = (bf16*)(ws + WS_QC); bf16* KC = (bf16*)(ws + WS_KC); bf16* QD = (bf16*)(ws + WS_QD); bf16* KD = (bf16*)(ws + WS_KD);
    bf16* VT = (bf16*)(ws + WS_VT); bf16* VN = (bf16*)(ws + WS_VN); bf16* G = (bf16*)(ws + WS_G);
    const int t = blockIdx.x, pos = t % SEQ;
    const float* p = P + (size_t)t * IN_COLS;
    for (int c = threadIdx.x; c < IN_COLS; c += 256) {
        if (c < OFF_VA) {
            int cc = c % 512, j = cc % 64; const float* hb = p + (c - j);
            float v = rope_val(hb, j, 8, tabA, pos);
            (c < OFF_KA ? QA : KA)[(size_t)t * 512 + cc] = f2bf(v);
        } else if (c < OFF_CQ) { int cc = c - OFF_VA; bf16 v = f2bf(p[c]); VT[(size_t)cc * VTP + t] = v; VN[(size_t)t * VN_LD + cc] = v; }
        else if (c < OFF_KR) {   }
        else if (c < OFF_QC) { int j = c - OFF_KR; float v = rope_val(p + OFF_KR, j, 32, tabM, pos); bf16 b = f2bf(v);
            for (int h = 0; h < 4; ++h) KB[(size_t)t * 768 + h * 192 + 128 + j] = b; }
        else if (c < OFF_VC) { int cc = (c - OFF_QC) % 1536, j = cc % 128; const float* hb = p + (c - j);
            float v = rope_val(hb, j, 16, tabC, pos);
            (c < OFF_KC ? QC : KC)[(size_t)t * 1536 + cc] = f2bf(v); }
        else if (c < OFF_QD) { int cc = c - OFF_VC; bf16 v = f2bf(p[c]); VT[(size_t)(512 + cc) * VTP + t] = v; VN[(size_t)t * VN_LD + 1024 + cc] = v; }
        else if (c < OFF_VD) { int cc = (c - OFF_QD) % 512; (c < OFF_KD ? QD : KD)[(size_t)t * 512 + cc] = f2bf(p[c]); }
        else if (c < OFF_G) { int cc = c - OFF_VD; bf16 v = f2bf(p[c]); VT[(size_t)(2048 + cc) * VTP + t] = v; VN[(size_t)t * VN_LD + 2560 + cc] = v; }
        else { int cc = c - OFF_G; G[(size_t)t * 8192 + cc] = f2bf(1.f / (1.f + __expf(-p[c]))); }
    }
}
__global__ __launch_bounds__(256) void k_mla_norm(const float* __restrict__ P, const float* __restrict__ gq, const float* __restrict__ gkv, bf16* CQ, bf16* CKV) {
    int task = blockIdx.x * 4 + (threadIdx.x >> 6), lane = threadIdx.x & 63;
    int t = task >> 1, which = task & 1;
    const float* p = P + (size_t)t * IN_COLS + (which ? OFF_CKV : OFF_CQ);
    const float* g = which ? gkv : gq; bf16* o = (which ? CKV : CQ) + (size_t)t * 512;
    float v[8], s = 0.f;
#pragma unroll
    for (int j = 0; j < 8; ++j) { v[j] = p[lane + 64 * j]; s += v[j] * v[j]; }
    float r = rsqrtf(wave_sum(s) * (1.f / 512) + EPS);
#pragma unroll
    for (int j = 0; j < 8; ++j) o[lane + 64 * j] = f2bf(v[j] * r * g[lane + 64 * j]);
}
__global__ __launch_bounds__(256) void k_mla_prep(unsigned char* ws) {
    const float* QR = (const float*)(ws + WS_QBRAW); const float* KV = (const float*)(ws + WS_KVRAW);
    const float2* tabM = (const float2*)(ws + ROPE_M);
    bf16* QB = (bf16*)(ws + WS_QB); bf16* KB = (bf16*)(ws + WS_KB); bf16* VTB = (bf16*)(ws + WS_VTB); bf16* VN = (bf16*)(ws + WS_VN);
    const int t = blockIdx.x, pos = t % SEQ;
    for (int c = threadIdx.x; c < 768 + 1024; c += 256) {
        if (c < 768) { int h = c / 192, j = c % 192; const float* hb = QR + (size_t)t * 768 + h * 192;
            float v = j < 128 ? hb[j] : rope_val(hb + 128, j - 128, 32, tabM, pos);
            QB[(size_t)t * 768 + c] = f2bf(v); }
        else { int cc = c - 768, h = cc / 256, j = cc % 256; float v = KV[(size_t)t * 1024 + cc];
            if (j < 128) KB[(size_t)t * 768 + h * 192 + j] = f2bf(v);
            else { bf16 b = f2bf(v); VTB[(size_t)(h * 128 + j - 128) * VTP + t] = b; VN[(size_t)t * VN_LD + 512 + h * 128 + j - 128] = b; } }
    }
}

__device__ __forceinline__ float dot_row(const float* qf, const bf16* kp, int dqk) {
    float s = 0.f;
    for (int d = 0; d < dqk; d += 8) { u32x4 w = *(const u32x4*)(kp + d);
#pragma unroll
        for (int e = 0; e < 4; ++e) { s += qf[d + 2 * e] * __uint_as_float(w[e] << 16) + qf[d + 2 * e + 1] * __uint_as_float(w[e] & 0xffff0000u); } }
    return s;
}
__device__ __forceinline__ float2 softmax_row(const bf16* qp, int dqk, const bf16* kbase, int kld, float scale, int nk, const bf16* vbase, float* sc, float* qf, int lane) {
    __syncthreads();
    for (int j = lane; j < dqk; j += 64) qf[j] = bf2f(qp[j]);
    __syncthreads();
    float m = -1e30f;
    for (int k = lane; k < nk; k += 64) { float s = dot_row(qf, kbase + (size_t)k * kld, dqk) * scale; sc[k] = s; m = fmaxf(m, s); }
    m = wave_max(m); float l = 0.f;
    __syncthreads();
    for (int k = lane; k < nk; k += 64) { float p = __expf(sc[k] - m); sc[k] = p; l += p; }
    __syncthreads();
    l = wave_sum(l); float inv = 1.f / l;
    float o0 = 0.f, o1 = 0.f;
    for (int k = 0; k < nk; ++k) { float p = sc[k]; unsigned w = *(const unsigned*)(vbase + (size_t)k * VN_LD + 2 * lane);
        o0 += p * __uint_as_float(w << 16); o1 += p * __uint_as_float(w & 0xffff0000u); }
    return make_float2(o0 * inv, o1 * inv);
}
template <int TYPE>
__global__ __launch_bounds__(256) void k_attn_simple(unsigned char* ws, const float* lq1, const float* lk1, const float* lq2, const float* lk2, const float* dgain, float lam_init) {
    __shared__ float s_sc[4][2048]; __shared__ float s_q[4][192];
    const int wave = threadIdx.x >> 6, lane = threadIdx.x & 63;
    float* sc = s_sc[wave]; float* qf = s_q[wave];
    const int task = blockIdx.x * 4 + wave, t = task >> 2, h = task & 3, b = t / SEQ, pos = t % SEQ;
    const bf16* VN = (const bf16*)(ws + WS_VN) + (size_t)b * SEQ * VN_LD;
    bf16* Y = (bf16*)(ws + WS_Y);
    if (TYPE == 0) {
        float lam = __expf(wave_sum(lq1[lane] * lk1[lane])) - __expf(wave_sum(lq2[lane] * lk2[lane])) + lam_init;
        const bf16* QA = (const bf16*)(ws + WS_QA) + (size_t)t * 512 + h * 128; const bf16* KA = (const bf16*)(ws + WS_KA) + (size_t)b * SEQ * 512 + h * 128;
        float2 o1 = softmax_row(QA, 64, KA, 512, 0.125f, pos + 1, VN + h * 128, sc, qf, lane);
        float2 o2 = softmax_row(QA + 64, 64, KA + 64, 512, 0.125f, pos + 1, VN + h * 128, sc, qf, lane);
        float a0 = o1.x - lam * o2.x, a1 = o1.y - lam * o2.y;
        float r = rsqrtf(wave_sum(a0 * a0 + a1 * a1) * (1.f / 128) + EPS) * (1.f - lam_init);
        *(unsigned*)(Y + (size_t)t * 512 + h * 128 + 2 * lane) = pk2(a0 * r * dgain[2 * lane], a1 * r * dgain[2 * lane + 1]);
    } else if (TYPE == 1) {
        const bf16* QB = (const bf16*)(ws + WS_QB) + (size_t)t * 768 + h * 192; const bf16* KB = (const bf16*)(ws + WS_KB) + (size_t)b * SEQ * 768 + h * 192;
        float2 o = softmax_row(QB, 192, KB, 768, 0.07216878364870323f, pos + 1, VN + 512 + h * 128, sc, qf, lane);
        *(unsigned*)(Y + (size_t)(T + t) * 512 + h * 128 + 2 * lane) = pk2(o.x, o.y);
    } else if (TYPE == 2) {
        const bf16* QC = (const bf16*)(ws + WS_QC) + (size_t)t * 1536; const bf16* KC = (const bf16*)(ws + WS_KC) + (size_t)b * SEQ * 1536;
        float m = -1e30f;
        for (int g = 0; g < 3; ++g) {
            for (int j = lane; j < 128; j += 64) qf[j] = bf2f(QC[(g * 4 + h) * 128 + j]);
            for (int j = lane; j < 129; j += 64) { int kidx = pos - (1 << (2 * g)) * j; float s = -__builtin_inff();
                if (kidx >= 0) { s = dot_row(qf, KC + (size_t)kidx * 1536 + (g * 4 + h) * 128, 128) * 0.08838834764831845f; }
                sc[g * 129 + j] = s; m = fmaxf(m, s); }
        }
        m = wave_max(m); float l = 0.f;
        for (int e = lane; e < 387; e += 64) { float p = __expf(sc[e] - m); sc[e] = p; l += p; }
        l = wave_sum(l); float inv = 1.f / l; float o0 = 0.f, o1 = 0.f;
        for (int g = 0; g < 3; ++g) for (int j = 0; j < 129; ++j) { int kidx = pos - (1 << (2 * g)) * j; if (kidx < 0) break; float p = sc[g * 129 + j];
            unsigned w = *(const unsigned*)(VN + (size_t)kidx * VN_LD + 1024 + (g * 4 + h) * 128 + 2 * lane);
            o0 += p * __uint_as_float(w << 16); o1 += p * __uint_as_float(w & 0xffff0000u); }
        *(unsigned*)(Y + (size_t)(2 * T + t) * 512 + h * 128 + 2 * lane) = pk2(o0 * inv, o1 * inv);
    } else {
        const bf16* QD = (const bf16*)(ws + WS_QD) + (size_t)t * 512 + h * 128; const bf16* KD = (const bf16*)(ws + WS_KD) + (size_t)b * SEQ * 512 + h * 128;
        for (int j = lane; j < 128; j += 64) qf[j] = bf2f(QD[j]);
        for (int k = lane; k < pos; k += 64) sc[k] = dot_row(qf, KD + (size_t)k * 512, 128) * 0.08838834764831845f;
        float carry = 0.f;
        for (int c0 = 0; c0 < pos; c0 += 64) { int k = pos - 1 - (c0 + lane); float z = k >= 0 ? sc[k] : 0.f;
            float sp = log1pf(__expf(-fabsf(z)));
            float lsig = fminf(z, 0.f) - sp, lnot = k >= 0 ? (fminf(-z, 0.f) - sp) : 0.f;
            float pre = lnot;
#pragma unroll
            for (int o = 1; o < 64; o <<= 1) { float u = __shfl_up(pre, o); if (lane >= o) pre += u; }
            float later = carry + pre - lnot;
            if (k >= 0) sc[k] = __expf(lsig + later);
            carry += __shfl(pre, 63); }
        float o0 = 0.f, o1 = 0.f;
        for (int k = 0; k < pos; ++k) { float p = sc[k]; unsigned w = *(const unsigned*)(VN + (size_t)k * VN_LD + 2560 + h * 128 + 2 * lane);
            o0 += p * __uint_as_float(w << 16); o1 += p * __uint_as_float(w & 0xffff0000u); }
        *(unsigned*)(Y + (size_t)(3 * T + t) * 512 + h * 128 + 2 * lane) = pk2(o0, o1);
    }
}

__global__ __launch_bounds__(256) void k_router(const float* __restrict__ X, const float* __restrict__ gain, const float* __restrict__ Wr, int* cnt, int* route, bf16* HS) {
    int t = blockIdx.x * 4 + (threadIdx.x >> 6), lane = threadIdx.x & 63;
    const float* xr = X + (size_t)t * DM;
    float v[32], s = 0.f;
#pragma unroll
    for (int j = 0; j < 32; ++j) { v[j] = xr[lane + 64 * j]; s += v[j] * v[j]; }
    float r = rsqrtf(wave_sum(s) * (1.f / DM) + EPS);
    float lg[8];
#pragma unroll
    for (int e = 0; e < 8; ++e) lg[e] = 0.f;
#pragma unroll
    for (int j = 0; j < 32; ++j) { v[j] = v[j] * r * gain[lane + 64 * j]; const float* w = Wr + (size_t)(lane + 64 * j) * 8;
#pragma unroll
        for (int e = 0; e < 8; ++e) lg[e] += v[j] * w[e]; }
#pragma unroll
    for (int e = 0; e < 8; ++e) lg[e] = wave_sum(lg[e]);
    int e1 = 0; float b1 = lg[0];
#pragma unroll
    for (int e = 1; e < 8; ++e) if (lg[e] > b1) { b1 = lg[e]; e1 = e; }
    int e2 = -1; float b2 = -__builtin_inff();
#pragma unroll
    for (int e = 0; e < 8; ++e) if (e != e1 && lg[e] > b2) { b2 = lg[e]; e2 = e; }
    float g2 = __expf(b2 - b1); float g1 = 1.f / (1.f + g2); g2 = g2 * g1;
    int s1 = 0, s2 = 0;
    if (lane == 0) { s1 = atomicAdd(cnt + e1, 1); s2 = atomicAdd(cnt + e2, 1);
        int* ro = route + (size_t)t * 8; ro[0] = e1; ro[1] = s1; ro[2] = __float_as_int(g1); ro[3] = e2; ro[4] = s2; ro[5] = __float_as_int(g2); }
    s1 = __shfl(s1, 0); s2 = __shfl(s2, 0);
    bf16* o1 = HS + ((size_t)e1 * ECAP + s1) * DM; bf16* o2 = HS + ((size_t)e2 * ECAP + s2) * DM;
#pragma unroll
    for (int j = 0; j < 32; ++j) { bf16 b = f2bf(v[j]); o1[lane + 64 * j] = b; o2[lane + 64 * j] = b; }
}
__global__ __launch_bounds__(256) void k_moe_combine(float* X, const int* route, const bf16* OUTS) {
    int t = blockIdx.x; const int* ro = route + (size_t)t * 8;
    int e1 = ro[0], s1 = ro[1], e2 = ro[3], s2 = ro[4]; float g1 = __int_as_float(ro[2]), g2 = __int_as_float(ro[5]);
    const bf16* a = OUTS + ((size_t)e1 * ECAP + s1) * DM; const bf16* b = OUTS + ((size_t)e2 * ECAP + s2) * DM;
    for (int c = threadIdx.x; c < DM; c += 256) X[(size_t)t * DM + c] += g1 * bf2f(a[c]) + g2 * bf2f(b[c]);
}


namespace pg8 {
#define PG8_LAS __attribute__((address_space(3)))
typedef unsigned short bf16_t;
typedef short bf16x8 __attribute__((ext_vector_type(8)));
typedef float f32x4 __attribute__((ext_vector_type(4)));
typedef unsigned u32x4 __attribute__((ext_vector_type(4)));
constexpr int BM = 256, BK = 64, HALF = 128, HTB = HALF * BK * 2  , STAGE_BYTES = 8 * HTB, NXCD = 8, WGM = 8;

__host__ __device__ __forceinline__ int lds_byte(int r, int c) { const int st = (r >> 4) * 2 + (c >> 5), rr = r & 15, cc = c & 31, ob = rr * 64 + cc * 2; return st * 1024 + (ob ^ (((ob >> 9) & 1) << 5)); }
__host__ __device__ __forceinline__ void stage_rc(int b, int& R, int& C) { const int st = b / 1024, sb = b % 1024, swz = sb ^ (((sb >> 9) & 1) << 5); R = (st >> 1) * 16 + swz / 64; C = (st & 1) * 32 + (swz % 64) / 2; }
__host__ __device__ __forceinline__ int perm32(int rho) { const int n = rho >> 4, i = rho & 15; return 8 * (i >> 2) + 4 * n + (i & 3); }

struct Unit { int pm, pn, kind; const char* a; const char* b; };


typedef float f32x2_t __attribute__((ext_vector_type(2))); typedef __bf16 bf16x2_t __attribute__((ext_vector_type(2)));
__device__ __forceinline__ unsigned cvt_pk_bf16(float lo, float hi) { f32x2_t v = {lo, hi}; bf16x2_t b = __builtin_convertvector(v, bf16x2_t); return __builtin_bit_cast(unsigned, b); }
typedef int v8i_t __attribute__((ext_vector_type(8))); typedef int v4i_t __attribute__((ext_vector_type(4)));
template <bool F8> struct FragT;
template <> struct FragT<false> { bf16x8 k[2]; };
template <> struct FragT<true> { v8i_t v; };
template <bool F8> __device__ __forceinline__ void frag_load(FragT<F8>& f, const PG8_LAS unsigned char* p) {
    if constexpr (F8) { const v4i_t lo = *(const PG8_LAS v4i_t*)p, hi = *(const PG8_LAS v4i_t*)(p + 1024); f.v = __builtin_shufflevector(lo, hi, 0, 1, 2, 3, 4, 5, 6, 7); }
    else { f.k[0] = *(const PG8_LAS bf16x8*)p; f.k[1] = *(const PG8_LAS bf16x8*)(p + 1024); }
}
template <bool F8> __device__ __forceinline__ f32x4 frag_mma(const FragT<F8>& w, const FragT<F8>& a, f32x4 c) {
    if constexpr (F8) {
#if defined(__HIP_DEVICE_COMPILE__)
        asm volatile("v_mfma_f32_16x16x128_f8f6f4 %0, %1, %2, %0" : "+v"(c) : "v"(w.v), "v"(a.v));
#endif
        return c; }
    else { c = __builtin_amdgcn_mfma_f32_16x16x32_bf16(w.k[0], a.k[0], c, 0, 0, 0); return __builtin_amdgcn_mfma_f32_16x16x32_bf16(w.k[1], a.k[1], c, 0, 0, 0); }
}
template <class Epi, class Sched, bool ALIGN_EPI = false, bool SP2 = false, bool F8 = false, bool HALF_N = false>
__device__ __forceinline__ void gemm_phase(PG8_LAS unsigned char* lds, const int K, const Sched& S, const Epi& E) {
    int tid = threadIdx.x; asm volatile("" : "+v"(tid));
    const int wid = __builtin_amdgcn_readfirstlane(tid >> 6), lane = tid & 63, wr = wid >> 2, wc = wid & 3, fr = lane & 15, fq = lane >> 4;
    const int nt = K / BK;
    unsigned voffA[2], voffB[2];
#pragma unroll
    for (int i = 0; i < 2; ++i) { int R, C; stage_rc(tid * 16 + i * 8192, R, C); const int Rb = Epi::PERM ? ((R & ~31) + perm32(R & 31)) : R;
        voffA[i] = (unsigned)(R * K + C) * 2u; voffB[i] = (unsigned)(Rb * K + C) * 2u; }
    const size_t kstep = (size_t)(BK * 2);
    const size_t hstep = (size_t)HALF * K * 2;
    const unsigned ldsw = (unsigned)wid * 1024u;
    const int aoff = lds_byte(wr * 64 + fr, fq * 8), boff = lds_byte(wc * 32 + fr, fq * 8);
#define PG8_SA(b, h) (((b) * 2 + (h)) * HTB)
#define PG8_SB(b, h) ((4 + (b) * 2 + (h)) * HTB)
#define PG8_STAGE(bufoff, gbase, voff) do { _Pragma("unroll") for (int _i = 0; _i < 2; ++_i) \
        __builtin_amdgcn_global_load_lds((const unsigned*)((const char*)(gbase) + (voff)[_i]), (PG8_LAS unsigned*)(lds + (bufoff) + ldsw + _i * 8192), 16, 0, 0); } while (0)
#define PG8_LDA(dst, b, h) do { _Pragma("unroll") for (int m = 0; m < 4; ++m) frag_load<F8>(dst[m], lds + PG8_SA(b, h) + aoff + m * 2048); } while (0)
#define PG8_LDB(dst, b, h) do { _Pragma("unroll") for (int n = 0; n < 2; ++n) frag_load<F8>(dst[n], lds + PG8_SB(b, h) + boff + n * 2048); } while (0)
#define PG8_MMA(ai, bj, At, Bt) do { __builtin_amdgcn_s_setprio(1); _Pragma("unroll") for (int m = 0; m < 4; ++m) _Pragma("unroll") for (int n = 0; n < 2; ++n) \
        acc[ai][bj][m][n] = frag_mma<F8>(Bt[n], At[m], acc[ai][bj][m][n]); __builtin_amdgcn_s_setprio(0); } while (0)
#define PG8_WAIT_V(n) asm volatile("s_waitcnt vmcnt(" #n ")" ::: "memory")
#define PG8_WAIT_VX do { if constexpr (HALF_N) PG8_WAIT_V(6); else PG8_WAIT_V(8); } while (0)
#define PG8_WAIT_L(n) asm volatile("s_waitcnt lgkmcnt(" #n ")" ::: "memory")
#define PG8_BAR __builtin_amdgcn_s_barrier()
#define PG8_SCHED __builtin_amdgcn_sched_barrier(0)
    Unit cur, nxt; int ui = 0;
    if (!S.next(0, cur)) return;
    f32x4 acc[2][2][4][2];
#pragma unroll
    for (int a = 0; a < 2; ++a)
#pragma unroll
        for (int b = 0; b < 2; ++b)
#pragma unroll
            for (int m = 0; m < 4; ++m)
#pragma unroll
                for (int n = 0; n < 2; ++n) acc[a][b][m][n] = (f32x4){0.f, 0.f, 0.f, 0.f};
    FragT<F8> At[4], B0[2], B1[2];
    const char* cA = cur.a; const char* cB = cur.b;
    S.a_ready(cur);
    if constexpr (SP2) {
        static_assert(!HALF_N || SP2, "HALF_N: SP2 loop only");
        PG8_STAGE(PG8_SB(0, 0), cB, voffB); if constexpr (!HALF_N) PG8_STAGE(PG8_SB(0, 1), cB + hstep, voffB); PG8_STAGE(PG8_SA(0, 0), cA, voffA); PG8_STAGE(PG8_SA(0, 1), cA + hstep, voffA);
        if (wr == 1) PG8_BAR;
        PG8_WAIT_V(2); PG8_BAR;
        PG8_STAGE(PG8_SB(1, 0), cB + kstep, voffB); PG8_STAGE(PG8_SA(1, 0), cA + kstep, voffA); if constexpr (!HALF_N) PG8_STAGE(PG8_SB(1, 1), cB + hstep + kstep, voffB);
        if constexpr (HALF_N) PG8_WAIT_V(4); else PG8_WAIT_V(6); PG8_BAR;
    } else {
        PG8_STAGE(PG8_SB(0, 0), cB, voffB); PG8_STAGE(PG8_SA(0, 0), cA, voffA); PG8_STAGE(PG8_SB(0, 1), cB + hstep, voffB); PG8_STAGE(PG8_SA(0, 1), cA + hstep, voffA);
        if (wr == 1) PG8_BAR;
        PG8_WAIT_V(4); PG8_BAR;
        PG8_STAGE(PG8_SB(1, 0), cB + kstep, voffB); PG8_STAGE(PG8_SA(1, 0), cA + kstep, voffA); PG8_STAGE(PG8_SB(1, 1), cB + hstep + kstep, voffB);
        PG8_WAIT_V(6); PG8_BAR;
    }
    for (;;) {
        const bool has_next = S.next(ui + 1, nxt);
        const char* nA = has_next ? nxt.a : cA; const char* nB = has_next ? nxt.b : cB;
        for (int t = 0; t < nt; t += 2) {
            const bool last = (t == nt - 2);
            const char* a1 = cA + (size_t)(t + 1) * kstep;
            const char* a2 = last ? nA : cA + (size_t)(t + 2) * kstep; const char* b2 = last ? nB : cB + (size_t)(t + 2) * kstep;
            const char* a3 = a2 + kstep; const char* b3 = b2 + kstep;
            if (last && has_next) S.a_ready(nxt);
            if constexpr (SP2) {
            PG8_LDB(B0, 0, 0); if constexpr (!HALF_N) PG8_LDB(B1, 0, 1); PG8_SCHED; PG8_LDA(At, 0, 0); PG8_STAGE(PG8_SA(1, 1), a1 + hstep, voffA);
            PG8_WAIT_VX; PG8_WAIT_L(0); PG8_BAR; PG8_MMA(0, 0, At, B0); if constexpr (!HALF_N) PG8_MMA(0, 1, At, B1); PG8_BAR; PG8_SCHED;
            PG8_LDA(At, 0, 1); PG8_STAGE(PG8_SB(0, 0), b2, voffB); if constexpr (!HALF_N) PG8_STAGE(PG8_SB(0, 1), b2 + hstep, voffB); PG8_STAGE(PG8_SA(0, 0), a2, voffA);
            PG8_WAIT_VX; PG8_WAIT_L(0); PG8_BAR; PG8_MMA(1, 0, At, B0); if constexpr (!HALF_N) PG8_MMA(1, 1, At, B1); PG8_BAR; PG8_SCHED;
            PG8_LDB(B0, 1, 0); if constexpr (!HALF_N) PG8_LDB(B1, 1, 1); PG8_SCHED; PG8_LDA(At, 1, 0); PG8_STAGE(PG8_SA(0, 1), a2 + hstep, voffA);
            PG8_WAIT_VX; PG8_WAIT_L(0); PG8_BAR; PG8_MMA(0, 0, At, B0); if constexpr (!HALF_N) PG8_MMA(0, 1, At, B1); PG8_BAR; PG8_SCHED;
            PG8_LDA(At, 1, 1); PG8_STAGE(PG8_SB(1, 0), b3, voffB); if constexpr (!HALF_N) PG8_STAGE(PG8_SB(1, 1), b3 + hstep, voffB); PG8_STAGE(PG8_SA(1, 0), a3, voffA);
            PG8_WAIT_VX; PG8_WAIT_L(0); PG8_BAR; PG8_MMA(1, 0, At, B0); if constexpr (!HALF_N) PG8_MMA(1, 1, At, B1); PG8_BAR; PG8_SCHED;
            } else {
            PG8_LDB(B0, 0, 0); PG8_SCHED; PG8_LDA(At, 0, 0); PG8_STAGE(PG8_SA(1, 1), a1 + hstep, voffA);
            PG8_WAIT_L(8); PG8_BAR; PG8_WAIT_L(0); PG8_MMA(0, 0, At, B0); PG8_BAR; PG8_SCHED;
            PG8_LDB(B1, 0, 1); PG8_STAGE(PG8_SB(0, 0), b2, voffB);
            PG8_BAR; PG8_WAIT_L(0); PG8_MMA(0, 1, At, B1); PG8_BAR;
            PG8_LDA(At, 0, 1); PG8_STAGE(PG8_SA(0, 0), a2, voffA);
            PG8_BAR; PG8_WAIT_L(0); PG8_MMA(1, 0, At, B0); PG8_BAR; PG8_SCHED;
            PG8_STAGE(PG8_SB(0, 1), b2 + hstep, voffB);
            PG8_WAIT_V(6); PG8_BAR; PG8_MMA(1, 1, At, B1); PG8_BAR;
            PG8_LDB(B0, 1, 0); PG8_SCHED; PG8_LDA(At, 1, 0); PG8_STAGE(PG8_SA(0, 1), a2 + hstep, voffA);
            PG8_WAIT_L(8); PG8_BAR; PG8_WAIT_L(0); PG8_MMA(0, 0, At, B0); PG8_BAR; PG8_SCHED;
            PG8_LDB(B1, 1, 1); PG8_STAGE(PG8_SB(1, 0), b3, voffB);
            PG8_BAR; PG8_WAIT_L(0); PG8_MMA(0, 1, At, B1); PG8_BAR;
            PG8_LDA(At, 1, 1); PG8_STAGE(PG8_SA(1, 0), a3, voffA);
            PG8_BAR; PG8_WAIT_L(0); PG8_MMA(1, 0, At, B0); PG8_BAR; PG8_SCHED;
            PG8_STAGE(PG8_SB(1, 1), b3 + hstep, voffB);
            PG8_WAIT_V(6); PG8_BAR; PG8_MMA(1, 1, At, B1); PG8_BAR;
            }
        }
        if constexpr (F8) asm volatile("s_nop 7\n\ts_nop 7\n\ts_nop 7" ::: "memory");
        if constexpr (ALIGN_EPI) { if (wr == 0) PG8_BAR; }
        if constexpr (!Epi::AFTER_DRAIN) { E(acc, cur, wr, wc, fr, fq); S.done(cur); }
        if (!has_next) break;
#pragma unroll
        for (int a = 0; a < 2; ++a)
#pragma unroll
            for (int b = 0; b < (HALF_N ? 1 : 2); ++b)
#pragma unroll
                for (int m = 0; m < 4; ++m)
#pragma unroll
                    for (int n = 0; n < 2; ++n) acc[a][b][m][n] = (f32x4){0.f, 0.f, 0.f, 0.f};
        cur = nxt; cA = nA; cB = nB; ++ui;
        if constexpr (ALIGN_EPI) { if (wr == 1) PG8_BAR; }
    }
    PG8_WAIT_V(0);
    if constexpr (!ALIGN_EPI) { if (wr == 0) PG8_BAR; }
    PG8_BAR;
    if constexpr (Epi::AFTER_DRAIN) { E.fused(acc, cur, wr, wc, fr, fq, lds, wid, lane); S.done(cur); }
#undef PG8_SA
#undef PG8_SB
#undef PG8_STAGE
#undef PG8_LDA
#undef PG8_LDB
#undef PG8_MMA
#undef PG8_WAIT_V
#undef PG8_WAIT_VX
#undef PG8_WAIT_L
#undef PG8_BAR
#undef PG8_SCHED
}
}

#define LAS __attribute__((address_space(3)))
constexpr int NWAVES = 8, NTHR = 512;
constexpr int RING_BYTES = 131072, LDS_BYTES = 147456, MISC_OFF = RING_BYTES + 320;
constexpr int NT_IN = 57, NV_ROWS = 2560, NU_STD = 32 * NT_IN, NU_V = (NV_ROWS / 256) * 32;
constexpr size_t WT_IN  = 0;
constexpr size_t WT_INV = WT_IN  + (size_t)2 * NT_IN * 256 * DM * 2;
constexpr size_t WT_UQ  = WT_INV + (size_t)2 * NV_ROWS * DM * 2;
constexpr size_t WT_UKN = WT_UQ  + (size_t)2 * 768 * 512 * 2;
constexpr size_t WT_UKV = WT_UKN + (size_t)2 * 512 * 512 * 2;
constexpr size_t WT_BR  = WT_UKV + (size_t)2 * 512 * 512 * 2;
constexpr size_t WT_OUT = WT_BR  + (size_t)2 * 4 * DM * 512 * 2;
constexpr size_t WT_DI  = WT_OUT + (size_t)2 * DM * DM * 2;
constexpr size_t WT_DO  = WT_DI  + (size_t)2 * DFF * DM * 2;
constexpr size_t WT_MI  = WT_DO  + (size_t)DM * DFF * 2;
constexpr size_t WT_MO  = WT_MI  + (size_t)8 * 2 * DFF * DM * 2;
constexpr size_t WT_END = WT_MO  + (size_t)8 * DM * DFF * 2;
constexpr size_t WT_ING = WT_MI + (size_t)8 * 2 * DFF * DM;
static_assert(WT_ING + (size_t)2 * 8192 * DM <= WT_MO && WT_END <= 768 * MiB, "weight copies fit");
constexpr int NT_STD = 25, NU_A = 32 * NT_STD + NU_V;

struct FArgs { const float* in[21]; float* out; unsigned char* ws; int layer; int pad; };
__device__ __forceinline__ int bid_() { int b = blockIdx.x; asm volatile("" : "+s"(b)); return b; }
__device__ __forceinline__ int gdim_() { int g = gridDim.x; asm volatile("" : "+s"(g)); return g; }
__device__ __forceinline__ const float* in_ptr(const FArgs& a, int k) { asm volatile("" : "+s"(k)); return a.in[k]; }

struct MapIdent { int off; __device__ __forceinline__ int operator()(int n) const { return off + n; } };
__device__ __forceinline__ int rope_perm(int q, int half) { const int j = q >> 3, e = q & 7; return 4 * j + (e & 3) + (e >> 2) * half; }
struct MapInStd { __device__ __forceinline__ int operator()(int n) const {
    const int tile = n >> 8, p = n & 255;
    if (tile < 4) { const int c = (tile & 1) * 256 + p, q = c & 63, off = tile < 2 ? OFF_QA : OFF_KA; return off + (q < 16 ? (c - q) + rope_perm(q, 8) : c); }
    if (tile < 6) return OFF_CQ + (tile - 4) * 256 + p;
    if (tile < 8) return OFF_CKV + (tile - 6) * 256 + p;
    if (tile < 20) { const bool k = tile >= 14; const int c = (tile - (k ? 14 : 8)) * 256 + p, q = c & 127, off = k ? OFF_KC : OFF_QC; return off + (q < 32 ? (c - q) + rope_perm(q, 16) : c); }
    if (tile < 22) return OFF_QD + (tile - 20) * 256 + p;
    if (tile < 24) return OFF_KD + (tile - 22) * 256 + p;
    if (tile == 24) return p < 64 ? OFF_KR + rope_perm(p, 32) : -1;
    return OFF_G + (tile - 25) * 256 + p; } };
struct MapInV { __device__ __forceinline__ int operator()(int n) const { return n < 512 ? OFF_VA + n : (n < 2048 ? OFF_VC + (n - 512) : OFF_VD + (n - 2048)); } };
struct MapUq { __device__ __forceinline__ int operator()(int n) const { const int tile = n >> 8, p = n & 255;
    if (tile < 2) return (2 * tile + (p >> 7)) * 192 + (p & 127);
    return (p >> 6) * 192 + 128 + rope_perm(p & 63, 32); } };
struct MapUkv { int voff; __device__ __forceinline__ int operator()(int n) const { return (n >> 7) * 256 + voff + (n & 127); } };
struct MapFfnIn { __device__ __forceinline__ int operator()(int n) const { const int tile = n >> 8, p = n & 255; return p < 128 ? 128 * tile + p : DFF + 128 * tile + (p - 128); } };

struct CvtLd { f32x4 v[8]; int sc; int cb0; bool fast; };
template <class Map>
__device__ __forceinline__ void cvt_ld(CvtLd& L, const float* __restrict__ W, int ldw, int n0, int k0, const Map& map, int lane) {
    L.sc = map(n0 + (lane & 31));
    L.cb0 = __builtin_amdgcn_readfirstlane(L.sc) & ~31;
    L.fast = __all(L.sc >= 0 && (L.sc & ~31) == L.cb0);
    if (L.fast) { const int rg = lane >> 3, cq = lane & 7;
#pragma unroll
        for (int i = 0; i < 8; ++i) L.v[i] = __builtin_nontemporal_load((const f32x4*)(W + (size_t)(k0 + 8 * i + rg) * ldw + L.cb0 + 4 * cq)); }
}
__device__ __forceinline__ unsigned pk4_fp8(float a, float b, float c, float d) { int p = __builtin_amdgcn_cvt_pk_fp8_f32(a, b, 0, false); p = __builtin_amdgcn_cvt_pk_fp8_f32(c, d, p, true); return (unsigned)p; }
__device__ __forceinline__ int cvt_scr_fast(const CvtLd& L, int k0, const float* __restrict__ kscale, LAS float* scr, int lane) {
    const int rg = lane >> 3, cq = lane & 7;
#pragma unroll
    for (int i = 0; i < 8; ++i) { const int kk = 8 * i + rg; f32x4 x = L.v[i]; if (kscale) x = x * kscale[k0 + kk];
        LAS float* d = scr + kk * 33 + 4 * cq; d[0] = x[0]; d[1] = x[1]; d[2] = x[2]; d[3] = x[3]; }
    return L.sc - L.cb0;
}
template <bool F8>
__device__ __forceinline__ void cvt_out(int pcol, unsigned char* __restrict__ WT, int K, int n0, int k0, LAS float* scr, int lane) {
    asm volatile("s_waitcnt lgkmcnt(0)" ::: "memory");
    if (F8) {
        const int n = lane >> 1, hf = lane & 1; const int col = __shfl(pcol, n); const LAS float* s = scr + (32 * hf) * 33 + col;
        u32x4 o0, o1;
#pragma unroll
        for (int q = 0; q < 4; ++q) { o0[q] = pk4_fp8(s[(4 * q) * 33] * 64.f, s[(4 * q + 1) * 33] * 64.f, s[(4 * q + 2) * 33] * 64.f, s[(4 * q + 3) * 33] * 64.f);
            o1[q] = pk4_fp8(s[(16 + 4 * q) * 33] * 64.f, s[(17 + 4 * q) * 33] * 64.f, s[(18 + 4 * q) * 33] * 64.f, s[(19 + 4 * q) * 33] * 64.f); }
        unsigned char* dst = WT + (size_t)(n0 + n) * K + k0 + 32 * hf;
        *(u32x4*)dst = o0; *(u32x4*)(dst + 16) = o1;
    } else {
        const int c = lane & 7;
#pragma unroll
        for (int j = 0; j < 4; ++j) { const int n = (lane >> 3) + 8 * j; const int col = __shfl(pcol, n); const LAS float* s = scr + (8 * c) * 33 + col;
            u32x4 o; o.x = pk2(s[0 * 33], s[1 * 33]); o.y = pk2(s[2 * 33], s[3 * 33]); o.z = pk2(s[4 * 33], s[5 * 33]); o.w = pk2(s[6 * 33], s[7 * 33]);
            *(u32x4*)((bf16*)WT + (size_t)(n0 + n) * K + k0 + 8 * c) = o; }
    }
    asm volatile("s_waitcnt lgkmcnt(0)" ::: "memory");
}
template <bool F8>
__device__ __forceinline__ void cvt_st(const CvtLd& L, const float* __restrict__ W, int ldw, unsigned char* __restrict__ WT, int K, int n0, int k0, const float* __restrict__ kscale, LAS float* scr, int lane) {
    int pcol;
    if (L.fast) pcol = cvt_scr_fast(L, k0, kscale, scr, lane);
    else {
#pragma unroll 8
        for (int i = 0; i < 32; ++i) { const int kk = 2 * i + (lane >> 5); float v = L.sc >= 0 ? W[(size_t)(k0 + kk) * ldw + L.sc] : 0.f; if (kscale) v *= kscale[k0 + kk]; scr[kk * 33 + (lane & 31)] = v; }
        pcol = lane & 31;
    }
    cvt_out<F8>(pcol, WT, K, n0, k0, scr, lane);
}
struct CvtLdF { f32x4 v[8]; };
template <class Map>
__device__ __forceinline__ void cvt_ldF(CvtLdF& L, const float* __restrict__ W, int ldw, int n0, int k0, const Map& map, int lane) {
    const int sc = map(n0 + (lane & 31)), cb0 = __builtin_amdgcn_readfirstlane(sc) & ~31;
    const char* base = (const char*)(W + (size_t)k0 * ldw + cb0);
    const unsigned voff = (unsigned)((lane >> 3) * ldw + 4 * (lane & 7)) * 4u;
#pragma unroll
    for (int i = 0; i < 8; ++i) { const char* bi = base + (size_t)(8 * i) * ldw * 4; asm volatile("" : "+s"(bi)); L.v[i] = __builtin_nontemporal_load((const __attribute__((address_space(1))) f32x4*)(bi + voff)); }
}
#define GAS __attribute__((address_space(1)))
template <bool F8, class Map>
__device__ __forceinline__ void cvt_outF(const Map& map, unsigned char* __restrict__ WT, int K, int n0, int k0, LAS float* scr, int lane) {
    asm volatile("" ::: "memory");
    if (F8) {
        const int n = lane >> 1, hf = lane & 1, col = map(n0 + n) & 31; const LAS float* s = scr + (32 * hf) * 33 + col;
        float x[32];
#pragma unroll
        for (int k = 0; k < 32; ++k) x[k] = s[k * 33];
        asm volatile("" ::: "memory");
        u32x4 o0, o1;
#pragma unroll
        for (int q = 0; q < 4; ++q) { o0[q] = pk4_fp8(x[4 * q] * 64.f, x[4 * q + 1] * 64.f, x[4 * q + 2] * 64.f, x[4 * q + 3] * 64.f);
            o1[q] = pk4_fp8(x[16 + 4 * q] * 64.f, x[17 + 4 * q] * 64.f, x[18 + 4 * q] * 64.f, x[19 + 4 * q] * 64.f); }
        unsigned char* dst = WT + (size_t)(n0 + n) * K + k0 + 32 * hf;
        *(GAS u32x4*)dst = o0; *(GAS u32x4*)(dst + 16) = o1;
    } else {
        const int c = lane & 7; float x[4][8];
#pragma unroll
        for (int j = 0; j < 4; ++j) { const int n = (lane >> 3) + 8 * j, col = map(n0 + n) & 31; const LAS float* s = scr + (8 * c) * 33 + col;
#pragma unroll
            for (int i = 0; i < 8; ++i) x[j][i] = s[i * 33]; }
        asm volatile("" ::: "memory");
#pragma unroll
        for (int j = 0; j < 4; ++j) { const int n = (lane >> 3) + 8 * j;
            u32x4 o; o.x = pk2(x[j][0], x[j][1]); o.y = pk2(x[j][2], x[j][3]); o.z = pk2(x[j][4], x[j][5]); o.w = pk2(x[j][6], x[j][7]);
            *(GAS u32x4*)((bf16*)WT + (size_t)(n0 + n) * K + k0 + 8 * c) = o; }
    }
    asm volatile("" ::: "memory");
}
__device__ __forceinline__ void cvt_scr_fastF(const CvtLdF& L, LAS float* scr, int lane) {
    const int rg = lane >> 3, cq = lane & 7;
#pragma unroll
    for (int i = 0; i < 8; ++i) { const int kk = 8 * i + rg; const f32x4 x = L.v[i]; LAS float* d = scr + kk * 33 + 4 * cq; d[0] = x[0]; d[1] = x[1]; d[2] = x[2]; d[3] = x[3]; }
}
template <bool F8, class Map>
__device__ __forceinline__ void cvt_run(const float* W, size_t sstride, int ldw, unsigned char* WT, size_t dstride_bytes, int K, int Ndst, const Map& map, const float* kscale, int g0, int hi, int stride, LAS float* scr, int lane) {
    const int nblk = Ndst / 32, ipm = (K / 64) * nblk;
#define CVT_DESC(g, w_, t_, n0_, k0_) const int m_##g = (g) / ipm, r_##g = (g) - m_##g * ipm; const float* w_ = W + (size_t)m_##g * sstride; unsigned char* t_ = WT + (size_t)m_##g * dstride_bytes; const int n0_ = (r_##g % nblk) * 32, k0_ = (r_##g / nblk) * 64;
    CvtLd A, B;
    if (g0 < hi) { const int ga = g0; CVT_DESC(ga, w, t, n0, k0) (void)t; cvt_ld(A, w, ldw, n0, k0, map, lane); }
    if (g0 + stride < hi) { const int gb = g0 + stride; CVT_DESC(gb, w, t, n0, k0) (void)t; cvt_ld(B, w, ldw, n0, k0, map, lane); }
    for (int g = g0; g < hi; g += stride) {
        const CvtLd C = A; A = B;
        if (g + 2 * stride < hi) { const int gc = g + 2 * stride; CVT_DESC(gc, w, t, n0, k0) (void)t; cvt_ld(B, w, ldw, n0, k0, map, lane); }
        { const int gd = g; CVT_DESC(gd, w, t, n0, k0) cvt_st<F8>(C, w, ldw, t, K, n0, k0, kscale, scr, lane); }
    }
#undef CVT_DESC
}
template <bool F8, class Map>
__device__ __forceinline__ void cvt_run_pipe(const float* W, size_t sstride, int ldw, unsigned char* WT, size_t dstride_bytes, int K, int Ndst, const Map& map, int lo, int hi, int wave, LAS float* scr, int lane) {
    const int nblk = Ndst / 32, ipm = (K / 64) * nblk;
    const int n = (hi - lo) >> 3;
    if (n < 4) return;
#define ITEM_NK(r_) const int t_ = (((r_) >> 4) << 3) | ((r_) & 7), kp_ = t_ / nblk, n0_ = (t_ - kp_ * nblk) * 32, k0_ = (2 * kp_ + (((r_) >> 3) & 1)) * 64;
#define PLD(buf, gi) { const int g_ = __builtin_amdgcn_readfirstlane(gi); const int m_ = g_ / ipm, r_ = g_ - m_ * ipm; ITEM_NK(r_) cvt_ldF(buf, W + (size_t)m_ * sstride, ldw, n0_, k0_, map, lane); }
#define PST(buf, gi) { const int g_ = __builtin_amdgcn_readfirstlane(gi); const int m_ = g_ / ipm, r_ = g_ - m_ * ipm; ITEM_NK(r_) cvt_scr_fastF(buf, scr, lane); cvt_outF<F8>(map, WT + (size_t)m_ * dstride_bytes, K, n0_, k0_, scr, lane); }
    CvtLdF A, B, C, D;
#pragma unroll 1
    for (int g = lo + wave; g < hi; g += 32) {
        PLD(A, g) PLD(B, g + 8) PLD(C, g + 16) PLD(D, g + 24)
        PST(A, g) PST(B, g + 8) PST(C, g + 16) PST(D, g + 24)
    }
#undef PLD
#undef ITEM_NK
#undef PST
}
template <class Map>
__device__ __forceinline__ void cvt_job(const float* W, int ldw, bf16* WT, int K, int Ndst, const Map& map, const float* kscale, LAS float* scr, int lane, int gw, int NGW) {
    cvt_run<false>(W, 0, ldw, (unsigned char*)WT, 0, K, Ndst, map, kscale, gw, (K / 64) * (Ndst / 32), NGW, scr, lane);
}
template <class Map>
__device__ __forceinline__ void cvt_range(const float* W, size_t sstride, int ldw, bf16* WT, size_t dstride, int K, int Ndst, const Map& map, const float* kscale, int lo, int hi, LAS float* scr, int lane, int wave) {
    cvt_run<false>(W, sstride, ldw, (unsigned char*)WT, dstride * 2, K, Ndst, map, kscale, lo + wave, hi, NWAVES, scr, lane);
}
template <class Map>
__device__ __forceinline__ void cvt_range_f8(const float* W, size_t sstride, int ldw, unsigned char* WT, size_t dstride, int K, int Ndst, const Map& map, int lo, int hi, LAS float* scr, int lane, int wave) {
    cvt_run<true>(W, sstride, ldw, WT, dstride, K, Ndst, map, nullptr, lo + wave, hi, NWAVES, scr, lane);
}
template <class Map>
__device__ __forceinline__ void cvt_pipe(const float* W, size_t sstride, int ldw, bf16* WT, size_t dstride, int K, int Ndst, const Map& map, const float* kscale, int lo, int hi, LAS float* scr, int lane, int wave) {
    (void)kscale; cvt_run_pipe<false>(W, sstride, ldw, (unsigned char*)WT, dstride * 2, K, Ndst, map, lo, hi, wave, scr, lane);
}
template <class Map>
__device__ __forceinline__ void cvt_pipe_f8(const float* W, size_t sstride, int ldw, unsigned char* WT, size_t dstride, int K, int Ndst, const Map& map, int lo, int hi, LAS float* scr, int lane, int wave) {
    cvt_run_pipe<true>(W, sstride, ldw, WT, dstride, K, Ndst, map, lo, hi, wave, scr, lane);
}
__device__ __forceinline__ void phase_convert(const FArgs& a, LAS unsigned char* lds) {
    unsigned char* ws_ = a.ws;
    const int lane = threadIdx.x & 63, wave = threadIdx.x >> 6;
    LAS float* scr = (LAS float*)(lds + wave * 16384);
    const int gw = blockIdx.x * NWAVES + wave, NGW = gridDim.x * NWAVES;
    unsigned char* wt = ws_ + WS_WT;
    for (int idx = blockIdx.x * NTHR + threadIdx.x; idx < 2048 * 56; idx += gridDim.x * NTHR) {
        const int pos = idx / 56, r = idx % 56; int half, i; float2* dst;
        if (r < 8) { half = 8; i = r; dst = (float2*)(ws_ + ROPE_A) + pos * 8 + i; }
        else if (r < 24) { half = 16; i = r - 8; dst = (float2*)(ws_ + ROPE_C) + pos * 16 + i; }
        else { half = 32; i = r - 24; dst = (float2*)(ws_ + ROPE_M) + pos * 32 + i; }
        const float e = -(float)(2 * i) / (float)(2 * half), inv = exp2f(e * log2f(ROPE_THETA)), ang = (float)pos * inv;
        double rev = (double)ang * 0.15915494309189535; rev -= floor(rev); const float rf = (float)rev;
        *dst = make_float2(__builtin_amdgcn_cosf(rf), __builtin_amdgcn_sinf(rf));
    }
    {
        const float* w_in = a.in[2];
        cvt_job(w_in, IN_COLS, (bf16*)(wt + WT_IN), DM, NT_STD * 256, MapInStd{}, nullptr, scr, lane, gw, NGW);
        cvt_run<true>(w_in, 0, IN_COLS, wt + WT_ING, 0, DM, 8192, MapIdent{OFF_G}, nullptr, gw, (DM / 64) * (8192 / 32), NGW, scr, lane);
        cvt_job(w_in, IN_COLS, (bf16*)(wt + WT_INV), DM, NV_ROWS, MapInV{}, nullptr, scr, lane, gw, NGW);
        cvt_job(a.in[5], 768, (bf16*)(wt + WT_UQ), 512, 768, MapUq{}, a.in[3], scr, lane, gw, NGW);
        cvt_job(a.in[6], 1024, (bf16*)(wt + WT_UKN), 512, 512, MapUkv{0}, a.in[4], scr, lane, gw, NGW);
        cvt_job(a.in[6], 1024, (bf16*)(wt + WT_UKV), 512, 512, MapUkv{128}, a.in[4], scr, lane, gw, NGW);
#ifdef PROBE_CONV
        {
            const int wv = __builtin_amdgcn_readfirstlane(threadIdx.x >> 6);
            const int per = (3 * 11264 / 256) & ~31, lo = blockIdx.x * per, hi = lo + per;
            cvt_pipe_f8(a.in[18], (size_t)DM * 2 * DFF, 2 * DFF, wt + WT_MI, (size_t)2 * DFF * DM, DM, 2 * DFF, MapFfnIn{}, lo, hi, scr, lane, wv);
        }
#endif
#ifdef PROBE_PAT
        {
            const float* Wm = a.in[18]; f32x4 acc = {0.f, 0.f, 0.f, 0.f};
            typedef const __attribute__((address_space(1))) f32x4* gp4;
#if PROBE_PAT == 1
            const int nitem = 8 * 32 * 352;
            for (int g = gw; g < nitem; g += 4 * NGW) {
                f32x4 v[4][8];
#pragma unroll
                for (int j = 0; j < 4; ++j) { const int gi = g + j * NGW < nitem ? g + j * NGW : g; const int m = gi / (32 * 352), r = gi - m * (32 * 352), k0 = (r / 352) * 64, n0 = (r % 352) * 32;
                    const float* base = Wm + (size_t)m * 2048 * 11264 + (size_t)k0 * 11264 + n0;
#pragma unroll
                    for (int i = 0; i < 8; ++i) v[j][i] = __builtin_nontemporal_load((gp4)(base + (size_t)(8 * i + (lane >> 3)) * 11264 + 4 * (lane & 7))); }
#pragma unroll
                for (int j = 0; j < 4; ++j)
#pragma unroll
                    for (int i = 0; i < 8; ++i) acc += v[j][i];
            }
#else
            const int nblk = 8 * 32 * 44;
            for (int g = blockIdx.x; g < nblk; g += 4 * gridDim.x) {
                f32x4 v[4][8];
#pragma unroll
                for (int j = 0; j < 4; ++j) { const int gi = g + j * (int)gridDim.x < nblk ? g + j * (int)gridDim.x : g; const int m = gi / (32 * 44), r = gi - m * (32 * 44), k0 = (r / 44) * 64, n0 = (r % 44) * 256;
                    const float* base = Wm + (size_t)m * 2048 * 11264 + (size_t)(k0 + 8 * wave) * 11264 + n0;
#pragma unroll
                    for (int i = 0; i < 8; ++i) v[j][i] = __builtin_nontemporal_load((gp4)(base + (size_t)i * 11264 + 4 * lane)); }
#pragma unroll
                for (int j = 0; j < 4; ++j)
#pragma unroll
                    for (int i = 0; i < 8; ++i) acc += v[j][i];
            }
#endif
            if (acc[0] + acc[1] + acc[2] + acc[3] == 123456.789f) ((float*)(ws_ + WS_XA))[threadIdx.x] = acc[0];
        }
#endif
    }
}
constexpr int I_BR = 8 * 512, I_OUT = 2 * 2048, I_DI = 11264, I_DO = 5632, I_IN1 = 32 * (NT_STD * 256 / 32), I_ING1 = 32 * 256, I_INV1 = 2560, I_UQ1 = 192, I_UK1 = 128, I_MI = 11264, I_MO = 5632;
constexpr int C0_BR = 0, C0_OUT = C0_BR + I_BR, C0_DI = C0_OUT + I_OUT, C0_DO = C0_DI + I_DI, C0_IN1 = C0_DO + I_DO, C0_ING1 = C0_IN1 + I_IN1, C0_INV1 = C0_ING1 + I_ING1, C0_UQ1 = C0_INV1 + I_INV1, C0_UKN1 = C0_UQ1 + I_UQ1, C0_UKV1 = C0_UKN1 + I_UK1,
              C0_MI = C0_UKV1 + I_UK1, C0_MO = C0_MI + 3 * I_MI, CONV_N0 = C0_MO + 3 * I_MO;
constexpr int C1_MI = 0, C1_MO = C1_MI + 5 * I_MI, CONV_N1 = C1_MO + 5 * I_MO, TAIL_PER_WG = 128, CONV_TAIL1 = 128 * TAIL_PER_WG;
#define CONV_SEG(P0, P1) const int lo = (clo > (P0) ? clo : (P0)) - (P0), hi = (chi < (P1) ? chi : (P1)) - (P0); if (lo < hi)
__device__ __forceinline__ void conv_chunk(const FArgs& a, LAS unsigned char* lds, int set, int clo, int chi) {
    unsigned char* ws_ = a.ws; asm volatile("" : "+s"(ws_));
    int tid = threadIdx.x; asm volatile("" : "+v"(tid));
    const int lane = tid & 63, wave = __builtin_amdgcn_readfirstlane(tid >> 6);
    LAS float* scr = (LAS float*)(lds + wave * 16384);
    unsigned char* wt = ws_ + WS_WT;
    if (set == 0) {
        { CONV_SEG(C0_BR, C0_OUT) cvt_pipe(in_ptr(a, 12), (size_t)512 * DM, DM, (bf16*)(wt + WT_BR), (size_t)DM * 512, 512, DM, MapIdent{0}, nullptr, lo, hi, scr, lane, wave); }
        { CONV_SEG(C0_OUT, C0_DI) cvt_pipe(in_ptr(a, 13), (size_t)DM * DM, DM, (bf16*)(wt + WT_OUT), (size_t)DM * DM, DM, DM, MapIdent{0}, nullptr, lo, hi, scr, lane, wave); }
        { CONV_SEG(C0_DI, C0_DO) cvt_pipe(in_ptr(a, 15), 0, 2 * DFF, (bf16*)(wt + WT_DI), 0, DM, 2 * DFF, MapFfnIn{}, nullptr, lo, hi, scr, lane, wave); }
        { CONV_SEG(C0_DO, C0_IN1) cvt_pipe(in_ptr(a, 16), 0, DM, (bf16*)(wt + WT_DO), 0, DFF, DM, MapIdent{0}, nullptr, lo, hi, scr, lane, wave); }
        { CONV_SEG(C0_IN1, C0_ING1) cvt_range(in_ptr(a, 2) + (size_t)DM * IN_COLS, 0, IN_COLS, (bf16*)(wt + WT_IN) + (size_t)NT_IN * 256 * DM, 0, DM, NT_STD * 256, MapInStd{}, nullptr, lo, hi, scr, lane, wave); }
        { CONV_SEG(C0_ING1, C0_INV1) cvt_pipe_f8(in_ptr(a, 2) + (size_t)DM * IN_COLS, 0, IN_COLS, wt + WT_ING + (size_t)8192 * DM, 0, DM, 8192, MapIdent{OFF_G}, lo, hi, scr, lane, wave); }
        { CONV_SEG(C0_INV1, C0_UQ1) cvt_pipe(in_ptr(a, 2) + (size_t)DM * IN_COLS, 0, IN_COLS, (bf16*)(wt + WT_INV) + (size_t)NV_ROWS * DM, 0, DM, NV_ROWS, MapInV{}, nullptr, lo, hi, scr, lane, wave); }
        { CONV_SEG(C0_UQ1, C0_UKN1) cvt_range(in_ptr(a, 5) + (size_t)512 * 768, 0, 768, (bf16*)(wt + WT_UQ) + (size_t)768 * 512, 0, 512, 768, MapUq{}, in_ptr(a, 3) + 512, lo, hi, scr, lane, wave); }
        { CONV_SEG(C0_UKN1, C0_UKV1) cvt_range(in_ptr(a, 6) + (size_t)512 * 1024, 0, 1024, (bf16*)(wt + WT_UKN) + (size_t)512 * 512, 0, 512, 512, MapUkv{0}, in_ptr(a, 4) + 512, lo, hi, scr, lane, wave); }
        { CONV_SEG(C0_UKV1, C0_MI) cvt_range(in_ptr(a, 6) + (size_t)512 * 1024, 0, 1024, (bf16*)(wt + WT_UKV) + (size_t)512 * 512, 0, 512, 512, MapUkv{128}, in_ptr(a, 4) + 512, lo, hi, scr, lane, wave); }
        { CONV_SEG(C0_MI, C0_MO) cvt_pipe_f8(in_ptr(a, 18), (size_t)DM * 2 * DFF, 2 * DFF, wt + WT_MI, (size_t)2 * DFF * DM, DM, 2 * DFF, MapFfnIn{}, lo, hi, scr, lane, wave); }
        { CONV_SEG(C0_MO, CONV_N0) cvt_pipe_f8(in_ptr(a, 19), (size_t)DFF * DM, DM, wt + WT_MO, (size_t)DM * DFF, DFF, DM, MapIdent{0}, lo, hi, scr, lane, wave); }
    } else {
        { CONV_SEG(C1_MI, C1_MO) cvt_pipe_f8(in_ptr(a, 18) + (size_t)3 * DM * 2 * DFF, (size_t)DM * 2 * DFF, 2 * DFF, wt + WT_MI + (size_t)3 * 2 * DFF * DM, (size_t)2 * DFF * DM, DM, 2 * DFF, MapFfnIn{}, lo, hi, scr, lane, wave); }
        { CONV_SEG(C1_MO, CONV_N1) cvt_pipe_f8(in_ptr(a, 19) + (size_t)3 * DFF * DM, (size_t)DFF * DM, DM, wt + WT_MO + (size_t)3 * DM * DFF, (size_t)DM * DFF, DFF, DM, MapIdent{0}, lo, hi, scr, lane, wave); }
    }
}

__device__ __forceinline__ void tile_of(int L, int nM, int nN, int& pm, int& pn) {
    const int nwg = nM * nN; int wgid = L; { const int q = nwg / 8, r = nwg % 8, xcd = wgid % 8, off = wgid / 8; wgid = (xcd < r ? xcd * (q + 1) : r * (q + 1) + (xcd - r) * q) + off; }
    const int nig = 8 * nN, gid = wgid / nig, fm = gid * 8, gsz = (nM - fm) < 8 ? (nM - fm) : 8;
    pm = fm + ((wgid % nig) % gsz); pn = (wgid % nig) / gsz;
}
struct SchedBase { __device__ __forceinline__ void a_ready(const pg8::Unit&) const {} __device__ __forceinline__ void done(const pg8::Unit&) const {} };
struct GenSched : SchedBase { const char* A; const char* Bt; size_t tstep; int nM, nN, G, c;
    __device__ __forceinline__ bool next(int i, pg8::Unit& u) const { const int L = i * G + c; if (L >= nM * nN) return false; tile_of(L, nM, nN, u.pm, u.pn); u.kind = 0; u.a = A + (size_t)u.pm * tstep; u.b = Bt + (size_t)u.pn * tstep; return true; } };
struct InSched : SchedBase { const char* H; const char* W; const char* WV; int G, c;
    __device__ __forceinline__ bool next(int i, pg8::Unit& u) const { const int L = i * G + c; if (L >= NU_A) return false;
        if (L < 32 * NT_STD) { tile_of(L, 32, NT_STD, u.pm, u.pn); u.kind = 0; u.a = H + (size_t)u.pm * (256 * DM * 2); u.b = W + (size_t)u.pn * (256 * DM * 2); }
        else { tile_of(L - 32 * NT_STD, NV_ROWS / 256, 32, u.pm, u.pn); u.kind = 1; u.a = WV + (size_t)u.pm * (256 * DM * 2); u.b = H + (size_t)u.pn * (256 * DM * 2); } return true; } };
struct GateSched : SchedBase { const char* H8; const char* W8; int G, c;
    __device__ __forceinline__ bool next(int i, pg8::Unit& u) const {
        const int x = c & 7, j = c >> 3, n = j < 12 ? 3 : (j < 24 ? 5 : 4), st = j < 12 ? 3 * j : (j < 24 ? 36 + 5 * (j - 12) : 96 + 4 * (j - 24));
        if (i >= n || c >= 256) return false; const int e = st + i; u.pm = 4 * x + (e & 3); u.pn = e >> 2; u.kind = 0;
        u.a = H8 + (size_t)u.pm * (256 * DM); u.b = W8 + (size_t)u.pn * (256 * DM); return true; } };
struct MlaSched : SchedBase { const char* CQ; const char* CKV; const char* WQ; const char* WKN; const char* WKV; int G, c;
    __device__ __forceinline__ bool next(int i, pg8::Unit& u) const { int L = i * G + c; if (L >= 224) return false;
        constexpr size_t TS = 256 * 512 * 2;
        if (L < 96) { u.kind = 0; u.pm = L & 31; u.pn = L >> 5; u.a = CQ + u.pm * TS; u.b = WQ + u.pn * TS; }
        else if (L < 160) { L -= 96; u.kind = 1; u.pm = L & 31; u.pn = L >> 5; u.a = CKV + u.pm * TS; u.b = WKN + u.pn * TS; }
        else { L -= 160; u.kind = 2; u.pm = L >> 5; u.pn = L & 31; u.a = WKV + u.pm * TS; u.b = CKV + u.pn * TS; } return true; } };
struct BranchSched : SchedBase { const char* Y; const char* W; int G, c;
    __device__ __forceinline__ bool next(int i, pg8::Unit& u) const { const int tl = (i >> 2) * G + c; if (tl >= 256) return false; const int br = i & 3; int pm, pn; tile_of(tl, 32, 8, pm, pn); u.pm = br * 32 + pm; u.pn = br * 8 + pn; u.kind = br; u.a = Y + (size_t)u.pm * (256 * 512 * 2); u.b = W + (size_t)u.pn * (256 * 512 * 2); return true; } };
struct BranchSchedH : SchedBase { const char* Y; const char* W; int c;
    __device__ __forceinline__ bool next(int i, pg8::Unit& u) const { if (i >= 8 || c >= 256) return false; const int hf = i >> 2, br = i & 3; int pm, pn; tile_of(c, 32, 8, pm, pn);
        u.pm = pm; u.pn = pn; u.kind = br | (hf << 2); u.a = Y + (size_t)(br * 32 + pm) * (256 * 512 * 2); u.b = W + (size_t)(br * 2048 + pn * 256 + hf * 128) * (512 * 2); return true; } };
struct MoeSched : SchedBase { const char* A; const char* Bt; size_t tstep; int NT, G, c; int imax = 1 << 20; int pre[9];
    __device__ __forceinline__ void init(const int* cnt) { pre[0] = 0;
#pragma unroll
        for (int e = 0; e < 8; ++e) pre[e + 1] = pre[e] + ((__builtin_amdgcn_readfirstlane(cnt[e]) + 255) >> 8); }
    __device__ __forceinline__ bool next(int i, pg8::Unit& u) const { const int total = pre[8] * NT, q = (total + 7) >> 3, off = i * (G >> 3) + (c >> 3), L = (c & 7) * q + off; if (i >= imax || off >= q || L >= total) return false;
        int e = 0, base = 0, pe = pre[1];
#pragma unroll
        for (int k = 1; k < 8; ++k) { const int b = pre[k] * NT; if (L >= b) { e = k; base = b; pe = pre[k + 1] - pre[k]; } }
        const int idx = L - base; u.pm = e * 32 + idx % pe; u.pn = e * NT + idx / pe; u.kind = 0; u.a = A + (size_t)u.pm * tstep; u.b = Bt + (size_t)u.pn * tstep; return true; } };

struct MoeSchedTail : SchedBase { const char* A; const char* Bt; size_t tstep; int NT, G, c, fr; int pre[9];
    __device__ __forceinline__ bool next(int i, pg8::Unit& u) const { const int total = pre[8] * NT, q = (total + 7) >> 3, r = q - fr * (G >> 3), h = i * (G >> 3) + (c >> 3), off = fr * (G >> 3) + (h >> 1), L = (c & 7) * q + off;
        if (h >= 2 * r || L >= total) return false;
        int e = 0, base = 0, pe = pre[1];
#pragma unroll
        for (int k = 1; k < 8; ++k) { const int b = pre[k] * NT; if (L >= b) { e = k; base = b; pe = pre[k + 1] - pre[k]; } }
        const int idx = L - base; u.pm = e * 32 + idx % pe; u.pn = e * NT + idx / pe; u.kind = h & 1; u.a = A + (size_t)u.pm * tstep; u.b = Bt + (size_t)u.pn * tstep + (size_t)(h & 1) * (tstep >> 1); return true; } };

__device__ __forceinline__ u32x4 pack8(const f32x4& a, const f32x4& b) { u32x4 w; w.x = pg8::cvt_pk_bf16(a[0], a[1]); w.y = pg8::cvt_pk_bf16(a[2], a[3]); w.z = pg8::cvt_pk_bf16(b[0], b[1]); w.w = pg8::cvt_pk_bf16(b[2], b[3]); return w; }
__device__ __forceinline__ void store4(bf16* p, const f32x4& a) { uint2 w; w.x = pg8::cvt_pk_bf16(a[0], a[1]); w.y = pg8::cvt_pk_bf16(a[2], a[3]); *(uint2*)p = w; }
__device__ __forceinline__ void rope4(const float2* tab, f32x4& v0, f32x4& v1) {
    const f32x4 t0 = *(const f32x4*)tab, t1 = *(const f32x4*)(tab + 2);
    const f32x4 c = {t0[0], t0[2], t1[0], t1[2]}, s = {t0[1], t0[3], t1[1], t1[3]};
    const f32x4 a = v0 * c - v1 * s, b = v0 * s + v1 * c; v0 = a; v1 = b;
}
__device__ __forceinline__ void rope4t(const f32x4& t0, const f32x4& t1, f32x4& v0, f32x4& v1) {
    const f32x4 c = {t0[0], t0[2], t1[0], t1[2]}, sn = {t0[1], t0[3], t1[1], t1[3]};
    const f32x4 a = v0 * c - v1 * sn, b = v0 * sn + v1 * c; v0 = a; v1 = b;
}
__device__ __forceinline__ f32x4 sigmoid4(const f32x4& x) { f32x4 r;
#pragma unroll
    for (int e = 0; e < 4; ++e) r[e] = __builtin_amdgcn_rcpf(1.f + __builtin_amdgcn_exp2f(-1.4426950408889634f * x[e]));
    return r; }
__device__ __forceinline__ void bf8_to_f32(const u32x4& w, f32x4& a, f32x4& b) {
    a[0] = __uint_as_float(w.x << 16); a[1] = __uint_as_float(w.x & 0xffff0000u); a[2] = __uint_as_float(w.y << 16); a[3] = __uint_as_float(w.y & 0xffff0000u);
    b[0] = __uint_as_float(w.z << 16); b[1] = __uint_as_float(w.z & 0xffff0000u); b[2] = __uint_as_float(w.w << 16); b[3] = __uint_as_float(w.w & 0xffff0000u); }

struct EpiInproj { static constexpr bool PERM = true, AFTER_DRAIN = false; unsigned char* ws; float* rsq;
    __device__ __forceinline__ void operator()(const f32x4 (&acc)[2][2][4][2], const pg8::Unit& u, int wr, int wc, int fr, int fq) const {
        const int p0 = wc * 32 + 8 * fq;
        if (u.kind == 1) { bf16* VT = (bf16*)(ws + WS_VT); const int row0 = u.pm * 256 + wr * 64 + fr, col0 = u.pn * 256 + p0;
#pragma unroll
            for (int ai = 0; ai < 2; ++ai)
#pragma unroll
                for (int m = 0; m < 4; ++m) { bf16* rp = VT + (size_t)(row0 + ai * 128 + m * 16) * VTP + col0;
#pragma unroll
                    for (int bj = 0; bj < 2; ++bj) *(u32x4*)(rp + bj * 128) = pack8(acc[ai][bj][m][0], acc[ai][bj][m][1]); }
            return; }
        const int tile = u.pn, row0 = u.pm * 256 + wr * 64 + fr;
        if (tile < 4) { bf16* dst = (bf16*)(ws + (tile < 2 ? WS_QA : WS_KA)) + (tile & 1) * 256 + p0; const float2* tab = (const float2*)(ws + ROPE_A) + 4 * fq;
            const bool rot = ((wc & 1) == 0) && (fq < 2);
#pragma unroll
            for (int ai = 0; ai < 2; ++ai) { f32x4 t0[4], t1[4];
                if (rot) {
#pragma unroll
                    for (int m = 0; m < 4; ++m) { const f32x4* tp = (const f32x4*)(tab + ((row0 + ai * 128 + m * 16) & (SEQ - 1)) * 8); t0[m] = tp[0]; t1[m] = tp[1]; } }
#pragma unroll
                for (int m = 0; m < 4; ++m) { bf16* rp = dst + (size_t)(row0 + ai * 128 + m * 16) * 512;
#pragma unroll
                    for (int bj = 0; bj < 2; ++bj) { f32x4 v0 = acc[ai][bj][m][0], v1 = acc[ai][bj][m][1];
                        if (rot) { rope4t(t0[m], t1[m], v0, v1); bf16* bp = rp + bj * 128 - 8 * fq; store4(bp + 4 * fq, v0); store4(bp + 8 + 4 * fq, v1); }
                        else *(u32x4*)(rp + bj * 128) = pack8(v0, v1); } } }
        } else if (tile < 8) { const int which = (tile - 4) >> 1; bf16* dst = (bf16*)(ws + (which ? WS_CKV : WS_CQ)) + (tile & 1) * 256 + p0;
#pragma unroll
            for (int ai = 0; ai < 2; ++ai)
#pragma unroll
                for (int m = 0; m < 4; ++m) { const int row = row0 + ai * 128 + m * 16; bf16* rp = dst + (size_t)row * 512; float ss = 0.f;
#pragma unroll
                    for (int bj = 0; bj < 2; ++bj) { const f32x4 v0 = acc[ai][bj][m][0], v1 = acc[ai][bj][m][1];
                        ss += v0[0] * v0[0] + v0[1] * v0[1] + v0[2] * v0[2] + v0[3] * v0[3] + v1[0] * v1[0] + v1[1] * v1[1] + v1[2] * v1[2] + v1[3] * v1[3];
                        *(u32x4*)(rp + bj * 128) = pack8(v0, v1); }
                    ss += __shfl_xor(ss, 16); ss += __shfl_xor(ss, 32);
                    if (fq == 0) rsq[((size_t)row * 2 + which) * 8 + (tile & 1) * 4 + wc] = ss; }
        } else if (tile < 20) { const bool isk = tile >= 14; bf16* dst = (bf16*)(ws + (isk ? WS_KC : WS_QC)) + (tile - (isk ? 14 : 8)) * 256 + p0; const float2* tab = (const float2*)(ws + ROPE_C) + 4 * fq;
            const bool rot = (wc == 0);
#pragma unroll
            for (int ai = 0; ai < 2; ++ai) { f32x4 t0[4], t1[4];
                if (rot) {
#pragma unroll
                    for (int m = 0; m < 4; ++m) { const f32x4* tp = (const f32x4*)(tab + ((row0 + ai * 128 + m * 16) & (SEQ - 1)) * 16); t0[m] = tp[0]; t1[m] = tp[1]; } }
#pragma unroll
                for (int m = 0; m < 4; ++m) { bf16* rp = dst + (size_t)(row0 + ai * 128 + m * 16) * 1536;
#pragma unroll
                    for (int bj = 0; bj < 2; ++bj) { f32x4 v0 = acc[ai][bj][m][0], v1 = acc[ai][bj][m][1];
                        if (rot) { rope4t(t0[m], t1[m], v0, v1); bf16* bp = rp + bj * 128 - 8 * fq; store4(bp + 4 * fq, v0); store4(bp + 16 + 4 * fq, v1); }
                        else *(u32x4*)(rp + bj * 128) = pack8(v0, v1); } } }
        } else if (tile < 24) { bf16* dst = (bf16*)(ws + (tile < 22 ? WS_QD : WS_KD)) + (tile & 1) * 256 + p0;
#pragma unroll
            for (int ai = 0; ai < 2; ++ai)
#pragma unroll
                for (int m = 0; m < 4; ++m) { bf16* rp = dst + (size_t)(row0 + ai * 128 + m * 16) * 512;
#pragma unroll
                    for (int bj = 0; bj < 2; ++bj) *(u32x4*)(rp + bj * 128) = pack8(acc[ai][bj][m][0], acc[ai][bj][m][1]); }
        } else { if (wc < 2) { const int j = 4 * wc + fq; bf16* KB = (bf16*)(ws + WS_KB) + 128 + 4 * j; const float2* tab = (const float2*)(ws + ROPE_M) + 4 * j;
#pragma unroll
            for (int ai = 0; ai < 2; ++ai) { f32x4 t0[4], t1[4];
#pragma unroll
                for (int m = 0; m < 4; ++m) { const f32x4* tp = (const f32x4*)(tab + ((row0 + ai * 128 + m * 16) & (SEQ - 1)) * 32); t0[m] = tp[0]; t1[m] = tp[1]; }
#pragma unroll
                for (int m = 0; m < 4; ++m) { bf16* rp = KB + (size_t)(row0 + ai * 128 + m * 16) * 768;
                    f32x4 v0 = acc[ai][0][m][0], v1 = acc[ai][0][m][1]; rope4t(t0[m], t1[m], v0, v1);
#pragma unroll
                    for (int h = 0; h < 4; ++h) { store4(rp + h * 192, v0); store4(rp + h * 192 + 32, v1); } } } } }
    }
};

__device__ __forceinline__ float rsq_scale(const float* rsq, int tok, int which) { const f32x4 a = *(const f32x4*)(rsq + ((size_t)tok * 2 + which) * 8), b = *(const f32x4*)(rsq + ((size_t)tok * 2 + which) * 8 + 4);
    return rsqrtf((((a[0] + a[1]) + (a[2] + a[3])) + ((b[0] + b[1]) + (b[2] + b[3]))) * (1.f / 512) + EPS); }
struct EpiGate { static constexpr bool PERM = true, AFTER_DRAIN = false; bf16* G;
    __device__ __forceinline__ void operator()(const f32x4 (&acc)[2][2][4][2], const pg8::Unit& u, int wr, int wc, int fr, int fq) const {
        bf16* gp = G + ((size_t)(u.pm * 32 + u.pn) << 16) + (wr * 64 + fr) * 256 + wc * 32 + 8 * fq;
#pragma unroll
        for (int ai = 0; ai < 2; ++ai)
#pragma unroll
            for (int m = 0; m < 4; ++m) { bf16* rp = gp + (ai * 128 + m * 16) * 256;
#pragma unroll
                for (int bj = 0; bj < 2; ++bj) *(u32x4*)(rp + bj * 128) = pack8(sigmoid4(acc[ai][bj][m][0] * (1.f / 256)), sigmoid4(acc[ai][bj][m][1] * (1.f / 256))); }
    }
};
struct EpiMla { static constexpr bool PERM = true, AFTER_DRAIN = false; unsigned char* ws; const float* rsq;
    __device__ __forceinline__ void operator()(const f32x4 (&acc)[2][2][4][2], const pg8::Unit& u, int wr, int wc, int fr, int fq) const {
        const int p0 = wc * 32 + 8 * fq;
        if (u.kind == 2) { bf16* VTB = (bf16*)(ws + WS_VTB); const int row0 = u.pm * 256 + wr * 64 + fr, col0 = u.pn * 256 + p0;
#pragma unroll
            for (int bj = 0; bj < 2; ++bj) { const int t0 = col0 + bj * 128;
                const f32x4 sa = {rsq_scale(rsq, t0, 1), rsq_scale(rsq, t0 + 1, 1), rsq_scale(rsq, t0 + 2, 1), rsq_scale(rsq, t0 + 3, 1)};
                const f32x4 sb = {rsq_scale(rsq, t0 + 4, 1), rsq_scale(rsq, t0 + 5, 1), rsq_scale(rsq, t0 + 6, 1), rsq_scale(rsq, t0 + 7, 1)};
#pragma unroll
                for (int ai = 0; ai < 2; ++ai)
#pragma unroll
                    for (int m = 0; m < 4; ++m) *(u32x4*)(VTB + (size_t)(row0 + ai * 128 + m * 16) * VTP + col0 + bj * 128) = pack8(acc[ai][bj][m][0] * sa, acc[ai][bj][m][1] * sb); }
            return; }
        const int row0 = u.pm * 256 + wr * 64 + fr, tile = u.pn;
        bf16* dst = (bf16*)(ws + (u.kind == 0 ? WS_QB : WS_KB));
#pragma unroll
        for (int ai = 0; ai < 2; ++ai)
#pragma unroll
            for (int m = 0; m < 4; ++m) { const int row = row0 + ai * 128 + m * 16, pos = row & (SEQ - 1); const float r = rsq_scale(rsq, row, u.kind); bf16* rp = dst + (size_t)row * 768;
#pragma unroll
                for (int bj = 0; bj < 2; ++bj) { f32x4 v0 = acc[ai][bj][m][0] * r, v1 = acc[ai][bj][m][1] * r;
                    if (u.kind == 0 && tile == 2) { const int hb = 2 * bj + (wc >> 1), j = 4 * (wc & 1) + fq; rope4((const float2*)(ws + ROPE_M) + pos * 32 + 4 * j, v0, v1);
                        store4(rp + hb * 192 + 128 + 4 * j, v0); store4(rp + hb * 192 + 160 + 4 * j, v1); }
                    else *(u32x4*)(rp + (2 * tile + bj) * 192 + p0) = pack8(v0, v1); } }
    }
};
struct EpiBranchF { static constexpr bool PERM = true, AFTER_DRAIN = false; const bf16* G; bf16* MGT; bf16* MGB;
    __device__ __forceinline__ void operator()(const f32x4 (&acc)[2][2][4][2], const pg8::Unit& u, int wr, int wc, int fr, int fq) const {
        const int i = u.kind, pm = u.pm & 31, pn = u.pn & 7, lr = wr * 64 + fr, lc = wc * 32 + 8 * fq;
        const bf16* gt = G + ((size_t)(pm * 32 + i * 8 + pn) << 16) + lr * 256 + lc;
        bf16* mt = MGT + ((size_t)(pm * 8 + pn) << 16) + lr * 256 + lc;
#pragma unroll
        for (int ai = 0; ai < 2; ++ai) {
            u32x4 gw[4][2], ow[4][2];
#pragma unroll
            for (int m = 0; m < 4; ++m)
#pragma unroll
                for (int bj = 0; bj < 2; ++bj) { const int off = (ai * 128 + m * 16) * 256 + bj * 128;
                    gw[m][bj] = *(const u32x4*)(gt + off);
                    if (i > 0) ow[m][bj] = *(const u32x4*)(mt + off); }
#pragma unroll
            for (int m = 0; m < 4; ++m)
#pragma unroll
                for (int bj = 0; bj < 2; ++bj) { const int off = (ai * 128 + m * 16) * 256 + bj * 128;
                    f32x4 g0, g1; bf8_to_f32(gw[m][bj], g0, g1);
                    f32x4 v0 = acc[ai][bj][m][0] * g0, v1 = acc[ai][bj][m][1] * g1;
                    if (i > 0) { f32x4 o0, o1; bf8_to_f32(ow[m][bj], o0, o1); v0 += o0; v1 += o1; }
                    if (i < 3) *(u32x4*)(mt + off) = pack8(v0, v1);
                    else *(u32x4*)(MGB + (size_t)(pm * 256 + lr + ai * 128 + m * 16) * DM + pn * 256 + lc + bj * 128) = pack8(v0, v1); }
            asm volatile("" ::: "memory"); }
    }
};
struct EpiBranchH { static constexpr bool PERM = true, AFTER_DRAIN = false; const bf16* G; bf16* MGB; mutable u32x4 gp[2][4];
    __device__ __forceinline__ void operator()(f32x4 (&acc)[2][2][4][2], const pg8::Unit& u, int wr, int wc, int fr, int fq) const {
        typedef const __attribute__((address_space(1))) u32x4 gv4;
        const int br = u.kind & 3, hf = u.kind >> 2, lr = wr * 64 + fr, lc = hf * 128 + wc * 32 + 8 * fq;
        const __attribute__((address_space(1))) bf16* gb = (const __attribute__((address_space(1))) bf16*)G + ((size_t)(u.pm * 32 + br * 8 + u.pn) << 16);
        const unsigned lo = (unsigned)(lr * 256 + lc);
        if (br == 0) {
#pragma unroll
            for (int ai = 0; ai < 2; ++ai)
#pragma unroll
                for (int m = 0; m < 4; ++m) gp[ai][m] = *(gv4*)(gb + lo + (ai * 128 + m * 16) * 256); }
#pragma unroll
        for (int ai = 0; ai < 2; ++ai)
#pragma unroll
            for (int m = 0; m < 4; ++m) { f32x4 g0, g1; bf8_to_f32(gp[ai][m], g0, g1);
                if (br == 0) { acc[ai][1][m][0] = acc[ai][0][m][0] * g0; acc[ai][1][m][1] = acc[ai][0][m][1] * g1; }
                else { acc[ai][1][m][0] += acc[ai][0][m][0] * g0; acc[ai][1][m][1] += acc[ai][0][m][1] * g1; } }
        if (br < 3) {
#pragma unroll
            for (int ai = 0; ai < 2; ++ai)
#pragma unroll
                for (int m = 0; m < 4; ++m) gp[ai][m] = *(gv4*)(gb + ((size_t)8 << 16) + lo + (ai * 128 + m * 16) * 256);
        } else {
            __attribute__((address_space(1))) bf16* mb = (__attribute__((address_space(1))) bf16*)MGB + (size_t)(u.pm * 256) * DM + u.pn * 256;
            const unsigned mo = (unsigned)(lr * DM + lc);
#pragma unroll
            for (int ai = 0; ai < 2; ++ai)
#pragma unroll
                for (int m = 0; m < 4; ++m) *(__attribute__((address_space(1))) u32x4*)(mb + mo + (ai * 128 + m * 16) * DM) = pack8(acc[ai][1][m][0], acc[ai][1][m][1]); }
    }
};
struct EpiResidF { static constexpr bool PERM = false, AFTER_DRAIN = false; const float* Xin; float* Xout;
    __device__ __forceinline__ void operator()(const f32x4 (&acc)[2][2][4][2], const pg8::Unit& u, int wr, int wc, int fr, int fq) const {
        const int row0 = u.pm * 256 + wr * 64 + fr, col0 = u.pn * 256 + wc * 32 + 4 * fq;
#pragma unroll
        for (int ai = 0; ai < 2; ++ai) {
            f32x4 xi[4][2][2];
#pragma unroll
            for (int m = 0; m < 4; ++m)
#pragma unroll
                for (int bj = 0; bj < 2; ++bj)
#pragma unroll
                    for (int n = 0; n < 2; ++n) xi[m][bj][n] = *(const f32x4*)(Xin + (size_t)(row0 + ai * 128 + m * 16) * DM + col0 + bj * 128 + n * 16);
#pragma unroll
            for (int m = 0; m < 4; ++m)
#pragma unroll
                for (int bj = 0; bj < 2; ++bj)
#pragma unroll
                    for (int n = 0; n < 2; ++n) *(f32x4*)(Xout + (size_t)(row0 + ai * 128 + m * 16) * DM + col0 + bj * 128 + n * 16) = xi[m][bj][n] + acc[ai][bj][m][n];
            asm volatile("" ::: "memory"); }
    }
};
struct EpiSwigluF { static constexpr bool PERM = true, AFTER_DRAIN = false; bf16* ACT; int NT;
    __device__ __forceinline__ void operator()(const f32x4 (&acc)[2][2][4][2], const pg8::Unit& u, int wr, int wc, int fr, int fq) const {
        const int row0 = u.pm * 256 + wr * 64 + fr, col0 = (u.pn % NT) * 128 + wc * 32 + 8 * fq;
#pragma unroll
        for (int ai = 0; ai < 2; ++ai)
#pragma unroll
            for (int m = 0; m < 4; ++m) { const f32x4 g0 = acc[ai][0][m][0], g1 = acc[ai][0][m][1];
                const f32x4 a0 = g0 * sigmoid4(g0) * acc[ai][1][m][0], a1 = g1 * sigmoid4(g1) * acc[ai][1][m][1];
                *(u32x4*)(ACT + (size_t)(row0 + ai * 128 + m * 16) * DFF + col0) = pack8(a0, a1); }
    }
};
struct EpiSwigluF8 { static constexpr bool PERM = true, AFTER_DRAIN = false; unsigned char* ACT; int NT;
    __device__ __forceinline__ void operator()(const f32x4 (&acc)[2][2][4][2], const pg8::Unit& u, int wr, int wc, int fr, int fq) const {
        const int row0 = u.pm * 256 + wr * 64 + fr, col0 = (u.pn % NT) * 128 + wc * 32 + 8 * fq;
#pragma unroll
        for (int ai = 0; ai < 2; ++ai)
#pragma unroll
            for (int m = 0; m < 4; ++m) { const f32x4 g0 = acc[ai][0][m][0] * (1.f / 256), g1 = acc[ai][0][m][1] * (1.f / 256);
                f32x4 a0 = g0 * sigmoid4(g0) * acc[ai][1][m][0] * (4.f / 256), a1 = g1 * sigmoid4(g1) * acc[ai][1][m][1] * (4.f / 256);
#pragma unroll
                for (int e = 0; e < 4; ++e) { a0[e] = fminf(fmaxf(a0[e], -440.f), 440.f); a1[e] = fminf(fmaxf(a1[e], -440.f), 440.f); }
                const uint2 o = {pk4_fp8(a0[0], a0[1], a0[2], a0[3]), pk4_fp8(a1[0], a1[1], a1[2], a1[3])};
                *(uint2*)(ACT + (size_t)(row0 + ai * 128 + m * 16) * DFF + col0) = o; }
    }
};
struct EpiStoreF { static constexpr bool PERM = true, AFTER_DRAIN = false; bf16* O; int NT; float sc;
    __device__ __forceinline__ void operator()(const f32x4 (&acc)[2][2][4][2], const pg8::Unit& u, int wr, int wc, int fr, int fq) const {
        const int row0 = u.pm * 256 + wr * 64 + fr, col0 = (u.pn % NT) * 256 + wc * 32 + 8 * fq;
#pragma unroll
        for (int ai = 0; ai < 2; ++ai)
#pragma unroll
            for (int m = 0; m < 4; ++m) { bf16* rp = O + (size_t)(row0 + ai * 128 + m * 16) * DM + col0;
#pragma unroll
                for (int bj = 0; bj < 2; ++bj) *(u32x4*)(rp + bj * 128) = pack8(acc[ai][bj][m][0] * sc, acc[ai][bj][m][1] * sc); }
    }
};

struct EpiStoreFH { static constexpr bool PERM = true, AFTER_DRAIN = false; bf16* O; int NT; float sc;
    __device__ __forceinline__ void operator()(const f32x4 (&acc)[2][2][4][2], const pg8::Unit& u, int wr, int wc, int fr, int fq) const {
        const int row0 = u.pm * 256 + wr * 64 + fr, col0 = (u.pn % NT) * 256 + u.kind * 128 + wc * 32 + 8 * fq;
#pragma unroll
        for (int ai = 0; ai < 2; ++ai)
#pragma unroll
            for (int m = 0; m < 4; ++m) *(u32x4*)(O + (size_t)(row0 + ai * 128 + m * 16) * DM + col0) = pack8(acc[ai][0][m][0] * sc, acc[ai][0][m][1] * sc);
    }
};

__device__ __forceinline__ void phase_inproj(const FArgs& a, LAS unsigned char* lds, int layer) {
    unsigned char* ws_ = a.ws; asm volatile("" : "+s"(ws_));
    {   InSched S; S.H = (const char*)(ws_ + WS_H); S.W = (const char*)(ws_ + WS_WT + WT_IN) + (size_t)layer * NT_IN * 256 * DM * 2; S.WV = (const char*)(ws_ + WS_WT + WT_INV) + (size_t)layer * NV_ROWS * DM * 2; S.G = gdim_(); S.c = bid_();
        EpiInproj E{ws_, (float*)(ws_ + WS_RSQP) + (size_t)layer * T * 16};
        pg8::gemm_phase<EpiInproj, InSched, true, true>(lds, DM, S, E); }
    {   GateSched S; S.H8 = (const char*)(ws_ + WS_ACT); S.W8 = (const char*)(ws_ + WS_WT + WT_ING) + (size_t)layer * 8192 * DM; S.G = gdim_(); S.c = bid_();
        EpiGate E{(bf16*)(ws_ + WS_G)};
        pg8::gemm_phase<EpiGate, GateSched, true, true, true>(lds, DM / 2, S, E); }
}
__device__ __forceinline__ void phase_mlaup(const FArgs& a, LAS unsigned char* lds, int layer) {
    unsigned char* ws_ = a.ws; asm volatile("" : "+s"(ws_));
    MlaSched S; S.CQ = (const char*)(ws_ + WS_CQ); S.CKV = (const char*)(ws_ + WS_CKV);
    S.WQ = (const char*)(ws_ + WS_WT + WT_UQ) + (size_t)layer * 768 * 512 * 2; S.WKN = (const char*)(ws_ + WS_WT + WT_UKN) + (size_t)layer * 512 * 512 * 2; S.WKV = (const char*)(ws_ + WS_WT + WT_UKV) + (size_t)layer * 512 * 512 * 2; S.G = gdim_(); S.c = bid_();
    EpiMla E{ws_, (const float*)(ws_ + WS_RSQP) + (size_t)layer * T * 16};
    pg8::gemm_phase<EpiMla, MlaSched, true, true>(lds, 512, S, E);
}
__device__ __forceinline__ void phase_branch(const FArgs& a, LAS unsigned char* lds, int layer) {
    unsigned char* ws_ = a.ws; asm volatile("" : "+s"(ws_));
    BranchSchedH S; S.Y = (const char*)(ws_ + WS_Y); S.W = (const char*)(ws_ + WS_WT + WT_BR) + (size_t)layer * 4 * DM * 512 * 2; S.c = bid_();
    EpiBranchH E; E.G = (const bf16*)(ws_ + WS_G); E.MGB = (bf16*)(ws_ + WS_MGB);
    pg8::gemm_phase<EpiBranchH, BranchSchedH, true, true, false, true>(lds, 512, S, E);
}
__device__ __forceinline__ void phase_outproj(const FArgs& a, LAS unsigned char* lds, int layer) {
    unsigned char* ws_ = a.ws; asm volatile("" : "+s"(ws_));
    GenSched S; S.A = (const char*)(ws_ + WS_MGB); S.Bt = (const char*)(ws_ + WS_WT + WT_OUT) + (size_t)layer * DM * DM * 2; S.tstep = (size_t)256 * DM * 2; S.nM = 32; S.nN = 8; S.G = gdim_(); S.c = bid_();
    EpiResidF E{layer == 0 ? a.in[0] : (const float*)(ws_ + WS_XA), (float*)(ws_ + WS_XA)};
    pg8::gemm_phase<EpiResidF, GenSched, true, true>(lds, DM, S, E);
}
__device__ __forceinline__ void phase_ffn_in(const FArgs& a, LAS unsigned char* lds) {
    unsigned char* ws_ = a.ws; asm volatile("" : "+s"(ws_));
    GenSched S; S.A = (const char*)(ws_ + WS_H); S.Bt = (const char*)(ws_ + WS_WT + WT_DI); S.tstep = (size_t)256 * DM * 2; S.nM = 32; S.nN = 44; S.G = gdim_(); S.c = bid_();
    EpiSwigluF E{(bf16*)(ws_ + WS_ACT), 44};
    pg8::gemm_phase<EpiSwigluF, GenSched, true, true>(lds, DM, S, E);
    {   const int c = bid_();
        if (c >= 128) { __syncthreads(); const int lo = CONV_N1 - CONV_TAIL1 + (c - 128) * TAIL_PER_WG; conv_chunk(a, lds, 1, lo, lo + TAIL_PER_WG); } }
}
__device__ __forceinline__ void phase_ffn_out(const FArgs& a, LAS unsigned char* lds) {
    unsigned char* ws_ = a.ws; asm volatile("" : "+s"(ws_));
    GenSched S; S.A = (const char*)(ws_ + WS_ACT); S.Bt = (const char*)(ws_ + WS_WT + WT_DO); S.tstep = (size_t)256 * DFF * 2; S.nM = 32; S.nN = 8; S.G = gdim_(); S.c = bid_();
    EpiResidF E{(const float*)(ws_ + WS_XA), (float*)(ws_ + WS_XA)};
    pg8::gemm_phase<EpiResidF, GenSched, true, true>(lds, DFF, S, E);
}
__device__ __forceinline__ void phase_moe_in(const FArgs& a, LAS unsigned char* lds) {
    unsigned char* ws_ = a.ws; asm volatile("" : "+s"(ws_));
    MoeSched S; S.A = (const char*)(ws_ + WS_HS); S.Bt = (const char*)(ws_ + WS_WT + WT_MI); S.tstep = (size_t)256 * DM; S.NT = 44; S.G = gdim_(); S.c = bid_(); S.init((const int*)(ws_ + WS_CTL + CTL_CNT));
    EpiSwigluF8 E{ws_ + WS_ACTS, 44};
    pg8::gemm_phase<EpiSwigluF8, MoeSched, true, true, true>(lds, DM / 2, S, E);
}
__device__ __forceinline__ void phase_moe_out(const FArgs& a, LAS unsigned char* lds) {
    unsigned char* ws_ = a.ws; asm volatile("" : "+s"(ws_));
    MoeSched S; S.A = (const char*)(ws_ + WS_ACTS); S.Bt = (const char*)(ws_ + WS_WT + WT_MO); S.tstep = (size_t)256 * DFF; S.NT = 8; S.G = gdim_(); S.c = bid_(); S.init((const int*)(ws_ + WS_CTL + CTL_CNT));
    EpiStoreF E{(bf16*)(ws_ + WS_OUTS), 8, 1.f / 256};
    const int q = (S.pre[8] * 8 + 7) >> 3, fr = q >> 5, r = q - (fr << 5);
    const bool split = r > 0 && r <= 16;
    if (split) S.imax = fr;
    pg8::gemm_phase<EpiStoreF, MoeSched, true, true, true>(lds, DFF / 2, S, E);
    if (split) {
        MoeSchedTail Tl; Tl.A = S.A; Tl.Bt = S.Bt; Tl.tstep = S.tstep; Tl.NT = 8; Tl.G = S.G; Tl.c = S.c; Tl.fr = fr;
#pragma unroll
        for (int k = 0; k < 9; ++k) Tl.pre[k] = S.pre[k];
        EpiStoreFH EH{(bf16*)(ws_ + WS_OUTS), 8, 1.f / 256};
        pg8::gemm_phase<EpiStoreFH, MoeSchedTail, true, true, true, true>(lds, DFF / 2, Tl, EH);
    }
}

#ifndef MK_MULTI
#define PHASE_KERNEL(name, call)
#else
#define PHASE_KERNEL(name, call) __global__ void __launch_bounds__(NTHR, 2) name(FArgs a) { extern __shared__ __attribute__((aligned(16))) unsigned char lds_raw[]; LAS unsigned char* lds = (LAS unsigned char*)lds_raw; call; }
#endif
PHASE_KERNEL(kf_convert, phase_convert(a, lds))
PHASE_KERNEL(kf_inproj, phase_inproj(a, lds, a.layer))
PHASE_KERNEL(kf_mlaup, phase_mlaup(a, lds, a.layer))
PHASE_KERNEL(kf_branch, phase_branch(a, lds, a.layer))
PHASE_KERNEL(kf_outproj, phase_outproj(a, lds, a.layer))
PHASE_KERNEL(kf_ffn_in, phase_ffn_in(a, lds))
PHASE_KERNEL(kf_ffn_out, phase_ffn_out(a, lds))
PHASE_KERNEL(kf_moe_in, phase_moe_in(a, lds))
PHASE_KERNEL(kf_moe_out, phase_moe_out(a, lds))
__device__ __forceinline__ f32x16 mfma32(const bf16x8& a, const bf16x8& b, const f32x16& c) { return __builtin_amdgcn_mfma_f32_32x32x16_bf16(a, b, c, 0, 0, 0); }
__device__ __forceinline__ float ex2(float x) { return __builtin_amdgcn_exp2f(x); }
__device__ __forceinline__ float max_xor32(float v) { auto rr = __builtin_amdgcn_permlane32_swap(__float_as_uint(v), __float_as_uint(v), false, false); return fmaxf(__uint_as_float(rr[0]), __uint_as_float(rr[1])); }
__device__ __forceinline__ float lg2(float x) { return __builtin_amdgcn_logf(x); }
__device__ __forceinline__ bf16x8 pack8v(const f32x16& p, int s) {
    u32x4 w; w.x = pg8::cvt_pk_bf16(p[8 * s + 0], p[8 * s + 1]); w.y = pg8::cvt_pk_bf16(p[8 * s + 2], p[8 * s + 3]); w.z = pg8::cvt_pk_bf16(p[8 * s + 4], p[8 * s + 5]); w.w = pg8::cvt_pk_bf16(p[8 * s + 6], p[8 * s + 7]);
    return __builtin_bit_cast(bf16x8, w); }
constexpr int VS = 144;
template <int DQK, int MODE>
__device__ __forceinline__ void attn_pass(LAS unsigned char* lds, const bf16* __restrict__ Qp, int ldq, const bf16* __restrict__ Kp, int ldk, const bf16* __restrict__ VTp,
                                          int q0, int tile_lo, int tile_hi, int win, int dmask, float C, f32x16 (&O)[4], float& m, float& l) {
    constexpr int KS = DQK * 2 + 16, NKC = DQK / 8, CK = NKC / 8, BUFSZ = 64 * KS + 128 * VS, NKS = DQK / 16;
    int tid = threadIdx.x; asm volatile("" : "+v"(tid));
    const int wave = __builtin_amdgcn_readfirstlane(tid >> 6), lane = tid & 63, r = lane & 31, h = lane >> 5;
    const int qpos = q0 + 32 * wave + r, qw_min = q0 + 32 * wave, qw_max = qw_min + 31;
    const int kap = (r & 19) | ((r & 4) << 1) | ((r & 8) >> 1);
    typedef const __attribute__((address_space(1))) bf16 gbf16;
    gbf16* Qg = (gbf16*)Qp; gbf16* Kg = (gbf16*)Kp; gbf16* VTg = (gbf16*)VTp;
    bf16x8 qf[NKS];
#pragma unroll
    for (int ks = 0; ks < NKS; ++ks) qf[ks] = *(const __attribute__((address_space(1))) bf16x8*)(Qg + (size_t)(32 * wave + r) * ldq + 16 * ks + 8 * h);
    int krow[CK], kcc[CK];
#pragma unroll
    for (int i = 0; i < CK; ++i) { const int c = tid + 512 * i; krow[i] = c / NKC; kcc[i] = c % NKC; }
    const int vrow0 = tid >> 3, vcc = tid & 7;
    u32x4 kst[CK], vst[2];
    const int ntile = tile_hi - tile_lo;
    if (ntile <= 0) return;
    float carry = 0.f; bool seen = false;
    f32x16 madd;
#pragma unroll
    for (int e = 0; e < 16; ++e) madd[e] = (MODE == 1 && ((qpos - 8 * h - (e & 7) - 16 * (e >> 3)) & dmask) != 0) ? -__builtin_inff() : 0.f;
    LAS int* dflag = (LAS int*)(lds + 73728);
#define ATT_LOADS(key0_) do { _Pragma("unroll") for (int i = 0; i < CK; ++i) kst[i] = *(const __attribute__((address_space(1))) u32x4*)(Kg + (size_t)((key0_) + krow[i]) * ldk + kcc[i] * 8); \
        _Pragma("unroll") for (int i = 0; i < 2; ++i) vst[i] = *(const __attribute__((address_space(1))) u32x4*)(VTg + (size_t)(vrow0 + 64 * i) * VTP + (key0_) + vcc * 8); } while (0)
#define ATT_WRITE(buf_) do { LAS unsigned char* Kn_ = lds + (buf_) * BUFSZ; _Pragma("unroll") for (int i = 0; i < CK; ++i) *(LAS u32x4*)(Kn_ + krow[i] * KS + kcc[i] * 16) = kst[i]; \
        _Pragma("unroll") for (int i = 0; i < 2; ++i) *(LAS u32x4*)(Kn_ + 64 * KS + (vrow0 + 64 * i) * VS + vcc * 16) = vst[i]; } while (0)
#define ATT_KEY0(step_) ((MODE == 2 ? tile_hi - 1 - (step_) : tile_lo + (step_)) * 64)
    ATT_LOADS(ATT_KEY0(0)); ATT_WRITE(0);
    if (ntile > 1) ATT_LOADS(ATT_KEY0(1));
    __syncthreads();
    for (int step = 0; step < ntile; ++step) {
        const int key0 = ATT_KEY0(step);
        LAS unsigned char* Kb = lds + (step & 1) * BUFSZ; LAS unsigned char* Vb = Kb + 64 * KS;
        if (step + 1 < ntile) { ATT_WRITE((step + 1) & 1); if (step + 2 < ntile) ATT_LOADS(ATT_KEY0(step + 2)); }
        bool active, needmask;
        if (MODE == 0) { active = key0 <= qw_max; needmask = key0 + 63 > qw_min; }
        else if (MODE == 1) { active = key0 <= qw_max && key0 + 63 >= qw_min - win; needmask = true; }
        else { active = key0 < qw_max; needmask = key0 + 63 >= qw_min; }
        if (MODE == 2 && active) seen = true;
        if (active) {
            f32x16 p0, p1;
#pragma unroll
            for (int e = 0; e < 16; ++e) { p0[e] = 0.f; p1[e] = 0.f; }
#pragma unroll
            for (int ks = 0; ks < NKS; ++ks) {
                const bf16x8 k0 = *(const LAS bf16x8*)(Kb + kap * KS + ks * 32 + h * 16), k1 = *(const LAS bf16x8*)(Kb + (32 + kap) * KS + ks * 32 + h * 16);
                p0 = mfma32(k0, qf[ks], p0); p1 = mfma32(k1, qf[ks], p1); }
            const int d0 = qpos - key0 - 8 * h;
            if (MODE != 2) {
                bool bnd = key0 + 63 > qw_min; if (MODE == 1) bnd = bnd || (qw_max - key0 > win);
                if (bnd) {
                    asm volatile("" ::: "memory");
#pragma unroll
                    for (int e = 0; e < 16; ++e) { const int dl0 = d0 - (e & 7) - 16 * (e >> 3), dl1 = dl0 - 32; bool v0, v1;
                        if (MODE == 0) { v0 = dl0 >= 0; v1 = dl1 >= 0; } else { v0 = (unsigned)dl0 <= (unsigned)win && (dl0 & dmask) == 0; v1 = (unsigned)dl1 <= (unsigned)win && (dl1 & dmask) == 0; }
                        p0[e] = v0 ? p0[e] : -__builtin_inff(); p1[e] = v1 ? p1[e] : -__builtin_inff(); }
                    p0 = p0 * C; p1 = p1 * C;
                } else if (MODE == 1) { p0 = p0 * C + madd; p1 = p1 * C + madd; }
                else { p0 = p0 * C; p1 = p1 * C; }
                float mc[4];
#pragma unroll
                for (int c = 0; c < 4; ++c) mc[c] = fmaxf(fmaxf(p0[c], p1[c]), fmaxf(p0[c + 4], p1[c + 4]));
#pragma unroll
                for (int c = 0; c < 4; ++c) { mc[c] = fmaxf(fmaxf(p0[c + 8], p1[c + 8]), mc[c]); mc[c] = fmaxf(fmaxf(p0[c + 12], p1[c + 12]), mc[c]); }
                const float mt = max_xor32(fmaxf(fmaxf(mc[0], mc[1]), fmaxf(mc[2], mc[3])));
                float mn = m, alpha = 1.f; const bool resc = !__all(mt - m <= 11.5f);
                if (resc) { mn = fmaxf(m, mt); alpha = ex2(m - mn); m = mn; }
                p0 = p0 - mn; p1 = p1 - mn;
#pragma unroll
                for (int e = 0; e < 16; ++e) { p0[e] = ex2(p0[e]); p1[e] = ex2(p1[e]); }
                const f32x16 t16 = p0 + p1; const f32x8v t8 = t16.lo + t16.hi; const f32x4 t4 = t8.lo + t8.hi; const f32x2v t2 = t4.lo + t4.hi;
                const float ps = t2.x + t2.y;
                l = l * alpha + ps;
                if (resc) {
#pragma unroll
                    for (int d = 0; d < 4; ++d) O[d] = O[d] * alpha; }
            } else {
                float R[4];
#pragma unroll
                for (int rr = 0; rr < 4; ++rr) { float suf = 0.f;
#pragma unroll
                    for (int j = 7; j >= 0; --j) { const int e = 8 * (rr & 1) + j; const int dl = d0 - j - 16 * (rr & 1) - 32 * (rr >> 1);
                        const float z = (rr < 2 ? p0[e] : p1[e]) * C; const bool v = !needmask || dl > 0;
                        const float sp = lg2(1.f + ex2(-fabsf(z))), lsig = fminf(z, 0.f) - sp, lnot = v ? lsig - z : 0.f;
                        const float val = v ? lsig + suf : -__builtin_inff();
                        if (rr < 2) p0[e] = val; else p1[e] = val;
                        suf += lnot; }
                    R[rr] = suf; }
                float Rp[4];
#pragma unroll
                for (int rr = 0; rr < 4; ++rr) Rp[rr] = __shfl_xor(R[rr], 32);
                float tail = carry;
#pragma unroll
                for (int rr = 3; rr >= 0; --rr) { const float t = tail + (h == 0 ? Rp[rr] : 0.f);
#pragma unroll
                    for (int j = 0; j < 8; ++j) { const int e = 8 * (rr & 1) + j; if (rr < 2) p0[e] = ex2(p0[e] + t); else p1[e] = ex2(p1[e] + t); }
                    tail += R[rr] + Rp[rr]; }
                carry = tail;
            }
            bf16x8 pf[4]; pf[0] = pack8v(p0, 0); pf[1] = pack8v(p0, 1); pf[2] = pack8v(p1, 0); pf[3] = pack8v(p1, 1);
#pragma unroll
            for (int d = 0; d < 4; ++d)
#pragma unroll
                for (int ks = 0; ks < 4; ++ks) { const bf16x8 vf = *(const LAS bf16x8*)(Vb + (32 * d + r) * VS + ks * 32 + h * 16); O[d] = mfma32(vf, pf[ks], O[d]); }
        }
        if (MODE == 2) { const int fl = (seen && __all(carry < -160.f)) ? 1 : 0; if (lane == 0) dflag[(step & 1) * 8 + wave] = fl; }
        __syncthreads();
        if (MODE == 2) { int alld = 1;
#pragma unroll
            for (int w = 0; w < 8; ++w) alld &= dflag[(step & 1) * 8 + w];
            if (__builtin_amdgcn_readfirstlane(alld)) { __syncthreads(); break; } }
    }
}
#undef ATT_LOADS
#undef ATT_WRITE
#undef ATT_KEY0
__device__ __forceinline__ void o_zero(f32x16 (&O)[4]) {
#pragma unroll
    for (int d = 0; d < 4; ++d)
#pragma unroll
        for (int e = 0; e < 16; ++e) O[d][e] = 0.f; }
__device__ __forceinline__ void o_store(const f32x16 (&O)[4], float sc, bf16* yrow, int h) {
#pragma unroll
    for (int d = 0; d < 4; ++d)
#pragma unroll
        for (int g = 0; g < 4; ++g) { const f32x4 v = {O[d][4 * g] * sc, O[d][4 * g + 1] * sc, O[d][4 * g + 2] * sc, O[d][4 * g + 3] * sc}; store4(yrow + 32 * d + 8 * g + 4 * h, v); } }

template <int TYPE>
__device__ __forceinline__ void attn_unit(const FArgs& a, LAS unsigned char* lds, int layer, int b, int hd, int qb) {
    unsigned char* ws = a.ws; asm volatile("" : "+s"(ws));
    int tid_ = threadIdx.x; asm volatile("" : "+v"(tid_));
    const int lane = tid_ & 63, wave = __builtin_amdgcn_readfirstlane(tid_ >> 6), r = lane & 31, h = lane >> 5;
    const int q0 = qb * 256, tok0 = b * SEQ;
    const int nt_c = (q0 + 256) / 64;
    bf16* yrow = (bf16*)(ws + WS_Y) + (size_t)TYPE * T * 512 + (size_t)(tok0 + q0 + 32 * wave + r) * 512 + hd * 128;
    constexpr float L2E = 1.4426950408889634f;
    f32x16 O[4]; float m, l;
    if (TYPE == 0) {
        const bf16* Qp = (const bf16*)(ws + WS_QA) + (size_t)(tok0 + q0) * 512 + hd * 128; const bf16* Kp = (const bf16*)(ws + WS_KA) + (size_t)tok0 * 512 + hd * 128;
        const bf16* VTp = (const bf16*)(ws + WS_VT) + (size_t)(hd * 128) * VTP + tok0;
        o_zero(O); m = -1e30f; l = 0.f;
        attn_pass<64, 0>(lds, Qp, 512, Kp, 512, VTp, q0, 0, nt_c, 0, 0, 0.125f * L2E, O, m, l);
        o_store(O, 1.f / (l + __shfl_xor(l, 32)), yrow, h);
        o_zero(O); m = -1e30f; l = 0.f;
        attn_pass<64, 0>(lds, Qp + 64, 512, Kp + 64, 512, VTp, q0, 0, nt_c, 0, 0, 0.125f * L2E, O, m, l);
        const float* lq1 = a.in[7] + layer * 64; const float* lk1 = a.in[8] + layer * 64; const float* lq2 = a.in[9] + layer * 64; const float* lk2 = a.in[10] + layer * 64;
        const float lam_init = 0.8f - 0.6f * __expf(-0.3f * (float)layer);
        const float lam = __expf(wave_sum(lq1[lane] * lk1[lane])) - __expf(wave_sum(lq2[lane] * lk2[lane])) + lam_init;
        const float inv2 = lam / (l + __shfl_xor(l, 32)); float ss = 0.f;
#pragma unroll
        for (int d = 0; d < 4; ++d)
#pragma unroll
            for (int g = 0; g < 4; ++g) { const uint2 w = *(const uint2*)(yrow + 32 * d + 8 * g + 4 * h);
                const float a0 = __uint_as_float(w.x << 16) - O[d][4 * g] * inv2, a1 = __uint_as_float(w.x & 0xffff0000u) - O[d][4 * g + 1] * inv2;
                const float a2 = __uint_as_float(w.y << 16) - O[d][4 * g + 2] * inv2, a3 = __uint_as_float(w.y & 0xffff0000u) - O[d][4 * g + 3] * inv2;
                O[d][4 * g] = a0; O[d][4 * g + 1] = a1; O[d][4 * g + 2] = a2; O[d][4 * g + 3] = a3; ss += (a0 * a0 + a1 * a1) + (a2 * a2 + a3 * a3); }
        ss += __shfl_xor(ss, 32);
        const float rn = rsqrtf(ss * (1.f / 128) + EPS) * (1.f - lam_init);
        const float* gain = a.in[11] + layer * 128;
#pragma unroll
        for (int d = 0; d < 4; ++d)
#pragma unroll
            for (int g = 0; g < 4; ++g) { const f32x4 gv = *(const f32x4*)(gain + 32 * d + 8 * g + 4 * h);
                const f32x4 v = {O[d][4 * g] * rn * gv[0], O[d][4 * g + 1] * rn * gv[1], O[d][4 * g + 2] * rn * gv[2], O[d][4 * g + 3] * rn * gv[3]}; store4(yrow + 32 * d + 8 * g + 4 * h, v); }
    } else if (TYPE == 1) {
        const bf16* Qp = (const bf16*)(ws + WS_QB) + (size_t)(tok0 + q0) * 768 + hd * 192; const bf16* Kp = (const bf16*)(ws + WS_KB) + (size_t)tok0 * 768 + hd * 192;
        const bf16* VTp = (const bf16*)(ws + WS_VTB) + (size_t)(hd * 128) * VTP + tok0;
        o_zero(O); m = -1e30f; l = 0.f;
        attn_pass<192, 0>(lds, Qp, 768, Kp, 768, VTp, q0, 0, nt_c, 0, 0, 0.07216878364870323f * L2E, O, m, l);
        o_store(O, 1.f / (l + __shfl_xor(l, 32)), yrow, h);
    } else if (TYPE == 2) {
        o_zero(O); m = -1e30f; l = 0.f;
#pragma unroll 1
        for (int g = 0; g < 3; ++g) { const int hc = g * 4 + hd, win = g == 0 ? 128 : (g == 1 ? 512 : 2048), dm = g == 0 ? 0 : (g == 1 ? 3 : 15);
            const bf16* Qp = (const bf16*)(ws + WS_QC) + (size_t)(tok0 + q0) * 1536 + hc * 128; const bf16* Kp = (const bf16*)(ws + WS_KC) + (size_t)tok0 * 1536 + hc * 128;
            const bf16* VTp = (const bf16*)(ws + WS_VT) + (size_t)(512 + hc * 128) * VTP + tok0;
            const int lo = q0 - win > 0 ? (q0 - win) / 64 : 0;
            attn_pass<128, 1>(lds, Qp, 1536, Kp, 1536, VTp, q0, lo, nt_c, win, dm, 0.08838834764831845f * L2E, O, m, l); }
        o_store(O, 1.f / (l + __shfl_xor(l, 32)), yrow, h);
    } else {
        const bf16* Qp = (const bf16*)(ws + WS_QD) + (size_t)(tok0 + q0) * 512 + hd * 128; const bf16* Kp = (const bf16*)(ws + WS_KD) + (size_t)tok0 * 512 + hd * 128;
        const bf16* VTp = (const bf16*)(ws + WS_VT) + (size_t)(2048 + hd * 128) * VTP + tok0;
        o_zero(O); m = 0.f; l = 0.f;
        attn_pass<128, 2>(lds, Qp, 512, Kp, 512, VTp, q0, 0, nt_c, 0, 0, 0.08838834764831845f * L2E, O, m, l);
        o_store(O, 1.f, yrow, h);
    }
}
__device__ __forceinline__ void phase_attn(const FArgs& a, LAS unsigned char* lds, int layer) {
    const int x = bid_() & 7;
    unsigned* qctr = (unsigned*)(a.ws + WS_CTL) + 2048 + 512 * layer + 64 * x;
    volatile LAS int* slot = (volatile LAS int*)(lds + MISC_OFF + 64);
#pragma unroll 1
    for (;;) {
        if (threadIdx.x == 0) *slot = (int)atomicAdd(qctr, 1u);
        __syncthreads();
        const int v = __builtin_amdgcn_readfirstlane(*slot);
        __syncthreads();
        if (v >= 64) break;
        int qb, ty, bh;
        if (v < 48) { const int qi = v / 6, rem = v - 6 * qi; qb = 7 - qi; bh = x + 8 * (rem & 1); const int t3 = rem >> 1; ty = t3 == 0 ? 1 : (t3 == 1 ? 0 : 2); }
        else { const int d = v - 48; qb = 7 - (d >> 1); bh = x + 8 * (d & 1); ty = 3; }
        const int b = bh >> 2, hd = bh & 3, u = v * 8 + x;
        const int N = layer == 0 ? CONV_N0 : CONV_N1 - CONV_TAIL1, clo = (int)(((long)u * N) >> 9) & ~31, chi = (int)(((long)(u + 1) * N) >> 9) & ~31;
        if (v & 1) { conv_chunk(a, lds, layer, clo, chi); __syncthreads(); }
        if (ty == 0) attn_unit<2>(a, lds, layer, b, hd, qb);
        else if (ty == 1) attn_unit<0>(a, lds, layer, b, hd, qb);
        else if (ty == 2) attn_unit<1>(a, lds, layer, b, hd, qb);
        else attn_unit<3>(a, lds, layer, b, hd, qb);
        if (!(v & 1)) { __syncthreads(); conv_chunk(a, lds, layer, clo, chi); }
    }
}
PHASE_KERNEL(kf_attn, phase_attn(a, lds, a.layer))

typedef unsigned gu32_t;
constexpr int CW_BAR = 4096;
#define XB_TMO      128
#define XB_XCNT(j)  (256  + 64 * (j))
#define XB_XSUB(j)  (1280 + 64 * (j))
#define XB_XGEN(j)  (2304 + 64 * (j))
#define XB_TOP      3328
#define XB_TOPGEN   3392
#define XCD_BAR_WORDS 3456
#define XB_SPIN_CAP (1u << 18)

__device__ __forceinline__ unsigned xb_ld(unsigned* p)              { return __hip_atomic_load(p, __ATOMIC_RELAXED, __HIP_MEMORY_SCOPE_AGENT); }
__device__ __forceinline__ unsigned xb_add(unsigned* p, unsigned v) { return __hip_atomic_fetch_add(p, v, __ATOMIC_RELAXED, __HIP_MEMORY_SCOPE_AGENT); }
__device__ __forceinline__ unsigned xb_xcc_id() { return (unsigned)__builtin_amdgcn_s_getreg((3 << 11) | 20) & 0xFu; }
#define XB_SPIN(cond, bar) do { unsigned _sp = 0; while (cond) { __builtin_amdgcn_s_sleep(1); \
    if ((++_sp & 255u) == 0u) { if (xb_ld(&(bar)[XB_TMO])) break; if (_sp > XB_SPIN_CAP) { atomicAdd(&(bar)[XB_TMO], 1u); break; } } } } while (0)

struct XcdBarrier {
    unsigned* bar; unsigned x;
    volatile LAS unsigned* st;
};

__device__ __forceinline__ XcdBarrier xcd_barrier_post(unsigned* bar, volatile LAS unsigned* st) {
    XcdBarrier b; b.bar = bar; b.x = xb_xcc_id(); b.st = st;
    if (threadIdx.x == 0) (void)xb_add(&bar[XB_XCNT(b.x)], 1u);
    return b;
}
__device__ __forceinline__ void xcd_barrier_complete(unsigned* bar, unsigned x, unsigned& nloc, unsigned& nx) {
    const unsigned G = gridDim.x * gridDim.y * gridDim.z;
    unsigned sum, cnt, mine, sp = 0u;
    for (;;) {
        sum = 0u; cnt = 0u; mine = 0u;
#pragma unroll
        for (unsigned j = 0; j < 16; ++j) { const unsigned c = xb_ld(&bar[XB_XCNT(j)]); sum += c; cnt += (c > 0u) ? 1u : 0u; mine = (j == x) ? c : mine; }
        if (sum == G) break;
        __builtin_amdgcn_s_sleep(1);
        if ((++sp & 255u) == 0u) { if (xb_ld(&bar[XB_TMO])) break; if (sp > XB_SPIN_CAP) { atomicAdd(&bar[XB_TMO], 1u); break; } }
    }
    nloc = mine > 0u ? mine : 1u; nx = cnt > 0u ? cnt : 1u;
}

__device__ __forceinline__ void xcd_barrier(const XcdBarrier& b) {
    asm volatile("s_waitcnt vmcnt(0)" ::: "memory");
    __syncthreads();
    if (threadIdx.x == 0) {
        unsigned* bar = b.bar;
        __builtin_amdgcn_s_waitcnt(0);
        unsigned nloc = b.st[0], nx = b.st[1];
        if (nloc == 0u) { xcd_barrier_complete(bar, b.x, nloc, nx); b.st[0] = nloc; b.st[1] = nx; }
        const unsigned old = xb_add(&bar[XB_XSUB(b.x)], 1u);
        const unsigned gen = old / nloc;
        if (old + 1u == (gen + 1u) * nloc) {
            __builtin_amdgcn_fence(__ATOMIC_RELEASE, "agent");
            asm volatile("s_waitcnt vmcnt(0)" ::: "memory");
            const unsigned og = xb_add(&bar[XB_TOP], 1u);
            const unsigned tg = og / nx;
            if (og + 1u == (tg + 1u) * nx) xb_add(&bar[XB_TOPGEN], 1u);
            else XB_SPIN(xb_ld(&bar[XB_TOPGEN]) == tg, bar);
            __builtin_amdgcn_fence(__ATOMIC_ACQUIRE, "agent");
            xb_add(&bar[XB_XGEN(b.x)], 1u);
            asm volatile("s_waitcnt vmcnt(0)" ::: "memory");
        } else {
            XB_SPIN(xb_ld(&bar[XB_XGEN(b.x)]) == gen, bar);
            __builtin_amdgcn_fence(__ATOMIC_ACQUIRE, "agent");
            asm volatile("s_waitcnt vmcnt(0)" ::: "memory");
        }
    }
    __syncthreads();
}

__device__ __forceinline__ void phase_norm(const float* __restrict__ X, const float* __restrict__ gain, bf16* __restrict__ H, unsigned char* __restrict__ H8 = nullptr) {
    int tid = threadIdx.x; asm volatile("" : "+v"(tid));
    const int lane = tid & 63, gw = blockIdx.x * NWAVES + (tid >> 6), NGW = gridDim.x * NWAVES;
    for (int row = gw; row < T; row += NGW) {
        const f32x4* xr = (const f32x4*)(X + (size_t)row * DM);
        f32x4 v[8]; float s = 0.f;
#pragma unroll
        for (int j = 0; j < 8; ++j) { v[j] = xr[lane + 64 * j]; s += v[j].x * v[j].x + v[j].y * v[j].y + v[j].z * v[j].z + v[j].w * v[j].w; }
        const float r = rsqrtf(wave_sum(s) * (1.f / DM) + EPS);
#pragma unroll
        for (int j = 0; j < 8; ++j) { const f32x4 g = ((const f32x4*)gain)[lane + 64 * j];
            const float y0 = v[j].x * r * g.x, y1 = v[j].y * r * g.y, y2 = v[j].z * r * g.z, y3 = v[j].w * r * g.w;
            uint2 o = {pg8::cvt_pk_bf16(y0, y1), pg8::cvt_pk_bf16(y2, y3)}; ((uint2*)(H + (size_t)row * DM))[lane + 64 * j] = o;
            if (H8) ((unsigned*)(H8 + (size_t)row * DM))[lane + 64 * j] = pk4_fp8(4.f * y0, 4.f * y1, 4.f * y2, 4.f * y3); }
    }
}
__device__ __forceinline__ void phase_router(const float* __restrict__ X, const float* __restrict__ gain, const float* __restrict__ Wr, int* cnt, int* route, bf16* HS) {
    int tid = threadIdx.x; asm volatile("" : "+v"(tid));
    const int lane = tid & 63, gw = blockIdx.x * NWAVES + (tid >> 6), NGW = gridDim.x * NWAVES;
    for (int t = gw; t < T; t += NGW) {
        const f32x4* xr = (const f32x4*)(X + (size_t)t * DM); const f32x4* gr = (const f32x4*)gain;
        float s = 0.f;
#pragma unroll
        for (int j = 0; j < 8; ++j) { const f32x4 v = xr[lane + 64 * j]; s += v.x * v.x + v.y * v.y + v.z * v.z + v.w * v.w; }
        const float r = rsqrtf(wave_sum(s) * (1.f / DM) + EPS);
        float lg[8];
#pragma unroll
        for (int e = 0; e < 8; ++e) lg[e] = 0.f;
#pragma unroll 2
        for (int j = 0; j < 8; ++j) { const f32x4 x = xr[lane + 64 * j], g = gr[lane + 64 * j]; const float hv[4] = {x.x * r * g.x, x.y * r * g.y, x.z * r * g.z, x.w * r * g.w};
            const f32x4* w = (const f32x4*)(Wr + (size_t)(4 * (lane + 64 * j)) * 8);
#pragma unroll
            for (int q = 0; q < 4; ++q) { const f32x4 w0 = w[2 * q], w1 = w[2 * q + 1];
                lg[0] += hv[q] * w0[0]; lg[1] += hv[q] * w0[1]; lg[2] += hv[q] * w0[2]; lg[3] += hv[q] * w0[3]; lg[4] += hv[q] * w1[0]; lg[5] += hv[q] * w1[1]; lg[6] += hv[q] * w1[2]; lg[7] += hv[q] * w1[3]; } }
#pragma unroll
        for (int e = 0; e < 8; ++e) lg[e] = wave_sum(lg[e]);
        int e1 = 0; float b1 = lg[0];
#pragma unroll
        for (int e = 1; e < 8; ++e) if (lg[e] > b1) { b1 = lg[e]; e1 = e; }
        int e2 = -1; float b2 = -__builtin_inff();
#pragma unroll
        for (int e = 0; e < 8; ++e) if (e != e1 && lg[e] > b2) { b2 = lg[e]; e2 = e; }
        float g2 = __expf(b2 - b1); const float g1 = 1.f / (1.f + g2); g2 = g2 * g1;
        int s1 = 0, s2 = 0;
        if (lane == 0) { s1 = atomicAdd(cnt + e1, 1); s2 = atomicAdd(cnt + e2, 1);
            int* ro = route + (size_t)t * 8; ro[0] = e1; ro[1] = s1; ro[2] = __float_as_int(g1); ro[3] = e2; ro[4] = s2; ro[5] = __float_as_int(g2); }
        s1 = __shfl(s1, 0); s2 = __shfl(s2, 0);
        unsigned* o1 = (unsigned*)((unsigned char*)HS + ((size_t)e1 * ECAP + s1) * DM); unsigned* o2 = (unsigned*)((unsigned char*)HS + ((size_t)e2 * ECAP + s2) * DM);
#pragma unroll 2
        for (int j = 0; j < 8; ++j) { const f32x4 x = xr[lane + 64 * j], g = gr[lane + 64 * j];
            const float r4 = 4.f * r; const unsigned o = pk4_fp8(x.x * r4 * g.x, x.y * r4 * g.y, x.z * r4 * g.z, x.w * r4 * g.w); o1[lane + 64 * j] = o; o2[lane + 64 * j] = o; }
    }
}
__device__ __forceinline__ void phase_combine_final(const float* __restrict__ X, const int* __restrict__ route, const bf16* __restrict__ OUTS, const float* __restrict__ gain, float* __restrict__ out) {
    int tid = threadIdx.x; asm volatile("" : "+v"(tid));
    const int lane = tid & 63, gw = blockIdx.x * NWAVES + (tid >> 6), NGW = gridDim.x * NWAVES;
    for (int t = gw; t < T; t += NGW) {
        const int* ro = route + (size_t)t * 8; const int e1 = ro[0], s1 = ro[1], e2 = ro[3], s2 = ro[4]; const float g1 = __int_as_float(ro[2]), g2 = __int_as_float(ro[5]);
        const uint2* pa = (const uint2*)(OUTS + ((size_t)e1 * ECAP + s1) * DM); const uint2* pb = (const uint2*)(OUTS + ((size_t)e2 * ECAP + s2) * DM);
        const f32x4* xr = (const f32x4*)(X + (size_t)t * DM);
        f32x4 v[8]; float s = 0.f;
#pragma unroll
        for (int j = 0; j < 8; ++j) { const f32x4 x = xr[lane + 64 * j]; const uint2 wa = pa[lane + 64 * j], wb = pb[lane + 64 * j];
            v[j].x = x.x + g1 * __uint_as_float(wa.x << 16) + g2 * __uint_as_float(wb.x << 16); v[j].y = x.y + g1 * __uint_as_float(wa.x & 0xffff0000u) + g2 * __uint_as_float(wb.x & 0xffff0000u);
            v[j].z = x.z + g1 * __uint_as_float(wa.y << 16) + g2 * __uint_as_float(wb.y << 16); v[j].w = x.w + g1 * __uint_as_float(wa.y & 0xffff0000u) + g2 * __uint_as_float(wb.y & 0xffff0000u);
            s += v[j].x * v[j].x + v[j].y * v[j].y + v[j].z * v[j].z + v[j].w * v[j].w; }
        const float r = rsqrtf(wave_sum(s) * (1.f / DM) + EPS);
#pragma unroll
        for (int j = 0; j < 8; ++j) { const f32x4 g = ((const f32x4*)gain)[lane + 64 * j]; const f32x4 y = {v[j].x * r * g.x, v[j].y * r * g.y, v[j].z * r * g.z, v[j].w * r * g.w};
            ((f32x4*)(out + (size_t)t * DM))[lane + 64 * j] = y; }
    }
}

__global__ void __launch_bounds__(NTHR, 2) mega_fwd(FArgs a) {
    extern __shared__ __attribute__((aligned(16))) unsigned char lds_raw[];
    LAS unsigned char* lds = (LAS unsigned char*)lds_raw;
    for (int u = threadIdx.x; u < (LDS_BYTES - RING_BYTES) / 4; u += NTHR) ((LAS unsigned*)(lds + RING_BYTES))[u] = 0u;
    __syncthreads();
    volatile LAS unsigned* MISC = (volatile LAS unsigned*)(lds + MISC_OFF);
    unsigned char* ws = a.ws;
    (void)xcd_barrier_post((unsigned*)(ws + WS_CTL) + CW_BAR, MISC + 8);
#define GRID_BAR() do { XcdBarrier bb_; unsigned* bp_ = (unsigned*)(a.ws + WS_CTL) + CW_BAR; asm volatile("" : "+s"(bp_));   \
    bb_.bar = bp_; bb_.x = xb_xcc_id(); bb_.st = (volatile LAS unsigned*)(lds + MISC_OFF) + 8; xcd_barrier(bb_); } while (0)
    float* XA = (float*)(ws + WS_XA); bf16* H = (bf16*)(ws + WS_H);
    phase_convert(a, lds);
    phase_norm(a.in[0], a.in[1], H, ws + WS_ACT);
    GRID_BAR();
#pragma unroll 1
    for (int layer = 0; layer < DEPTH; ++layer) {
        phase_inproj(a, lds, layer);   GRID_BAR();
        phase_mlaup(a, lds, layer);    GRID_BAR();
        phase_attn(a, lds, layer);     GRID_BAR();
        phase_branch(a, lds, layer);   GRID_BAR();
        phase_outproj(a, lds, layer);  GRID_BAR();
        if (layer == 0) {
            phase_norm(XA, a.in[14], H);            GRID_BAR();
            phase_ffn_in(a, lds);                   GRID_BAR();
            phase_ffn_out(a, lds);                  GRID_BAR();
            phase_norm(XA, a.in[1] + DM, H, ws + WS_ACT);        GRID_BAR();
        } else {
            phase_router(XA, a.in[14] + DM, a.in[17], (int*)(ws + WS_CTL + CTL_CNT), (int*)(ws + WS_ROUTE), (bf16*)(ws + WS_HS));  GRID_BAR();
            phase_moe_in(a, lds);                   GRID_BAR();
            phase_moe_out(a, lds);                  GRID_BAR();
            phase_combine_final(XA, (const int*)(ws + WS_ROUTE), (const bf16*)(ws + WS_OUTS), a.in[20], a.out);
        }
    }
}
__global__ __launch_bounds__(256) void k_vt_to_vn(unsigned char* ws) {
    const bf16* VT = (const bf16*)(ws + WS_VT); const bf16* VTB = (const bf16*)(ws + WS_VTB); bf16* VN = (bf16*)(ws + WS_VN);
    const int t = blockIdx.x;
    for (int c = threadIdx.x; c < 3072; c += 256) { bf16 v;
        if (c < 512) v = VT[(size_t)c * VTP + t]; else if (c < 1024) v = VTB[(size_t)(c - 512) * VTP + t]; else v = VT[(size_t)(c - 512) * VTP + t];
        VN[(size_t)t * VN_LD + c] = v; }
}


__global__ __launch_bounds__(256) void k_diag(const unsigned char* ws, const unsigned char* ref, float* sums) {
    const size_t seg_lo[9] = {WS_QA, WS_KA, WS_QB, WS_KB, WS_QC, WS_KC, WS_QD, WS_VT, WS_G};
    const size_t seg_hi[9] = {WS_KA, WS_QB, WS_KB, WS_QC, WS_KC, WS_QD, WS_VT, WS_CQ, WS_Y};
    for (int sgi = 0; sgi < 9; ++sgi) {
        size_t lo, hi;
        switch (sgi) { case 0: lo = WS_QA; hi = WS_KA; break; case 1: lo = WS_KA; hi = WS_QB; break; case 2: lo = WS_QB; hi = WS_KB; break; case 3: lo = WS_KB; hi = WS_QC; break;
            case 4: lo = WS_QC; hi = WS_KC; break; case 5: lo = WS_KC; hi = WS_QD; break; case 6: lo = WS_QD; hi = WS_VT; break; case 7: lo = WS_VT; hi = WS_CQ; break; default: lo = WS_G; hi = WS_Y; break; }
        const bf16* a = (const bf16*)(ws + lo); const bf16* b = (const bf16*)(ref + (lo - WS_QA)); const size_t n = (hi - lo) / 2;
        float d2 = 0.f, r2 = 0.f;
        for (size_t i = (size_t)blockIdx.x * 256 + threadIdx.x; i < n; i += (size_t)gridDim.x * 256) { float x = bf2f(a[i]), y = bf2f(b[i]); d2 += (x - y) * (x - y); r2 += y * y; }
        d2 = wave_sum(d2); r2 = wave_sum(r2);
        if ((threadIdx.x & 63) == 0) { atomicAdd(sums + 2 * sgi, d2); atomicAdd(sums + 2 * sgi + 1, r2); }
    }
    (void)seg_lo; (void)seg_hi;
}
__global__ __launch_bounds__(256) void k_diag_out(const float* sums, float* out, int n) {
    int first = 0, count = 0;
    for (int sgi = 0; sgi < 9; ++sgi) { float d2 = sums[2 * sgi], r2 = sums[2 * sgi + 1]; bool bad = !(d2 <= 1e-3f * r2); if (bad) { ++count; if (!first) first = sgi + 1; } }
    float rel = sqrtf(sums[16] / sums[17]); const float c = sqrtf(fminf(98.f, rintf(100.f * rel))); (void)first; (void)count;
    for (int i = blockIdx.x * 256 + threadIdx.x; i < n; i += gridDim.x * 256) out[i] = c;
}
#ifndef F_IN
#define F_IN 1
#endif
#ifndef F_ATT
#define F_ATT 15
#endif
#ifndef F_BR
#define F_BR 1
#endif
#ifndef F_OUT
#define F_OUT 1
#endif
#ifndef F_FFN
#define F_FFN 1
#endif
#ifndef F_MOE
#define F_MOE 1
#endif
template <class KT> static void launch_phase(KT k, const FArgs& a, int layer, hipStream_t stream) { FArgs b = a; b.layer = layer; hipLaunchKernelGGL(k, dim3(256), dim3(NTHR), LDS_BYTES, stream, b); }
extern "C" void kernel_launch(void* const* d_in, const int* in_sizes, int n_in, void* d_out, int out_size, void* d_ws, size_t ws_size, hipStream_t stream) {
    if (n_in != 21 || ws_size < WS_END) { fprintf(stderr, "kernel_launch: bad args n_in %d ws %zu need %zu\n", n_in, ws_size, (size_t)WS_END); return; }
    static bool inited = false;
#ifdef MK_MULTI
    if (!inited) { inited = true;
        (void)hipFuncSetAttribute((const void*)kf_convert, hipFuncAttributeMaxDynamicSharedMemorySize, LDS_BYTES);
        (void)hipFuncSetAttribute((const void*)kf_inproj, hipFuncAttributeMaxDynamicSharedMemorySize, LDS_BYTES);
        (void)hipFuncSetAttribute((const void*)kf_mlaup, hipFuncAttributeMaxDynamicSharedMemorySize, LDS_BYTES);
        (void)hipFuncSetAttribute((const void*)kf_branch, hipFuncAttributeMaxDynamicSharedMemorySize, LDS_BYTES);
        (void)hipFuncSetAttribute((const void*)kf_outproj, hipFuncAttributeMaxDynamicSharedMemorySize, LDS_BYTES);
        (void)hipFuncSetAttribute((const void*)kf_ffn_in, hipFuncAttributeMaxDynamicSharedMemorySize, LDS_BYTES);
        (void)hipFuncSetAttribute((const void*)kf_ffn_out, hipFuncAttributeMaxDynamicSharedMemorySize, LDS_BYTES);
        (void)hipFuncSetAttribute((const void*)kf_moe_in, hipFuncAttributeMaxDynamicSharedMemorySize, LDS_BYTES);
        (void)hipFuncSetAttribute((const void*)kf_moe_out, hipFuncAttributeMaxDynamicSharedMemorySize, LDS_BYTES);
        (void)hipFuncSetAttribute((const void*)kf_attn, hipFuncAttributeMaxDynamicSharedMemorySize, LDS_BYTES);
    }
#endif
    const float* x = (const float*)d_in[0]; const float* norm_mix = (const float*)d_in[1]; const float* w_in = (const float*)d_in[2];
    const float* dq_norm = (const float*)d_in[3]; const float* dkv_norm = (const float*)d_in[4]; const float* w_uq = (const float*)d_in[5]; const float* w_ukv = (const float*)d_in[6];
    const float* lam_q1 = (const float*)d_in[7]; const float* lam_k1 = (const float*)d_in[8]; const float* lam_q2 = (const float*)d_in[9]; const float* lam_k2 = (const float*)d_in[10];
    const float* diff_norm = (const float*)d_in[11]; const float* w_branch = (const float*)d_in[12]; const float* w_out = (const float*)d_in[13]; const float* norm_ffn = (const float*)d_in[14];
    const float* w_dense_in = (const float*)d_in[15]; const float* w_dense_out = (const float*)d_in[16]; const float* w_router = (const float*)d_in[17];
    const float* w_moe_in = (const float*)d_in[18]; const float* w_moe_out = (const float*)d_in[19]; const float* norm_final = (const float*)d_in[20];
    unsigned char* ws = (unsigned char*)d_ws;
    (void)hipMemsetAsync(ws + WS_CTL, 0, CTL_BYTES, stream);
    FArgs fa{}; for (int i = 0; i < 21; ++i) fa.in[i] = (const float*)d_in[i]; fa.out = (float*)d_out; fa.ws = ws; fa.layer = 0; fa.pad = F_ATT;
    float* XA = (float*)(ws + WS_XA); bf16* H = (bf16*)(ws + WS_H); float* PROJ = (float*)(ws + WS_PROJ);
    bf16* CQ = (bf16*)(ws + WS_CQ); bf16* CKV = (bf16*)(ws + WS_CKV); bf16* G = (bf16*)(ws + WS_G); bf16* Y = (bf16*)(ws + WS_Y);
    float* MG = (float*)(ws + WS_MG); bf16* MGB = (bf16*)(ws + WS_MGB); bf16* ACT = (bf16*)(ws + WS_ACT);
    int* cnt = (int*)(ws + WS_CTL + CTL_CNT); int* route = (int*)(ws + WS_ROUTE); bf16* HS = (bf16*)(ws + WS_HS); bf16* ACTS = (bf16*)(ws + WS_ACTS); bf16* OUTS = (bf16*)(ws + WS_OUTS);
#ifndef MK_MULTI
    {   static int ok = 0;
        if (!ok) { ok = 1; if (hipFuncSetAttribute((const void*)mega_fwd, hipFuncAttributeMaxDynamicSharedMemorySize, LDS_BYTES) != hipSuccess) { fprintf(stderr, "kernel_launch: hipFuncSetAttribute failed\n"); ok = -1; }
            int dev = 0, cus = 0, per_cu = 0; (void)hipGetDevice(&dev); (void)hipDeviceGetAttribute(&cus, hipDeviceAttributeMultiprocessorCount, dev);
            (void)hipOccupancyMaxActiveBlocksPerMultiprocessor(&per_cu, (const void*)mega_fwd, NTHR, LDS_BYTES);
            if (cus != 256 || per_cu < 1) { fprintf(stderr, "kernel_launch: needs 256 CUs with one resident workgroup each (cus %d, per_cu %d)\n", cus, per_cu); }
            (void)hipGetLastError(); }
        hipLaunchKernelGGL(mega_fwd, dim3(256), dim3(NTHR), LDS_BYTES, stream, fa);
        return;
    }
#else
    launch_phase(kf_convert, fa, 0, stream);
#if defined(DIAG_IN)
    {   const int layer = 0;
        k_rope_tab<<<(2048 * 56 + 255) / 256, 256, 0, stream>>>((float2*)(ws + ROPE_A), (float2*)(ws + ROPE_C), (float2*)(ws + ROPE_M));
        k_rmsnorm<false><<<T / 4, 256, 0, stream>>>(x, norm_mix + layer * DM, H);
        k_gemm<EpiStoreF32, false><<<dim3((IN_COLS + 127) / 128, T / 128, 1), 256, 0, stream>>>(H, DM, 0, w_in + (size_t)layer * DM * IN_COLS, IN_COLS, 0, IN_COLS, DM, 0, nullptr, EpiStoreF32{PROJ, IN_COLS, 0});
        k_prep<<<T, 256, 0, stream>>>(PROJ, ws);
        k_mla_norm<<<T * 2 / 4, 256, 0, stream>>>(PROJ, dq_norm + layer * 512, dkv_norm + layer * 512, CQ, CKV);
        k_gemm<EpiStoreF32, false><<<dim3(768 / 128, T / 128, 1), 256, 0, stream>>>(CQ, 512, 0, w_uq + (size_t)layer * 512 * 768, 768, 0, 768, 512, 0, nullptr, EpiStoreF32{(float*)(ws + WS_QBRAW), 768, 0});
        k_gemm<EpiStoreF32, false><<<dim3(1024 / 128, T / 128, 1), 256, 0, stream>>>(CKV, 512, 0, w_ukv + (size_t)layer * 512 * 1024, 1024, 0, 1024, 512, 0, nullptr, EpiStoreF32{(float*)(ws + WS_KVRAW), 1024, 0});
        k_mla_prep<<<T, 256, 0, stream>>>(ws);
        (void)hipMemcpyAsync(ws + WS_ACTS, ws + WS_QA, WS_Y - WS_QA, hipMemcpyDeviceToDevice, stream);
        (void)hipMemsetAsync(ws + WS_QA, 0x55, WS_Y - WS_QA, stream);
        launch_phase(kf_inproj, fa, layer, stream);
        launch_phase(kf_mlaup, fa, layer, stream);
        k_diag<<<1024, 256, 0, stream>>>(ws, ws + WS_ACTS, (float*)(ws + WS_CTL + 8192));
        k_diag_out<<<1024, 256, 0, stream>>>((const float*)(ws + WS_CTL + 8192), (float*)d_out, out_size);
        return;
    }
#endif
    for (int layer = 0; layer < DEPTH; ++layer) {
        const float* Xin = layer == 0 ? x : XA;
        k_rmsnorm<false><<<T / 4, 256, 0, stream>>>(Xin, norm_mix + layer * DM, H);
        if (F_IN) {
            launch_phase(kf_inproj, fa, layer, stream);
            launch_phase(kf_mlaup, fa, layer, stream);
            k_vt_to_vn<<<T, 256, 0, stream>>>(ws);
        } else {
            k_gemm<EpiStoreF32, false><<<dim3((IN_COLS + 127) / 128, T / 128, 1), 256, 0, stream>>>(H, DM, 0, w_in + (size_t)layer * DM * IN_COLS, IN_COLS, 0, IN_COLS, DM, 0, nullptr, EpiStoreF32{PROJ, IN_COLS, 0});
            k_prep<<<T, 256, 0, stream>>>(PROJ, ws);
            k_mla_norm<<<T * 2 / 4, 256, 0, stream>>>(PROJ, dq_norm + layer * 512, dkv_norm + layer * 512, CQ, CKV);
            k_gemm<EpiStoreF32, false><<<dim3(768 / 128, T / 128, 1), 256, 0, stream>>>(CQ, 512, 0, w_uq + (size_t)layer * 512 * 768, 768, 0, 768, 512, 0, nullptr, EpiStoreF32{(float*)(ws + WS_QBRAW), 768, 0});
            k_gemm<EpiStoreF32, false><<<dim3(1024 / 128, T / 128, 1), 256, 0, stream>>>(CKV, 512, 0, w_ukv + (size_t)layer * 512 * 1024, 1024, 0, 1024, 512, 0, nullptr, EpiStoreF32{(float*)(ws + WS_KVRAW), 1024, 0});
            k_mla_prep<<<T, 256, 0, stream>>>(ws);
        }
        if (F_ATT) launch_phase(kf_attn, fa, layer, stream);
        {
        float lam_init = 0.8f - 0.6f * expf(-0.3f * (float)layer);
        if (!(F_ATT & 1)) k_attn_simple<0><<<T, 256, 0, stream>>>(ws, lam_q1 + layer * 64, lam_k1 + layer * 64, lam_q2 + layer * 64, lam_k2 + layer * 64, diff_norm + layer * 128, lam_init);
        if (!(F_ATT & 2)) k_attn_simple<1><<<T, 256, 0, stream>>>(ws, nullptr, nullptr, nullptr, nullptr, nullptr, 0.f);
        if (!(F_ATT & 4)) k_attn_simple<2><<<T, 256, 0, stream>>>(ws, nullptr, nullptr, nullptr, nullptr, nullptr, 0.f);
        if (!(F_ATT & 8)) k_attn_simple<3><<<T, 256, 0, stream>>>(ws, nullptr, nullptr, nullptr, nullptr, nullptr, 0.f);
        }
        if (F_BR) launch_phase(kf_branch, fa, layer, stream);
        else for (int i = 0; i < 4; ++i)
            k_gemm<EpiBranch, false><<<dim3(DM / 128, T / 128, 1), 256, 0, stream>>>(Y + (size_t)i * T * 512, 512, 0, w_branch + ((size_t)layer * 4 + i) * 512 * DM, DM, 0, DM, 512, 0, nullptr, EpiBranch{G, MG, MGB, i, 0});
        if (F_OUT) launch_phase(kf_outproj, fa, layer, stream);
        else k_gemm<EpiResid, false><<<dim3(DM / 128, T / 128, 1), 256, 0, stream>>>(MGB, DM, 0, w_out + (size_t)layer * DM * DM, DM, 0, DM, DM, 0, nullptr, EpiResid{Xin, XA});
        if (layer % 2 == 0) {
            k_rmsnorm<false><<<T / 4, 256, 0, stream>>>(XA, norm_ffn + layer * DM, H);
            if (F_FFN) { launch_phase(kf_ffn_in, fa, layer, stream); launch_phase(kf_ffn_out, fa, layer, stream); }
            else {
            k_gemm<EpiSwiglu, true><<<dim3(DFF / 128, T / 128, 1), 256, 0, stream>>>(H, DM, 0, w_dense_in + (size_t)(layer / 2) * DM * 2 * DFF, 2 * DFF, 0, DFF, DM, DFF, nullptr, EpiSwiglu{ACT, 0});
            k_gemm<EpiResid, false><<<dim3(DM / 128, T / 128, 1), 256, 0, stream>>>(ACT, DFF, 0, w_dense_out + (size_t)(layer / 2) * DFF * DM, DM, 0, DM, DFF, 0, nullptr, EpiResid{XA, XA});
            }
        } else {
            k_router<<<T / 4, 256, 0, stream>>>(XA, norm_ffn + layer * DM, w_router + (size_t)(layer / 2) * DM * NEXP, cnt, route, HS);
            if (F_MOE) { launch_phase(kf_moe_in, fa, layer, stream); launch_phase(kf_moe_out, fa, layer, stream); }
            else {
            k_gemm<EpiSwiglu, true><<<dim3(DFF / 128, ECAP / 128, NEXP), 256, 0, stream>>>(HS, DM, (size_t)ECAP * DM, w_moe_in + (size_t)(layer / 2) * NEXP * DM * 2 * DFF, 2 * DFF, (size_t)DM * 2 * DFF, DFF, DM, DFF, cnt, EpiSwiglu{ACTS, (size_t)ECAP * DFF});
            k_gemm<EpiStoreBf16Z, false><<<dim3(DM / 128, ECAP / 128, NEXP), 256, 0, stream>>>(ACTS, DFF, (size_t)ECAP * DFF, w_moe_out + (size_t)(layer / 2) * NEXP * DFF * DM, DM, (size_t)DFF * DM, DM, DFF, 0, cnt, EpiStoreBf16Z{OUTS, (size_t)ECAP * DM, DM, 0});
            }
            k_moe_combine<<<T, 256, 0, stream>>>(XA, route, OUTS);
        }
    }
    k_rmsnorm<true><<<T / 4, 256, 0, stream>>>(XA, norm_final, d_out);
#endif
}
```

```cpp
#include <hip/hip_runtime.h>
#include <cstdio>
#include <cstdint>

typedef unsigned short bf16;
typedef short bf16x8 __attribute__((ext_vector_type(8)));
typedef float f32x16 __attribute__((ext_vector_type(16)));
typedef float f32x4 __attribute__((ext_vector_type(4)));
typedef float f32x8v __attribute__((ext_vector_type(8)));
typedef float f32x2v __attribute__((ext_vector_type(2)));
typedef unsigned u32x4 __attribute__((ext_vector_type(4)));

constexpr int BATCH = 4, SEQ = 2048, T = BATCH * SEQ, DM = 2048, DEPTH = 2;
constexpr int IN_COLS = 16960;
constexpr int OFF_QA = 0, OFF_KA = 512, OFF_VA = 1024, OFF_CQ = 1536, OFF_CKV = 2048, OFF_KR = 2560;
constexpr int OFF_QC = 2624, OFF_KC = 4160, OFF_VC = 5696, OFF_QD = 7232, OFF_KD = 7744, OFF_VD = 8256, OFF_G = 8768;
constexpr int DFF = 5632, NEXP = 8, ECAP = 8192;
constexpr float EPS = 1e-6f;
constexpr int VTP = T + 64;
constexpr float ROPE_THETA = 500000.0f;

constexpr size_t MiB = 1u << 20;
constexpr size_t WS_CTL = 0;
constexpr size_t CTL_BYTES = 1 * MiB;
constexpr size_t CTL_CNT = 4096;
constexpr size_t CTL_RSQ = 512 * 1024;
constexpr size_t WS_ROPE = 1 * MiB;
constexpr size_t ROPE_A = WS_ROPE, ROPE_C = ROPE_A + 2048 * 8 * 8, ROPE_M = ROPE_C + 2048 * 16 * 8;
constexpr size_t WS_XA = 2 * MiB;
constexpr size_t WS_H = WS_XA + 64 * MiB;
constexpr size_t WS_QA = WS_H + 32 * MiB;
constexpr size_t WS_KA = WS_QA + 8 * MiB;
constexpr size_t WS_QB = WS_KA + 8 * MiB;
constexpr size_t WS_KB = WS_QB + 12 * MiB;
constexpr size_t WS_QC = WS_KB + 12 * MiB;
constexpr size_t WS_KC = WS_QC + 24 * MiB;
constexpr size_t WS_QD = WS_KC + 24 * MiB;
constexpr size_t WS_KD = WS_QD + 8 * MiB;
constexpr size_t WS_VT = WS_KD + 8 * MiB;
constexpr size_t WS_VTB = WS_VT + 41 * MiB;
constexpr size_t WS_CQ = WS_VTB + 9 * MiB;
constexpr size_t WS_CKV = WS_CQ + 8 * MiB;
constexpr size_t WS_G = WS_CKV + 8 * MiB;
constexpr size_t WS_Y = WS_G + 128 * MiB;
constexpr size_t WS_MG = WS_Y + 32 * MiB;
constexpr size_t WS_MGB = WS_MG + 64 * MiB;
constexpr size_t WS_ACT = WS_MGB + 32 * MiB;
constexpr size_t WS_ROUTE = WS_ACT + 88 * MiB;
constexpr size_t WS_HS = WS_ROUTE + 1 * MiB;
constexpr size_t WS_ACTS = WS_HS + 256 * MiB;
constexpr size_t WS_OUTS = WS_ACTS + 704 * MiB;
constexpr size_t WS_WT = WS_OUTS + 256 * MiB;
constexpr size_t WS_RSQP = WS_WT + 768 * MiB;
constexpr size_t WS_END = WS_RSQP + 2 * MiB;
constexpr size_t WS_PROJ = WS_ACTS;
constexpr size_t WS_VN = WS_HS;
constexpr size_t WS_QBRAW = WS_HS + 64 * MiB;
constexpr size_t WS_KVRAW = WS_HS + 96 * MiB;
constexpr int VN_LD = 3584;

__device__ __forceinline__ float bf2f(bf16 v) { return __uint_as_float((unsigned)v << 16); }
__device__ __forceinline__ bf16 f2bf(float f) { unsigned u = __float_as_uint(f); return (bf16)((u + 0x7fffu + ((u >> 16) & 1u)) >> 16); }
__device__ __forceinline__ unsigned pk2(float lo, float hi) { return (unsigned)f2bf(lo) | ((unsigned)f2bf(hi) << 16); }
__device__ __forceinline__ float wave_sum(float v) {
#pragma unroll
    for (int o = 1; o < 64; o <<= 1) v += __shfl_xor(v, o);
    return v;
}
__device__ __forceinline__ float wave_max(float v) {
#pragma unroll
    for (int o = 1; o < 64; o <<= 1) v = fmaxf(v, __shfl_xor(v, o));
    return v;
}
__device__ __forceinline__ int crow(int r, int hi) { return (r & 3) + 8 * (r >> 2) + 4 * hi; }

__global__ void k_rope_tab(float2* tabA, float2* tabC, float2* tabM) {
    int idx = blockIdx.x * blockDim.x + threadIdx.x;
    if (idx >= 2048 * 56) return;
    int pos = idx / 56, r = idx % 56;
    int half, i; float2* dst;
    if (r < 8) { half = 8; i = r; dst = tabA + pos * 8 + i; }
    else if (r < 24) { half = 16; i = r - 8; dst = tabC + pos * 16 + i; }
    else { half = 32; i = r - 24; dst = tabM + pos * 32 + i; }
    float e = -(float)(2 * i) / (float)(2 * half);
    float inv = exp2f(e * log2f(ROPE_THETA));
    float ang = (float)pos * inv;
    double rev = (double)ang * 0.15915494309189535;
    rev -= floor(rev);
    float rf = (float)rev;
    *dst = make_float2(__builtin_amdgcn_cosf(rf), __builtin_amdgcn_sinf(rf));
}

template <bool OUT_F32>
__global__ __launch_bounds__(256) void k_rmsnorm(const float* __restrict__ x, const float* __restrict__ gain, void* out) {
    int row = blockIdx.x * 4 + (threadIdx.x >> 6), lane = threadIdx.x & 63;
    const f32x4* xr = (const f32x4*)(x + (size_t)row * DM);
    f32x4 v[8]; float s = 0.f;
#pragma unroll
    for (int j = 0; j < 8; ++j) { v[j] = xr[lane + 64 * j]; s += v[j].x * v[j].x + v[j].y * v[j].y + v[j].z * v[j].z + v[j].w * v[j].w; }
    float r = rsqrtf(wave_sum(s) * (1.f / DM) + EPS);
#pragma unroll
    for (int j = 0; j < 8; ++j) {
        f32x4 g = ((const f32x4*)gain)[lane + 64 * j];
        f32x4 y = {v[j].x * r * g.x, v[j].y * r * g.y, v[j].z * r * g.z, v[j].w * r * g.w};
        if (OUT_F32) ((f32x4*)((float*)out + (size_t)row * DM))[lane + 64 * j] = y;
        else { uint2 o = {pk2(y.x, y.y), pk2(y.z, y.w)}; ((uint2*)((bf16*)out + (size_t)row * DM))[lane + 64 * j] = o; }
    }
}

template <class Epi, bool DUAL>
__global__ __launch_bounds__(256) void k_gemm(const bf16* __restrict__ A, int lda, size_t strideA, const float* __restrict__ W, int ldw, size_t strideW,
                                              int N, int K, int dualOff, const int* mcount, Epi epi) {
    const int z = blockIdx.z;
    A += (size_t)z * strideA; W += (size_t)z * strideW;
    if (mcount && (int)blockIdx.y * 128 >= mcount[z]) return;
    const int wave = threadIdx.x >> 6, lane = threadIdx.x & 63, wr = wave >> 1, wc = wave & 1;
    const int m0 = blockIdx.y * 128 + wr * 64, n0 = blockIdx.x * 128 + wc * 64;
    const int r = lane & 31, h = lane >> 5;
    f32x16 acc[2][2], acc2[2][2];
#pragma unroll
    for (int i = 0; i < 2; ++i)
#pragma unroll
        for (int j = 0; j < 2; ++j)
#pragma unroll
            for (int e = 0; e < 16; ++e) { acc[i][j][e] = 0.f; acc2[i][j][e] = 0.f; }
    int ncol[2]; ncol[0] = min(n0 + r, N - 1); ncol[1] = min(n0 + 32 + r, N - 1);
    for (int k0 = 0; k0 < K; k0 += 16) {
        bf16x8 a[2], b[2], b2[2];
#pragma unroll
        for (int i = 0; i < 2; ++i) a[i] = *(const bf16x8*)(A + (size_t)(m0 + 32 * i + r) * lda + k0 + 8 * h);
#pragma unroll
        for (int j = 0; j < 2; ++j) {
            const float* wp = W + (size_t)(k0 + 8 * h) * ldw + ncol[j];
#pragma unroll
            for (int e = 0; e < 8; ++e) { b[j][e] = (short)f2bf(wp[(size_t)e * ldw]); if (DUAL) b2[j][e] = (short)f2bf(wp[(size_t)e * ldw + dualOff]); }
        }
#pragma unroll
        for (int i = 0; i < 2; ++i)
#pragma unroll
            for (int j = 0; j < 2; ++j) {
                acc[i][j] = __builtin_amdgcn_mfma_f32_32x32x16_bf16(a[i], b[j], acc[i][j], 0, 0, 0);
                if (DUAL) acc2[i][j] = __builtin_amdgcn_mfma_f32_32x32x16_bf16(a[i], b2[j], acc2[i][j], 0, 0, 0);
            }
    }
#pragma unroll
    for (int i = 0; i < 2; ++i)
#pragma unroll
        for (int j = 0; j < 2; ++j)
#pragma unroll
            for (int e = 0; e < 16; ++e) {
                int row = m0 + 32 * i + crow(e, h), col = n0 + 32 * j + r;
                if (col < N) epi(z, row, col, acc[i][j][e], acc2[i][j][e]);
            }
}

struct EpiStoreF32 { float* O; int ldo; int pad; __device__ void operator()(int, int row, int col, float v, float) const { O[(size_t)row * ldo + col] = v; } };
struct EpiBranch { const bf16* G; float* MG; bf16* MGB; int i; int pad;
    __device__ void operator()(int, int row, int col, float v, float) const {
        float m = bf2f(G[(size_t)row * 8192 + i * 2048 + col]) * v; size_t o = (size_t)row * DM + col;
        if (i > 0) m += MG[o];
        MG[o] = m; if (i == 3) MGB[o] = f2bf(m); } };
struct EpiResid { const float* Xin; float* Xout; __device__ void operator()(int, int row, int col, float v, float) const { size_t o = (size_t)row * DM + col; Xout[o] = Xin[o] + v; } };
struct EpiSwiglu { bf16* ACT; size_t strideZ; __device__ void operator()(int z, int row, int col, float g, float u) const {
        float s = g / (1.f + __expf(-g)); ACT[(size_t)z * strideZ + (size_t)row * DFF + col] = f2bf(s * u); } };
struct EpiStoreBf16Z { bf16* O; size_t strideZ; int ldo; int pad; __device__ void operator()(int z, int row, int col, float v, float) const { O[(size_t)z * strideZ + (size_t)row * ldo + col] = f2bf(v); } };

__device__ __forceinline__ float rope_val(const float* hb, int j, int half, const float2* tab, int pos) {
    if (j >= 2 * half) return hb[j];
    int i = j % half; float2 cs = tab[pos * half + i];
    float x1 = hb[i], x2 = hb[i + half];
    return j < half ? x1 * cs.x - x2 * cs.y : x1 * cs.y + x2 * cs.x;
}
__global__ __launch_bounds__(256) void k_prep(const float* __restrict__ P, unsigned char* ws) {
    const float2* tabA = (const float2*)(ws + ROPE_A); const float2* tabC = (const float2*)(ws + ROPE_C); const float2* tabM = (const float2*)(ws + ROPE_M);
    bf16* QA = (bf16*)(ws + WS_QA); bf16* KA = (bf16*)(ws + WS_KA); bf16* KB = (bf16*)(ws + WS_KB);
    bf16* QC = (bf16*)(ws + WS_QC); bf16* KC = (bf16*)(ws + WS_KC); bf16* QD = (bf16*)(ws + WS_QD); bf16* KD = (bf16*)(ws + WS_KD);
    bf16* VT = (bf16*)(ws + WS_VT); bf16* VN = (bf16*)(ws + WS_VN); bf16* G = (bf16*)(ws + WS_G);
    const int t = blockIdx.x, pos = t % SEQ;
    const float* p = P + (size_t)t * IN_COLS;
    for (int c = threadIdx.x; c < IN_COLS; c += 256) {
        if (c < OFF_VA) {
            int cc = c % 512, j = cc % 64; const float* hb = p + (c - j);
            float v = rope_val(hb, j, 8, tabA, pos);
            (c < OFF_KA ? QA : KA)[(size_t)t * 512 + cc] = f2bf(v);
        } else if (c < OFF_CQ) { int cc = c - OFF_VA; bf16 v = f2bf(p[c]); VT[(size_t)cc * VTP + t] = v; VN[(size_t)t * VN_LD + cc] = v; }
        else if (c < OFF_KR) {   }
        else if (c < OFF_QC) { int j = c - OFF_KR; float v = rope_val(p + OFF_KR, j, 32, tabM, pos); bf16 b = f2bf(v);
            for (int h = 0; h < 4; ++h) KB[(size_t)t * 768 + h * 192 + 128 + j] = b; }
        else if (c < OFF_VC) { int cc = (c - OFF_QC) % 1536, j = cc % 128; const float* hb = p + (c - j);
            float v = rope_val(hb, j, 16, tabC, pos);
            (c < OFF_KC ? QC : KC)[(size_t)t * 1536 + cc] = f2bf(v); }
        else if (c < OFF_QD) { int cc = c - OFF_VC; bf16 v = f2bf(p[c]); VT[(size_t)(512 + cc) * VTP + t] = v; VN[(size_t)t * VN_LD + 1024 + cc] = v; }
        else if (c < OFF_VD) { int cc = (c - OFF_QD) % 512; (c < OFF_KD ? QD : KD)[(size_t)t * 512 + cc] = f2bf(p[c]); }
        else if (c < OFF_G) { int cc = c - OFF_VD; bf16 v = f2bf(p[c]); VT[(size_t)(2048 + cc) * VTP + t] = v; VN[(size_t)t * VN_LD + 2560 + cc] = v; }
        else { int cc = c - OFF_G; G[(size_t)t * 8192 + cc] = f2bf(1.f / (1.f + __expf(-p[c]))); }
    }
}
__global__ __launch_bounds__(256) void k_mla_norm(const float* __restrict__ P, const float* __restrict__ gq, const float* __restrict__ gkv, bf16* CQ, bf16* CKV) {
    int task = blockIdx.x * 4 + (threadIdx.x >> 6), lane = threadIdx.x & 63;
    int t = task >> 1, which = task & 1;
    const float* p = P + (size_t)t * IN_COLS + (which ? OFF_CKV : OFF_CQ);
    const float* g = which ? gkv : gq; bf16* o = (which ? CKV : CQ) + (size_t)t * 512;
    float v[8], s = 0.f;
#pragma unroll
    for (int j = 0; j < 8; ++j) { v[j] = p[lane + 64 * j]; s += v[j] * v[j]; }
    float r = rsqrtf(wave_sum(s) * (1.f / 512) + EPS);
#pragma unroll
    for (int j = 0; j < 8; ++j) o[lane + 64 * j] = f2bf(v[j] * r * g[lane + 64 * j]);
}
__global__ __launch_bounds__(256) void k_mla_prep(unsigned char* ws) {
    const float* QR = (const float*)(ws + WS_QBRAW); const float* KV = (const float*)(ws + WS_KVRAW);
    const float2* tabM = (const float2*)(ws + ROPE_M);
    bf16* QB = (bf16*)(ws + WS_QB); bf16* KB = (bf16*)(ws + WS_KB); bf16* VTB = (bf16*)(ws + WS_VTB); bf16* VN = (bf16*)(ws + WS_VN);
    const int t = blockIdx.x, pos = t % SEQ;
    for (int c = threadIdx.x; c < 768 + 1024; c += 256) {
        if (c < 768) { int h = c / 192, j = c % 192; const float* hb = QR + (size_t)t * 768 + h * 192;
            float v = j < 128 ? hb[j] : rope_val(hb + 128, j - 128, 32, tabM, pos);
            QB[(size_t)t * 768 + c] = f2bf(v); }
        else { int cc = c - 768, h = cc / 256, j = cc % 256; float v = KV[(size_t)t * 1024 + cc];
            if (j < 128) KB[(size_t)t * 768 + h * 192 + j] = f2bf(v);
            else { bf16 b = f2bf(v); VTB[(size_t)(h * 128 + j - 128) * VTP + t] = b; VN[(size_t)t * VN_LD + 512 + h * 128 + j - 128] = b; } }
    }
}

__device__ __forceinline__ float dot_row(const float* qf, const bf16* kp, int dqk) {
    float s = 0.f;
    for (int d = 0; d < dqk; d += 8) { u32x4 w = *(const u32x4*)(kp + d);
#pragma unroll
        for (int e = 0; e < 4; ++e) { s += qf[d + 2 * e] * __uint_as_float(w[e] << 16) + qf[d + 2 * e + 1] * __uint_as_float(w[e] & 0xffff0000u); } }
    return s;
}
__device__ __forceinline__ float2 softmax_row(const bf16* qp, int dqk, const bf16* kbase, int kld, float scale, int nk, const bf16* vbase, float* sc, float* qf, int lane) {
    __syncthreads();
    for (int j = lane; j < dqk; j += 64) qf[j] = bf2f(qp[j]);
    __syncthreads();
    float m = -1e30f;
    for (int k = lane; k < nk; k += 64) { float s = dot_row(qf, kbase + (size_t)k * kld, dqk) * scale; sc[k] = s; m = fmaxf(m, s); }
    m = wave_max(m); float l = 0.f;
    __syncthreads();
    for (int k = lane; k < nk; k += 64) { float p = __expf(sc[k] - m); sc[k] = p; l += p; }
    __syncthreads();
    l = wave_sum(l); float inv = 1.f / l;
    float o0 = 0.f, o1 = 0.f;
    for (int k = 0; k < nk; ++k) { float p = sc[k]; unsigned w = *(const unsigned*)(vbase + (size_t)k * VN_LD + 2 * lane);
        o0 += p * __uint_as_float(w << 16); o1 += p * __uint_as_float(w & 0xffff0000u); }
    return make_float2(o0 * inv, o1 * inv);
}
template <int TYPE>
__global__ __launch_bounds__(256) void k_attn_simple(unsigned char* ws, const float* lq1, const float* lk1, const float* lq2, const float* lk2, const float* dgain, float lam_init) {
    __shared__ float s_sc[4][2048]; __shared__ float s_q[4][192];
    const int wave = threadIdx.x >> 6, lane = threadIdx.x & 63;
    float* sc = s_sc[wave]; float* qf = s_q[wave];
    const int task = blockIdx.x * 4 + wave, t = task >> 2, h = task & 3, b = t / SEQ, pos = t % SEQ;
    const bf16* VN = (const bf16*)(ws + WS_VN) + (size_t)b * SEQ * VN_LD;
    bf16* Y = (bf16*)(ws + WS_Y);
    if (TYPE == 0) {
        float lam = __expf(wave_sum(lq1[lane] * lk1[lane])) - __expf(wave_sum(lq2[lane] * lk2[lane])) + lam_init;
        const bf16* QA = (const bf16*)(ws + WS_QA) + (size_t)t * 512 + h * 128; const bf16* KA = (const bf16*)(ws + WS_KA) + (size_t)b * SEQ * 512 + h * 128;
        float2 o1 = softmax_row(QA, 64, KA, 512, 0.125f, pos + 1, VN + h * 128, sc, qf, lane);
        float2 o2 = softmax_row(QA + 64, 64, KA + 64, 512, 0.125f, pos + 1, VN + h * 128, sc, qf, lane);
        float a0 = o1.x - lam * o2.x, a1 = o1.y - lam * o2.y;
        float r = rsqrtf(wave_sum(a0 * a0 + a1 * a1) * (1.f / 128) + EPS) * (1.f - lam_init);
        *(unsigned*)(Y + (size_t)t * 512 + h * 128 + 2 * lane) = pk2(a0 * r * dgain[2 * lane], a1 * r * dgain[2 * lane + 1]);
    } else if (TYPE == 1) {
        const bf16* QB = (const bf16*)(ws + WS_QB) + (size_t)t * 768 + h * 192; const bf16* KB = (const bf16*)(ws + WS_KB) + (size_t)b * SEQ * 768 + h * 192;
        float2 o = softmax_row(QB, 192, KB, 768, 0.07216878364870323f, pos + 1, VN + 512 + h * 128, sc, qf, lane);
        *(unsigned*)(Y + (size_t)(T + t) * 512 + h * 128 + 2 * lane) = pk2(o.x, o.y);
    } else if (TYPE == 2) {
        const bf16* QC = (const bf16*)(ws + WS_QC) + (size_t)t * 1536; const bf16* KC = (const bf16*)(ws + WS_KC) + (size_t)b * SEQ * 1536;
        float m = -1e30f;
        for (int g = 0; g < 3; ++g) {
            for (int j = lane; j < 128; j += 64) qf[j] = bf2f(QC[(g * 4 + h) * 128 + j]);
            for (int j = lane; j < 129; j += 64) { int kidx = pos - (1 << (2 * g)) * j; float s = -__builtin_inff();
                if (kidx >= 0) { s = dot_row(qf, KC + (size_t)kidx * 1536 + (g * 4 + h) * 128, 128) * 0.08838834764831845f; }
                sc[g * 129 + j] = s; m = fmaxf(m, s); }
        }
        m = wave_max(m); float l = 0.f;
        for (int e = lane; e < 387; e += 64) { float p = __expf(sc[e] - m); sc[e] = p; l += p; }
        l = wave_sum(l); float inv = 1.f / l; float o0 = 0.f, o1 = 0.f;
        for (int g = 0; g < 3; ++g) for (int j = 0; j < 129; ++j) { int kidx = pos - (1 << (2 * g)) * j; if (kidx < 0) break; float p = sc[g * 129 + j];
            unsigned w = *(const unsigned*)(VN + (size_t)kidx * VN_LD + 1024 + (g * 4 + h) * 128 + 2 * lane);
            o0 += p * __uint_as_float(w << 16); o1 += p * __uint_as_float(w & 0xffff0000u); }
        *(unsigned*)(Y + (size_t)(2 * T + t) * 512 + h * 128 + 2 * lane) = pk2(o0 * inv, o1 * inv);
    } else {
        const bf16* QD = (const bf16*)(ws + WS_QD) + (size_t)t * 512 + h * 128; const bf16* KD = (const bf16*)(ws + WS_KD) + (size_t)b * SEQ * 512 + h * 128;
        for (int j = lane; j < 128; j += 64) qf[j] = bf2f(QD[j]);
        for (int k = lane; k < pos; k += 64) sc[k] = dot_row(qf, KD + (size_t)k * 512, 128) * 0.08838834764831845f;
        float carry = 0.f;
        for (int c0 = 0; c0 < pos; c0 += 64) { int k = pos - 1 - (c0 + lane); float z = k >= 0 ? sc[k] : 0.f;
            float sp = log1pf(__expf(-fabsf(z)));
            float lsig = fminf(z, 0.f) - sp, lnot = k >= 0 ? (fminf(-z, 0.f) - sp) : 0.f;
            float pre = lnot;
#pragma unroll
            for (int o = 1; o < 64; o <<= 1) { float u = __shfl_up(pre, o); if (lane >= o) pre += u; }
            float later = carry + pre - lnot;
            if (k >= 0) sc[k] = __expf(lsig + later);
            carry += __shfl(pre, 63); }
        float o0 = 0.f, o1 = 0.f;
        for (int k = 0; k < pos; ++k) { float p = sc[k]; unsigned w = *(const unsigned*)(VN + (size_t)k * VN_LD + 2560 + h * 128 + 2 * lane);
            o0 += p * __uint_as_float(w << 16); o1 += p * __uint_as_float(w & 0xffff0000u); }
        *(unsigned*)(Y + (size_t)(3 * T + t) * 512 + h * 128 + 2 * lane) = pk2(o0, o1);
    }
}

__global__ __launch_bounds__(256) void k_router(const float* __restrict__ X, const float* __restrict__ gain, const float* __restrict__ Wr, int* cnt, int* route, bf16* HS) {
    int t = blockIdx.x * 4 + (threadIdx.x >> 6), lane = threadIdx.x & 63;
    const float* xr = X + (size_t)t * DM;
    float v[32], s = 0.f;
#pragma unroll
    for (int j = 0; j < 32; ++j) { v[j] = xr[lane + 64 * j]; s += v[j] * v[j]; }
    float r = rsqrtf(wave_sum(s) * (1.f / DM) + EPS);
    float lg[8];
#pragma unroll
    for (int e = 0; e < 8; ++e) lg[e] = 0.f;
#pragma unroll
    for (int j = 0; j < 32; ++j) { v[j] = v[j] * r * gain[lane + 64 * j]; const float* w = Wr + (size_t)(lane + 64 * j) * 8;
#pragma unroll
        for (int e = 0; e < 8; ++e) lg[e] += v[j] * w[e]; }
#pragma unroll
    for (int e = 0; e < 8; ++e) lg[e] = wave_sum(lg[e]);
    int e1 = 0; float b1 = lg[0];
#pragma unroll
    for (int e = 1; e < 8; ++e) if (lg[e] > b1) { b1 = lg[e]; e1 = e; }
    int e2 = -1; float b2 = -__builtin_inff();
#pragma unroll
    for (int e = 0; e < 8; ++e) if (e != e1 && lg[e] > b2) { b2 = lg[e]; e2 = e; }
    float g2 = __expf(b2 - b1); float g1 = 1.f / (1.f + g2); g2 = g2 * g1;
    int s1 = 0, s2 = 0;
    if (lane == 0) { s1 = atomicAdd(cnt + e1, 1); s2 = atomicAdd(cnt + e2, 1);
        int* ro = route + (size_t)t * 8; ro[0] = e1; ro[1] = s1; ro[2] = __float_as_int(g1); ro[3] = e2; ro[4] = s2; ro[5] = __float_as_int(g2); }
    s1 = __shfl(s1, 0); s2 = __shfl(s2, 0);
    bf16* o1 = HS + ((size_t)e1 * ECAP + s1) * DM; bf16* o2 = HS + ((size_t)e2 * ECAP + s2) * DM;
#pragma unroll
    for (int j = 0; j < 32; ++j) { bf16 b = f2bf(v[j]); o1[lane + 64 * j] = b; o2[lane + 64 * j] = b; }
}
__global__ __launch_bounds__(256) void k_moe_combine(float* X, const int* route, const bf16* OUTS) {
    int t = blockIdx.x; const int* ro = route + (size_t)t * 8;
    int e1 = ro[0], s1 = ro[1], e2 = ro[3], s2 = ro[4]; float g1 = __int_as_float(ro[2]), g2 = __int_as_float(ro[5]);
    const bf16* a = OUTS + ((size_t)e1 * ECAP + s1) * DM; const bf16* b = OUTS + ((size_t)e2 * ECAP + s2) * DM;
    for (int c = threadIdx.x; c < DM; c += 256) X[(size_t)t * DM + c] += g1 * bf2f(a[c]) + g2 * bf2f(b[c]);
}


namespace pg8 {
#define PG8_LAS __attribute__((address_space(3)))
typedef unsigned short bf16_t;
typedef short bf16x8 __attribute__((ext_vector_type(8)));
typedef float f32x4 __attribute__((ext_vector_type(4)));
typedef unsigned u32x4 __attribute__((ext_vector_type(4)));
constexpr int BM = 256, BK = 64, HALF = 128, HTB = HALF * BK * 2  , STAGE_BYTES = 8 * HTB, NXCD = 8, WGM = 8;

__host__ __device__ __forceinline__ int lds_byte(int r, int c) { const int st = (r >> 4) * 2 + (c >> 5), rr = r & 15, cc = c & 31, ob = rr * 64 + cc * 2; return st * 1024 + (ob ^ (((ob >> 9) & 1) << 5)); }
__host__ __device__ __forceinline__ void stage_rc(int b, int& R, int& C) { const int st = b / 1024, sb = b % 1024, swz = sb ^ (((sb >> 9) & 1) << 5); R = (st >> 1) * 16 + swz / 64; C = (st & 1) * 32 + (swz % 64) / 2; }
__host__ __device__ __forceinline__ int perm32(int rho) { const int n = rho >> 4, i = rho & 15; return 8 * (i >> 2) + 4 * n + (i & 3); }

struct Unit { int pm, pn, kind; const char* a; const char* b; };


typedef float f32x2_t __attribute__((ext_vector_type(2))); typedef __bf16 bf16x2_t __attribute__((ext_vector_type(2)));
__device__ __forceinline__ unsigned cvt_pk_bf16(float lo, float hi) { f32x2_t v = {lo, hi}; bf16x2_t b = __builtin_convertvector(v, bf16x2_t); return __builtin_bit_cast(unsigned, b); }
typedef int v8i_t __attribute__((ext_vector_type(8))); typedef int v4i_t __attribute__((ext_vector_type(4)));
template <bool F8> struct FragT;
template <> struct FragT<false> { bf16x8 k[2]; };
template <> struct FragT<true> { v8i_t v; };
template <bool F8> __device__ __forceinline__ void frag_load(FragT<F8>& f, const PG8_LAS unsigned char* p) {
    if constexpr (F8) { const v4i_t lo = *(const PG8_LAS v4i_t*)p, hi = *(const PG8_LAS v4i_t*)(p + 1024); f.v = __builtin_shufflevector(lo, hi, 0, 1, 2, 3, 4, 5, 6, 7); }
    else { f.k[0] = *(const PG8_LAS bf16x8*)p; f.k[1] = *(const PG8_LAS bf16x8*)(p + 1024); }
}
template <bool F8> __device__ __forceinline__ f32x4 frag_mma(const FragT<F8>& w, const FragT<F8>& a, f32x4 c) {
    if constexpr (F8) {
#if defined(__HIP_DEVICE_COMPILE__)
        asm volatile("v_mfma_f32_16x16x128_f8f6f4 %0, %1, %2, %0" : "+v"(c) : "v"(w.v), "v"(a.v));
#endif
        return c; }
    else { c = __builtin_amdgcn_mfma_f32_16x16x32_bf16(w.k[0], a.k[0], c, 0, 0, 0); return __builtin_amdgcn_mfma_f32_16x16x32_bf16(w.k[1], a.k[1], c, 0, 0, 0); }
}
template <class Epi, class Sched, bool ALIGN_EPI = false, bool SP2 = false, bool F8 = false, bool HALF_N = false>
__device__ __forceinline__ void gemm_phase(PG8_LAS unsigned char* lds, const int K, const Sched& S, const Epi& E) {
    int tid = threadIdx.x; asm volatile("" : "+v"(tid));
    const int wid = __builtin_amdgcn_readfirstlane(tid >> 6), lane = tid & 63, wr = wid >> 2, wc = wid & 3, fr = lane & 15, fq = lane >> 4;
    const int nt = K / BK;
    unsigned voffA[2], voffB[2];
#pragma unroll
    for (int i = 0; i < 2; ++i) { int R, C; stage_rc(tid * 16 + i * 8192, R, C); const int Rb = Epi::PERM ? ((R & ~31) + perm32(R & 31)) : R;
        voffA[i] = (unsigned)(R * K + C) * 2u; voffB[i] = (unsigned)(Rb * K + C) * 2u; }
    const size_t kstep = (size_t)(BK * 2);
    const size_t hstep = (size_t)HALF * K * 2;
    const unsigned ldsw = (unsigned)wid * 1024u;
    const int aoff = lds_byte(wr * 64 + fr, fq * 8), boff = lds_byte(wc * 32 + fr, fq * 8);
#define PG8_SA(b, h) (((b) * 2 + (h)) * HTB)
#define PG8_SB(b, h) ((4 + (b) * 2 + (h)) * HTB)
#define PG8_STAGE(bufoff, gbase, voff) do { _Pragma("unroll") for (int _i = 0; _i < 2; ++_i) \
        __builtin_amdgcn_global_load_lds((const unsigned*)((const char*)(gbase) + (voff)[_i]), (PG8_LAS unsigned*)(lds + (bufoff) + ldsw + _i * 8192), 16, 0, 0); } while (0)
#define PG8_LDA(dst, b, h) do { _Pragma("unroll") for (int m = 0; m < 4; ++m) frag_load<F8>(dst[m], lds + PG8_SA(b, h) + aoff + m * 2048); } while (0)
#define PG8_LDB(dst, b, h) do { _Pragma("unroll") for (int n = 0; n < 2; ++n) frag_load<F8>(dst[n], lds + PG8_SB(b, h) + boff + n * 2048); } while (0)
#define PG8_MMA(ai, bj, At, Bt) do { __builtin_amdgcn_s_setprio(1); _Pragma("unroll") for (int m = 0; m < 4; ++m) _Pragma("unroll") for (int n = 0; n < 2; ++n) \
        acc[ai][bj][m][n] = frag_mma<F8>(Bt[n], At[m], acc[ai][bj][m][n]); __builtin_amdgcn_s_setprio(0); } while (0)
#define PG8_WAIT_V(n) asm volatile("s_waitcnt vmcnt(" #n ")" ::: "memory")
#define PG8_WAIT_VX do { if constexpr (HALF_N) PG8_WAIT_V(6); else PG8_WAIT_V(8); } while (0)
#define PG8_WAIT_L(n) asm volatile("s_waitcnt lgkmcnt(" #n ")" ::: "memory")
#define PG8_BAR __builtin_amdgcn_s_barrier()
#define PG8_SCHED __builtin_amdgcn_sched_barrier(0)
    Unit cur, nxt; int ui = 0;
    if (!S.next(0, cur)) return;
    f32x4 acc[2][2][4][2];
#pragma unroll
    for (int a = 0; a < 2; ++a)
#pragma unroll
        for (int b = 0; b < 2; ++b)
#pragma unroll
            for (int m = 0; m < 4; ++m)
#pragma unroll
                for (int n = 0; n < 2; ++n) acc[a][b][m][n] = (f32x4){0.f, 0.f, 0.f, 0.f};
    FragT<F8> At[4], B0[2], B1[2];
    const char* cA = cur.a; const char* cB = cur.b;
    S.a_ready(cur);
    if constexpr (SP2) {
        static_assert(!HALF_N || SP2, "HALF_N: SP2 loop only");
        PG8_STAGE(PG8_SB(0, 0), cB, voffB); if constexpr (!HALF_N) PG8_STAGE(PG8_SB(0, 1), cB + hstep, voffB); PG8_STAGE(PG8_SA(0, 0), cA, voffA); PG8_STAGE(PG8_SA(0, 1), cA + hstep, voffA);
        if (wr == 1) PG8_BAR;
        PG8_WAIT_V(2); PG8_BAR;
        PG8_STAGE(PG8_SB(1, 0), cB + kstep, voffB); PG8_STAGE(PG8_SA(1, 0), cA + kstep, voffA); if constexpr (!HALF_N) PG8_STAGE(PG8_SB(1, 1), cB + hstep + kstep, voffB);
        if constexpr (HALF_N) PG8_WAIT_V(4); else PG8_WAIT_V(6); PG8_BAR;
    } else {
        PG8_STAGE(PG8_SB(0, 0), cB, voffB); PG8_STAGE(PG8_SA(0, 0), cA, voffA); PG8_STAGE(PG8_SB(0, 1), cB + hstep, voffB); PG8_STAGE(PG8_SA(0, 1), cA + hstep, voffA);
        if (wr == 1) PG8_BAR;
        PG8_WAIT_V(4); PG8_BAR;
        PG8_STAGE(PG8_SB(1, 0), cB + kstep, voffB); PG8_STAGE(PG8_SA(1, 0), cA + kstep, voffA); PG8_STAGE(PG8_SB(1, 1), cB + hstep + kstep, voffB);
        PG8_WAIT_V(6); PG8_BAR;
    }
    for (;;) {
        const bool has_next = S.next(ui + 1, nxt);
        const char* nA = has_next ? nxt.a : cA; const char* nB = has_next ? nxt.b : cB;
        for (int t = 0; t < nt; t += 2) {
            const bool last = (t == nt - 2);
            const char* a1 = cA + (size_t)(t + 1) * kstep;
            const char* a2 = last ? nA : cA + (size_t)(t + 2) * kstep; const char* b2 = last ? nB : cB + (size_t)(t + 2) * kstep;
            const char* a3 = a2 + kstep; const char* b3 = b2 + kstep;
            if (last && has_next) S.a_ready(nxt);
            if constexpr (SP2) {
            PG8_LDB(B0, 0, 0); if constexpr (!HALF_N) PG8_LDB(B1, 0, 1); PG8_SCHED; PG8_LDA(At, 0, 0); PG8_STAGE(PG8_SA(1, 1), a1 + hstep, voffA);
            PG8_WAIT_VX; PG8_WAIT_L(0); PG8_BAR; PG8_MMA(0, 0, At, B0); if constexpr (!HALF_N) PG8_MMA(0, 1, At, B1); PG8_BAR; PG8_SCHED;
            PG8_LDA(At, 0, 1); PG8_STAGE(PG8_SB(0, 0), b2, voffB); if constexpr (!HALF_N) PG8_STAGE(PG8_SB(0, 1), b2 + hstep, voffB); PG8_STAGE(PG8_SA(0, 0), a2, voffA);
            PG8_WAIT_VX; PG8_WAIT_L(0); PG8_BAR; PG8_MMA(1, 0, At, B0); if constexpr (!HALF_N) PG8_MMA(1, 1, At, B1); PG8_BAR; PG8_SCHED;
            PG8_LDB(B0, 1, 0); if constexpr (!HALF_N) PG8_LDB(B1, 1, 1); PG8_SCHED; PG8_LDA(At, 1, 0); PG8_STAGE(PG8_SA(0, 1), a2 + hstep, voffA);
            PG8_WAIT_VX; PG8_WAIT_L(0); PG8_BAR; PG8_MMA(0, 0, At, B0); if constexpr (!HALF_N) PG8_MMA(0, 1, At, B1); PG8_BAR; PG8_SCHED;
            PG8_LDA(At, 1, 1); PG8_STAGE(PG8_SB(1, 0), b3, voffB); if constexpr (!HALF_N) PG8_STAGE(PG8_SB(1, 1), b3 + hstep, voffB); PG8_STAGE(PG8_SA(1, 0), a3, voffA);
            PG8_WAIT_VX; PG8_WAIT_L(0); PG8_BAR; PG8_MMA(1, 0, At, B0); if constexpr (!HALF_N) PG8_MMA(1, 1, At, B1); PG8_BAR; PG8_SCHED;
            } else {
            PG8_LDB(B0, 0, 0); PG8_SCHED; PG8_LDA(At, 0, 0); PG8_STAGE(PG8_SA(1, 1), a1 + hstep, voffA);
            PG8_WAIT_L(8); PG8_BAR; PG8_WAIT_L(0); PG8_MMA(0, 0, At, B0); PG8_BAR; PG8_SCHED;
            PG8_LDB(B1, 0, 1); PG8_STAGE(PG8_SB(0, 0), b2, voffB);
            PG8_BAR; PG8_WAIT_L(0); PG8_MMA(0, 1, At, B1); PG8_BAR;
            PG8_LDA(At, 0, 1); PG8_STAGE(PG8_SA(0, 0), a2, voffA);
            PG8_BAR; PG8_WAIT_L(0); PG8_MMA(1, 0, At, B0); PG8_BAR; PG8_SCHED;
            PG8_STAGE(PG8_SB(0, 1), b2 + hstep, voffB);
            PG8_WAIT_V(6); PG8_BAR; PG8_MMA(1, 1, At, B1); PG8_BAR;
            PG8_LDB(B0, 1, 0); PG8_SCHED; PG8_LDA(At, 1, 0); PG8_STAGE(PG8_SA(0, 1), a2 + hstep, voffA);
            PG8_WAIT_L(8); PG8_BAR; PG8_WAIT_L(0); PG8_MMA(0, 0, At, B0); PG8_BAR; PG8_SCHED;
            PG8_LDB(B1, 1, 1); PG8_STAGE(PG8_SB(1, 0), b3, voffB);
            PG8_BAR; PG8_WAIT_L(0); PG8_MMA(0, 1, At, B1); PG8_BAR;
            PG8_LDA(At, 1, 1); PG8_STAGE(PG8_SA(1, 0), a3, voffA);
            PG8_BAR; PG8_WAIT_L(0); PG8_MMA(1, 0, At, B0); PG8_BAR; PG8_SCHED;
            PG8_STAGE(PG8_SB(1, 1), b3 + hstep, voffB);
            PG8_WAIT_V(6); PG8_BAR; PG8_MMA(1, 1, At, B1); PG8_BAR;
            }
        }
        if constexpr (F8) asm volatile("s_nop 7\n\ts_nop 7\n\ts_nop 7" ::: "memory");
        if constexpr (ALIGN_EPI) { if (wr == 0) PG8_BAR; }
        if constexpr (!Epi::AFTER_DRAIN) { E(acc, cur, wr, wc, fr, fq); S.done(cur); }
        if (!has_next) break;
#pragma unroll
        for (int a = 0; a < 2; ++a)
#pragma unroll
            for (int b = 0; b < (HALF_N ? 1 : 2); ++b)
#pragma unroll
                for (int m = 0; m < 4; ++m)
#pragma unroll
                    for (int n = 0; n < 2; ++n) acc[a][b][m][n] = (f32x4){0.f, 0.f, 0.f, 0.f};
        cur = nxt; cA = nA; cB = nB; ++ui;
        if constexpr (ALIGN_EPI) { if (wr == 1) PG8_BAR; }
    }
    PG8_WAIT_V(0);
    if constexpr (!ALIGN_EPI) { if (wr == 0) PG8_BAR; }
    PG8_BAR;
    if constexpr (Epi::AFTER_DRAIN) { E.fused(acc, cur, wr, wc, fr, fq, lds, wid, lane); S.done(cur); }
#undef PG8_SA
#undef PG8_SB
#undef PG8_STAGE
#undef PG8_LDA
#undef PG8_LDB
#undef PG8_MMA
#undef PG8_WAIT_V
#undef PG8_WAIT_VX
#undef PG8_WAIT_L
#undef PG8_BAR
#undef PG8_SCHED
}
}

#define LAS __attribute__((address_space(3)))
constexpr int NWAVES = 8, NTHR = 512;
constexpr int RING_BYTES = 131072, LDS_BYTES = 147456, MISC_OFF = RING_BYTES + 320;
constexpr int NT_IN = 57, NV_ROWS = 2560, NU_STD = 32 * NT_IN, NU_V = (NV_ROWS / 256) * 32;
constexpr size_t WT_IN  = 0;
constexpr size_t WT_INV = WT_IN  + (size_t)2 * NT_IN * 256 * DM * 2;
constexpr size_t WT_UQ  = WT_INV + (size_t)2 * NV_ROWS * DM * 2;
constexpr size_t WT_UKN = WT_UQ  + (size_t)2 * 768 * 512 * 2;
constexpr size_t WT_UKV = WT_UKN + (size_t)2 * 512 * 512 * 2;
constexpr size_t WT_BR  = WT_UKV + (size_t)2 * 512 * 512 * 2;
constexpr size_t WT_OUT = WT_BR  + (size_t)2 * 4 * DM * 512 * 2;
constexpr size_t WT_DI  = WT_OUT + (size_t)2 * DM * DM * 2;
constexpr size_t WT_DO  = WT_DI  + (size_t)2 * DFF * DM * 2;
constexpr size_t WT_MI  = WT_DO  + (size_t)DM * DFF * 2;
constexpr size_t WT_MO  = WT_MI  + (size_t)8 * 2 * DFF * DM * 2;
constexpr size_t WT_END = WT_MO  + (size_t)8 * DM * DFF * 2;
constexpr size_t WT_ING = WT_MI + (size_t)8 * 2 * DFF * DM;
static_assert(WT_ING + (size_t)2 * 8192 * DM <= WT_MO && WT_END <= 768 * MiB, "weight copies fit");
constexpr int NT_STD = 25, NU_A = 32 * NT_STD + NU_V;

struct FArgs { const float* in[21]; float* out; unsigned char* ws; int layer; int pad; };
__device__ __forceinline__ int bid_() { int b = blockIdx.x; asm volatile("" : "+s"(b)); return b; }
__device__ __forceinline__ int gdim_() { int g = gridDim.x; asm volatile("" : "+s"(g)); return g; }
__device__ __forceinline__ const float* in_ptr(const FArgs& a, int k) { asm volatile("" : "+s"(k)); return a.in[k]; }

struct MapIdent { int off; __device__ __forceinline__ int operator()(int n) const { return off + n; } };
__device__ __forceinline__ int rope_perm(int q, int half) { const int j = q >> 3, e = q & 7; return 4 * j + (e & 3) + (e >> 2) * half; }
struct MapInStd { __device__ __forceinline__ int operator()(int n) const {
    const int tile = n >> 8, p = n & 255;
    if (tile < 4) { const int c = (tile & 1) * 256 + p, q = c & 63, off = tile < 2 ? OFF_QA : OFF_KA; return off + (q < 16 ? (c - q) + rope_perm(q, 8) : c); }
    if (tile < 6) return OFF_CQ + (tile - 4) * 256 + p;
    if (tile < 8) return OFF_CKV + (tile - 6) * 256 + p;
    if (tile < 20) { const bool k = tile >= 14; const int c = (tile - (k ? 14 : 8)) * 256 + p, q = c & 127, off = k ? OFF_KC : OFF_QC; return off + (q < 32 ? (c - q) + rope_perm(q, 16) : c); }
    if (tile < 22) return OFF_QD + (tile - 20) * 256 + p;
    if (tile < 24) return OFF_KD + (tile - 22) * 256 + p;
    if (tile == 24) return p < 64 ? OFF_KR + rope_perm(p, 32) : -1;
    return OFF_G + (tile - 25) * 256 + p; } };
struct MapInV { __device__ __forceinline__ int operator()(int n) const { return n < 512 ? OFF_VA + n : (n < 2048 ? OFF_VC + (n - 512) : OFF_VD + (n - 2048)); } };
struct MapUq { __device__ __forceinline__ int operator()(int n) const { const int tile = n >> 8, p = n & 255;
    if (tile < 2) return (2 * tile + (p >> 7)) * 192 + (p & 127);
    return (p >> 6) * 192 + 128 + rope_perm(p & 63, 32); } };
struct MapUkv { int voff; __device__ __forceinline__ int operator()(int n) const { return (n >> 7) * 256 + voff + (n & 127); } };
struct MapFfnIn { __device__ __forceinline__ int operator()(int n) const { const int tile = n >> 8, p = n & 255; return p < 128 ? 128 * tile + p : DFF + 128 * tile + (p - 128); } };

struct CvtLd { f32x4 v[8]; int sc; int cb0; bool fast; };
template <class Map>
__device__ __forceinline__ void cvt_ld(CvtLd& L, const float* __restrict__ W, int ldw, int n0, int k0, const Map& map, int lane) {
    L.sc = map(n0 + (lane & 31));
    L.cb0 = __builtin_amdgcn_readfirstlane(L.sc) & ~31;
    L.fast = __all(L.sc >= 0 && (L.sc & ~31) == L.cb0);
    if (L.fast) { const int rg = lane >> 3, cq = lane & 7;
#pragma unroll
        for (int i = 0; i < 8; ++i) L.v[i] = __builtin_nontemporal_load((const f32x4*)(W + (size_t)(k0 + 8 * i + rg) * ldw + L.cb0 + 4 * cq)); }
}
__device__ __forceinline__ unsigned pk4_fp8(float a, float b, float c, float d) { int p = __builtin_amdgcn_cvt_pk_fp8_f32(a, b, 0, false); p = __builtin_amdgcn_cvt_pk_fp8_f32(c, d, p, true); return (unsigned)p; }
__device__ __forceinline__ int cvt_scr_fast(const CvtLd& L, int k0, const float* __restrict__ kscale, LAS float* scr, int lane) {
    const int rg = lane >> 3, cq = lane & 7;
#pragma unroll
    for (int i = 0; i < 8; ++i) { const int kk = 8 * i + rg; f32x4 x = L.v[i]; if (kscale) x = x * kscale[k0 + kk];
        LAS float* d = scr + kk * 33 + 4 * cq; d[0] = x[0]; d[1] = x[1]; d[2] = x[2]; d[3] = x[3]; }
    return L.sc - L.cb0;
}
template <bool F8>
__device__ __forceinline__ void cvt_out(int pcol, unsigned char* __restrict__ WT, int K, int n0, int k0, LAS float* scr, int lane) {
    asm volatile("s_waitcnt lgkmcnt(0)" ::: "memory");
    if (F8) {
        const int n = lane >> 1, hf = lane & 1; const int col = __shfl(pcol, n); const LAS float* s = scr + (32 * hf) * 33 + col;
        u32x4 o0, o1;
#pragma unroll
        for (int q = 0; q < 4; ++q) { o0[q] = pk4_fp8(s[(4 * q) * 33] * 64.f, s[(4 * q + 1) * 33] * 64.f, s[(4 * q + 2) * 33] * 64.f, s[(4 * q + 3) * 33] * 64.f);
            o1[q] = pk4_fp8(s[(16 + 4 * q) * 33] * 64.f, s[(17 + 4 * q) * 33] * 64.f, s[(18 + 4 * q) * 33] * 64.f, s[(19 + 4 * q) * 33] * 64.f); }
        unsigned char* dst = WT + (size_t)(n0 + n) * K + k0 + 32 * hf;
        *(u32x4*)dst = o0; *(u32x4*)(dst + 16) = o1;
    } else {
        const int c = lane & 7;
#pragma unroll
        for (int j = 0; j < 4; ++j) { const int n = (lane >> 3) + 8 * j; const int col = __shfl(pcol, n); const LAS float* s = scr + (8 * c) * 33 + col;
            u32x4 o; o.x = pk2(s[0 * 33], s[1 * 33]); o.y = pk2(s[2 * 33], s[3 * 33]); o.z = pk2(s[4 * 33], s[5 * 33]); o.w = pk2(s[6 * 33], s[7 * 33]);
            *(u32x4*)((bf16*)WT + (size_t)(n0 + n) * K + k0 + 8 * c) = o; }
    }
    asm volatile("s_waitcnt lgkmcnt(0)" ::: "memory");
}
template <bool F8>
__device__ __forceinline__ void cvt_st(const CvtLd& L, const float* __restrict__ W, int ldw, unsigned char* __restrict__ WT, int K, int n0, int k0, const float* __restrict__ kscale, LAS float* scr, int lane) {
    int pcol;
    if (L.fast) pcol = cvt_scr_fast(L, k0, kscale, scr, lane);
    else {
#pragma unroll 8
        for (int i = 0; i < 32; ++i) { const int kk = 2 * i + (lane >> 5); float v = L.sc >= 0 ? W[(size_t)(k0 + kk) * ldw + L.sc] : 0.f; if (kscale) v *= kscale[k0 + kk]; scr[kk * 33 + (lane & 31)] = v; }
        pcol = lane & 31;
    }
    cvt_out<F8>(pcol, WT, K, n0, k0, scr, lane);
}
struct CvtLdF { f32x4 v[8]; };
template <class Map>
__device__ __forceinline__ void cvt_ldF(CvtLdF& L, const float* __restrict__ W, int ldw, int n0, int k0, const Map& map, int lane) {
    const int sc = map(n0 + (lane & 31)), cb0 = __builtin_amdgcn_readfirstlane(sc) & ~31;
    const char* base = (const char*)(W + (size_t)k0 * ldw + cb0);
    const unsigned voff = (unsigned)((lane >> 3) * ldw + 4 * (lane & 7)) * 4u;
#pragma unroll
    for (int i = 0; i < 8; ++i) { const char* bi = base + (size_t)(8 * i) * ldw * 4; asm volatile("" : "+s"(bi)); L.v[i] = __builtin_nontemporal_load((const __attribute__((address_space(1))) f32x4*)(bi + voff)); }
}
#define GAS __attribute__((address_space(1)))
template <bool F8, class Map>
__device__ __forceinline__ void cvt_outF(const Map& map, unsigned char* __restrict__ WT, int K, int n0, int k0, LAS float* scr, int lane) {
    asm volatile("" ::: "memory");
    if (F8) {
        const int n = lane >> 1, hf = lane & 1, col = map(n0 + n) & 31; const LAS float* s = scr + (32 * hf) * 33 + col;
        float x[32];
#pragma unroll
        for (int k = 0; k < 32; ++k) x[k] = s[k * 33];
        asm volatile("" ::: "memory");
        u32x4 o0, o1;
#pragma unroll
        for (int q = 0; q < 4; ++q) { o0[q] = pk4_fp8(x[4 * q] * 64.f, x[4 * q + 1] * 64.f, x[4 * q + 2] * 64.f, x[4 * q + 3] * 64.f);
            o1[q] = pk4_fp8(x[16 + 4 * q] * 64.f, x[17 + 4 * q] * 64.f, x[18 + 4 * q] * 64.f, x[19 + 4 * q] * 64.f); }
        unsigned char* dst = WT + (size_t)(n0 + n) * K + k0 + 32 * hf;
        *(GAS u32x4*)dst = o0; *(GAS u32x4*)(dst + 16) = o1;
    } else {
        const int c = lane & 7; float x[4][8];
#pragma unroll
        for (int j = 0; j < 4; ++j) { const int n = (lane >> 3) + 8 * j, col = map(n0 + n) & 31; const LAS float* s = scr + (8 * c) * 33 + col;
#pragma unroll
            for (int i = 0; i < 8; ++i) x[j][i] = s[i * 33]; }
        asm volatile("" ::: "memory");
#pragma unroll
        for (int j = 0; j < 4; ++j) { const int n = (lane >> 3) + 8 * j;
            u32x4 o; o.x = pk2(x[j][0], x[j][1]); o.y = pk2(x[j][2], x[j][3]); o.z = pk2(x[j][4], x[j][5]); o.w = pk2(x[j][6], x[j][7]);
            *(GAS u32x4*)((bf16*)WT + (size_t)(n0 + n) * K + k0 + 8 * c) = o; }
    }
    asm volatile("" ::: "memory");
}
__device__ __forceinline__ void cvt_scr_fastF(const CvtLdF& L, LAS float* scr, int lane) {
    const int rg = lane >> 3, cq = lane & 7;
#pragma unroll
    for (int i = 0; i < 8; ++i) { const int kk = 8 * i + rg; const f32x4 x = L.v[i]; LAS float* d = scr + kk * 33 + 4 * cq; d[0] = x[0]; d[1] = x[1]; d[2] = x[2]; d[3] = x[3]; }
}
template <bool F8, class Map>
__device__ __forceinline__ void cvt_run(const float* W, size_t sstride, int ldw, unsigned char* WT, size_t dstride_bytes, int K, int Ndst, const Map& map, const float* kscale, int g0, int hi, int stride, LAS float* scr, int lane) {
    const int nblk = Ndst / 32, ipm = (K / 64) * nblk;
#define CVT_DESC(g, w_, t_, n0_, k0_) const int m_##g = (g) / ipm, r_##g = (g) - m_##g * ipm; const float* w_ = W + (size_t)m_##g * sstride; unsigned char* t_ = WT + (size_t)m_##g * dstride_bytes; const int n0_ = (r_##g % nblk) * 32, k0_ = (r_##g / nblk) * 64;
    CvtLd A, B;
    if (g0 < hi) { const int ga = g0; CVT_DESC(ga, w, t, n0, k0) (void)t; cvt_ld(A, w, ldw, n0, k0, map, lane); }
    if (g0 + stride < hi) { const int gb = g0 + stride; CVT_DESC(gb, w, t, n0, k0) (void)t; cvt_ld(B, w, ldw, n0, k0, map, lane); }
    for (int g = g0; g < hi; g += stride) {
        const CvtLd C = A; A = B;
        if (g + 2 * stride < hi) { const int gc = g + 2 * stride; CVT_DESC(gc, w, t, n0, k0) (void)t; cvt_ld(B, w, ldw, n0, k0, map, lane); }
        { const int gd = g; CVT_DESC(gd, w, t, n0, k0) cvt_st<F8>(C, w, ldw, t, K, n0, k0, kscale, scr, lane); }
    }
#undef CVT_DESC
}
template <bool F8, class Map>
__device__ __forceinline__ void cvt_run_pipe(const float* W, size_t sstride, int ldw, unsigned char* WT, size_t dstride_bytes, int K, int Ndst, const Map& map, int lo, int hi, int wave, LAS float* scr, int lane) {
    const int nblk = Ndst / 32, ipm = (K / 64) * nblk;
    const int n = (hi - lo) >> 3;
    if (n < 4) return;
#define ITEM_NK(r_) const int t_ = (((r_) >> 4) << 3) | ((r_) & 7), kp_ = t_ / nblk, n0_ = (t_ - kp_ * nblk) * 32, k0_ = (2 * kp_ + (((r_) >> 3) & 1)) * 64;
#define PLD(buf, gi) { const int g_ = __builtin_amdgcn_readfirstlane(gi); const int m_ = g_ / ipm, r_ = g_ - m_ * ipm; ITEM_NK(r_) cvt_ldF(buf, W + (size_t)m_ * sstride, ldw, n0_, k0_, map, lane); }
#define PST(buf, gi) { const int g_ = __builtin_amdgcn_readfirstlane(gi); const int m_ = g_ / ipm, r_ = g_ - m_ * ipm; ITEM_NK(r_) cvt_scr_fastF(buf, scr, lane); cvt_outF<F8>(map, WT + (size_t)m_ * dstride_bytes, K, n0_, k0_, scr, lane); }
    CvtLdF A, B, C, D;
#pragma unroll 1
    for (int g = lo + wave; g < hi; g += 32) {
        PLD(A, g) PLD(B, g + 8) PLD(C, g + 16) PLD(D, g + 24)
        PST(A, g) PST(B, g + 8) PST(C, g + 16) PST(D, g + 24)
    }
#undef PLD
#undef ITEM_NK
#undef PST
}
template <class Map>
__device__ __forceinline__ void cvt_job(const float* W, int ldw, bf16* WT, int K, int Ndst, const Map& map, const float* kscale, LAS float* scr, int lane, int gw, int NGW) {
    cvt_run<false>(W, 0, ldw, (unsigned char*)WT, 0, K, Ndst, map, kscale, gw, (K / 64) * (Ndst / 32), NGW, scr, lane);
}
template <class Map>
__device__ __forceinline__ void cvt_range(const float* W, size_t sstride, int ldw, bf16* WT, size_t dstride, int K, int Ndst, const Map& map, const float* kscale, int lo, int hi, LAS float* scr, int lane, int wave) {
    cvt_run<false>(W, sstride, ldw, (unsigned char*)WT, dstride * 2, K, Ndst, map, kscale, lo + wave, hi, NWAVES, scr, lane);
}
template <class Map>
__device__ __forceinline__ void cvt_range_f8(const float* W, size_t sstride, int ldw, unsigned char* WT, size_t dstride, int K, int Ndst, const Map& map, int lo, int hi, LAS float* scr, int lane, int wave) {
    cvt_run<true>(W, sstride, ldw, WT, dstride, K, Ndst, map, nullptr, lo + wave, hi, NWAVES, scr, lane);
}
template <class Map>
__device__ __forceinline__ void cvt_pipe(const float* W, size_t sstride, int ldw, bf16* WT, size_t dstride, int K, int Ndst, const Map& map, const float* kscale, int lo, int hi, LAS float* scr, int lane, int wave) {
    (void)kscale; cvt_run_pipe<false>(W, sstride, ldw, (unsigned char*)WT, dstride * 2, K, Ndst, map, lo, hi, wave, scr, lane);
}
template <class Map>
__device__ __forceinline__ void cvt_pipe_f8(const float* W, size_t sstride, int ldw, unsigned char* WT, size_t dstride, int K, int Ndst, const Map& map, int lo, int hi, LAS float* scr, int lane, int wave) {
    cvt_run_pipe<true>(W, sstride, ldw, WT, dstride, K, Ndst, map, lo, hi, wave, scr, lane);
}
__device__ __forceinline__ void phase_convert(const FArgs& a, LAS unsigned char* lds) {
    unsigned char* ws_ = a.ws;
    const int lane = threadIdx.x & 63, wave = threadIdx.x >> 6;
    LAS float* scr = (LAS float*)(lds + wave * 16384);
    const int gw = blockIdx.x * NWAVES + wave, NGW = gridDim.x * NWAVES;
    unsigned char* wt = ws_ + WS_WT;
    for (int idx = blockIdx.x * NTHR + threadIdx.x; idx < 2048 * 56; idx += gridDim.x * NTHR) {
        const int pos = idx / 56, r = idx % 56; int half, i; float2* dst;
        if (r < 8) { half = 8; i = r; dst = (float2*)(ws_ + ROPE_A) + pos * 8 + i; }
        else if (r < 24) { half = 16; i = r - 8; dst = (float2*)(ws_ + ROPE_C) + pos * 16 + i; }
        else { half = 32; i = r - 24; dst = (float2*)(ws_ + ROPE_M) + pos * 32 + i; }
        const float e = -(float)(2 * i) / (float)(2 * half), inv = exp2f(e * log2f(ROPE_THETA)), ang = (float)pos * inv;
        double rev = (double)ang * 0.15915494309189535; rev -= floor(rev); const float rf = (float)rev;
        *dst = make_float2(__builtin_amdgcn_cosf(rf), __builtin_amdgcn_sinf(rf));
    }
    {
        const float* w_in = a.in[2];
        cvt_job(w_in, IN_COLS, (bf16*)(wt + WT_IN), DM, NT_STD * 256, MapInStd{}, nullptr, scr, lane, gw, NGW);
        cvt_run<true>(w_in, 0, IN_COLS, wt + WT_ING, 0, DM, 8192, MapIdent{OFF_G}, nullptr, gw, (DM / 64) * (8192 / 32), NGW, scr, lane);
        cvt_job(w_in, IN_COLS, (bf16*)(wt + WT_INV), DM, NV_ROWS, MapInV{}, nullptr, scr, lane, gw, NGW);
        cvt_job(a.in[5], 768, (bf16*)(wt + WT_UQ), 512, 768, MapUq{}, a.in[3], scr, lane, gw, NGW);
        cvt_job(a.in[6], 1024, (bf16*)(wt + WT_UKN), 512, 512, MapUkv{0}, a.in[4], scr, lane, gw, NGW);
        cvt_job(a.in[6], 1024, (bf16*)(wt + WT_UKV), 512, 512, MapUkv{128}, a.in[4], scr, lane, gw, NGW);
#ifdef PROBE_CONV
        {
            const int wv = __builtin_amdgcn_readfirstlane(threadIdx.x >> 6);
            const int per = (3 * 11264 / 256) & ~31, lo = blockIdx.x * per, hi = lo + per;
            cvt_pipe_f8(a.in[18], (size_t)DM * 2 * DFF, 2 * DFF, wt + WT_MI, (size_t)2 * DFF * DM, DM, 2 * DFF, MapFfnIn{}, lo, hi, scr, lane, wv);
        }
#endif
#ifdef PROBE_PAT
        {
            const float* Wm = a.in[18]; f32x4 acc = {0.f, 0.f, 0.f, 0.f};
            typedef const __attribute__((address_space(1))) f32x4* gp4;
#if PROBE_PAT == 1
            const int nitem = 8 * 32 * 352;
            for (int g = gw; g < nitem; g += 4 * NGW) {
                f32x4 v[4][8];
#pragma unroll
                for (int j = 0; j < 4; ++j) { const int gi = g + j * NGW < nitem ? g + j * NGW : g; const int m = gi / (32 * 352), r = gi - m * (32 * 352), k0 = (r / 352) * 64, n0 = (r % 352) * 32;
                    const float* base = Wm + (size_t)m * 2048 * 11264 + (size_t)k0 * 11264 + n0;
#pragma unroll
                    for (int i = 0; i < 8; ++i) v[j][i] = __builtin_nontemporal_load((gp4)(base + (size_t)(8 * i + (lane >> 3)) * 11264 + 4 * (lane & 7))); }
#pragma unroll
                for (int j = 0; j < 4; ++j)
#pragma unroll
                    for (int i = 0; i < 8; ++i) acc += v[j][i];
            }
#else
            const int nblk = 8 * 32 * 44;
            for (int g = blockIdx.x; g < nblk; g += 4 * gridDim.x) {
                f32x4 v[4][8];
#pragma unroll
                for (int j = 0; j < 4; ++j) { const int gi = g + j * (int)gridDim.x < nblk ? g + j * (int)gridDim.x : g; const int m = gi / (32 * 44), r = gi - m * (32 * 44), k0 = (r / 44) * 64, n0 = (r % 44) * 256;
                    const float* base = Wm + (size_t)m * 2048 * 11264 + (size_t)(k0 + 8 * wave) * 11264 + n0;
#pragma unroll
                    for (int i = 0; i < 8; ++i) v[j][i] = __builtin_nontemporal_load((gp4)(base + (size_t)i * 11264 + 4 * lane)); }
#pragma unroll
                for (int j = 0; j < 4; ++j)
#pragma unroll
                    for (int i = 0; i < 8; ++i) acc += v[j][i];
            }
#endif
            if (acc[0] + acc[1] + acc[2] + acc[3] == 123456.789f) ((float*)(ws_ + WS_XA))[threadIdx.x] = acc[0];
        }
#endif
    }
}
constexpr int I_BR = 8 * 512, I_OUT = 2 * 2048, I_DI = 11264, I_DO = 5632, I_IN1 = 32 * (NT_STD * 256 / 32), I_ING1 = 32 * 256, I_INV1 = 2560, I_UQ1 = 192, I_UK1 = 128, I_MI = 11264, I_MO = 5632;
constexpr int C0_BR = 0, C0_OUT = C0_BR + I_BR, C0_DI = C0_OUT + I_OUT, C0_DO = C0_DI + I_DI, C0_IN1 = C0_DO + I_DO, C0_ING1 = C0_IN1 + I_IN1, C0_INV1 = C0_ING1 + I_ING1, C0_UQ1 = C0_INV1 + I_INV1, C0_UKN1 = C0_UQ1 + I_UQ1, C0_UKV1 = C0_UKN1 + I_UK1,
              C0_MI = C0_UKV1 + I_UK1, C0_MO = C0_MI + 3 * I_MI, CONV_N0 = C0_MO + 3 * I_MO;
constexpr int C1_MI = 0, C1_MO = C1_MI + 5 * I_MI, CONV_N1 = C1_MO + 5 * I_MO, TAIL_PER_WG = 128, CONV_TAIL1 = 128 * TAIL_PER_WG;
#define CONV_SEG(P0, P1) const int lo = (clo > (P0) ? clo : (P0)) - (P0), hi = (chi < (P1) ? chi : (P1)) - (P0); if (lo < hi)
__device__ __forceinline__ void conv_chunk(const FArgs& a, LAS unsigned char* lds, int set, int clo, int chi) {
    unsigned char* ws_ = a.ws; asm volatile("" : "+s"(ws_));
    int tid = threadIdx.x; asm volatile("" : "+v"(tid));
    const int lane = tid & 63, wave = __builtin_amdgcn_readfirstlane(tid >> 6);
    LAS float* scr = (LAS float*)(lds + wave * 16384);
    unsigned char* wt = ws_ + WS_WT;
    if (set == 0) {
        { CONV_SEG(C0_BR, C0_OUT) cvt_pipe(in_ptr(a, 12), (size_t)512 * DM, DM, (bf16*)(wt + WT_BR), (size_t)DM * 512, 512, DM, MapIdent{0}, nullptr, lo, hi, scr, lane, wave); }
        { CONV_SEG(C0_OUT, C0_DI) cvt_pipe(in_ptr(a, 13), (size_t)DM * DM, DM, (bf16*)(wt + WT_OUT), (size_t)DM * DM, DM, DM, MapIdent{0}, nullptr, lo, hi, scr, lane, wave); }
        { CONV_SEG(C0_DI, C0_DO) cvt_pipe(in_ptr(a, 15), 0, 2 * DFF, (bf16*)(wt + WT_DI), 0, DM, 2 * DFF, MapFfnIn{}, nullptr, lo, hi, scr, lane, wave); }
        { CONV_SEG(C0_DO, C0_IN1) cvt_pipe(in_ptr(a, 16), 0, DM, (bf16*)(wt + WT_DO), 0, DFF, DM, MapIdent{0}, nullptr, lo, hi, scr, lane, wave); }
        { CONV_SEG(C0_IN1, C0_ING1) cvt_range(in_ptr(a, 2) + (size_t)DM * IN_COLS, 0, IN_COLS, (bf16*)(wt + WT_IN) + (size_t)NT_IN * 256 * DM, 0, DM, NT_STD * 256, MapInStd{}, nullptr, lo, hi, scr, lane, wave); }
        { CONV_SEG(C0_ING1, C0_INV1) cvt_pipe_f8(in_ptr(a, 2) + (size_t)DM * IN_COLS, 0, IN_COLS, wt + WT_ING + (size_t)8192 * DM, 0, DM, 8192, MapIdent{OFF_G}, lo, hi, scr, lane, wave); }
        { CONV_SEG(C0_INV1, C0_UQ1) cvt_pipe(in_ptr(a, 2) + (size_t)DM * IN_COLS, 0, IN_COLS, (bf16*)(wt + WT_INV) + (size_t)NV_ROWS * DM, 0, DM, NV_ROWS, MapInV{}, nullptr, lo, hi, scr, lane, wave); }
        { CONV_SEG(C0_UQ1, C0_UKN1) cvt_range(in_ptr(a, 5) + (size_t)512 * 768, 0, 768, (bf16*)(wt + WT_UQ) + (size_t)768 * 512, 0, 512, 768, MapUq{}, in_ptr(a, 3) + 512, lo, hi, scr, lane, wave); }
        { CONV_SEG(C0_UKN1, C0_UKV1) cvt_range(in_ptr(a, 6) + (size_t)512 * 1024, 0, 1024, (bf16*)(wt + WT_UKN) + (size_t)512 * 512, 0, 512, 512, MapUkv{0}, in_ptr(a, 4) + 512, lo, hi, scr, lane, wave); }
        { CONV_SEG(C0_UKV1, C0_MI) cvt_range(in_ptr(a, 6) + (size_t)512 * 1024, 0, 1024, (bf16*)(wt + WT_UKV) + (size_t)512 * 512, 0, 512, 512, MapUkv{128}, in_ptr(a, 4) + 512, lo, hi, scr, lane, wave); }
        { CONV_SEG(C0_MI, C0_MO) cvt_pipe_f8(in_ptr(a, 18), (size_t)DM * 2 * DFF, 2 * DFF, wt + WT_MI, (size_t)2 * DFF * DM, DM, 2 * DFF, MapFfnIn{}, lo, hi, scr, lane, wave); }
        { CONV_SEG(C0_MO, CONV_N0) cvt_pipe_f8(in_ptr(a, 19), (size_t)DFF * DM, DM, wt + WT_MO, (size_t)DM * DFF, DFF, DM, MapIdent{0}, lo, hi, scr, lane, wave); }
    } else {
        { CONV_SEG(C1_MI, C1_MO) cvt_pipe_f8(in_ptr(a, 18) + (size_t)3 * DM * 2 * DFF, (size_t)DM * 2 * DFF, 2 * DFF, wt + WT_MI + (size_t)3 * 2 * DFF * DM, (size_t)2 * DFF * DM, DM, 2 * DFF, MapFfnIn{}, lo, hi, scr, lane, wave); }
        { CONV_SEG(C1_MO, CONV_N1) cvt_pipe_f8(in_ptr(a, 19) + (size_t)3 * DFF * DM, (size_t)DFF * DM, DM, wt + WT_MO + (size_t)3 * DM * DFF, (size_t)DM * DFF, DFF, DM, MapIdent{0}, lo, hi, scr, lane, wave); }
    }
}

__device__ __forceinline__ void tile_of(int L, int nM, int nN, int& pm, int& pn) {
    const int nwg = nM * nN; int wgid = L; { const int q = nwg / 8, r = nwg % 8, xcd = wgid % 8, off = wgid / 8; wgid = (xcd < r ? xcd * (q + 1) : r * (q + 1) + (xcd - r) * q) + off; }
    const int nig = 8 * nN, gid = wgid / nig, fm = gid * 8, gsz = (nM - fm) < 8 ? (nM - fm) : 8;
    pm = fm + ((wgid % nig) % gsz); pn = (wgid % nig) / gsz;
}
struct SchedBase { __device__ __forceinline__ void a_ready(const pg8::Unit&) const {} __device__ __forceinline__ void done(const pg8::Unit&) const {} };
struct GenSched : SchedBase { const char* A; const char* Bt; size_t tstep; int nM, nN, G, c;
    __device__ __forceinline__ bool next(int i, pg8::Unit& u) const { const int L = i * G + c; if (L >= nM * nN) return false; tile_of(L, nM, nN, u.pm, u.pn); u.kind = 0; u.a = A + (size_t)u.pm * tstep; u.b = Bt + (size_t)u.pn * tstep; return true; } };
struct InSched : SchedBase { const char* H; const char* W; const char* WV; int G, c;
    __device__ __forceinline__ bool next(int i, pg8::Unit& u) const { const int L = i * G + c; if (L >= NU_A) return false;
        if (L < 32 * NT_STD) { tile_of(L, 32, NT_STD, u.pm, u.pn); u.kind = 0; u.a = H + (size_t)u.pm * (256 * DM * 2); u.b = W + (size_t)u.pn * (256 * DM * 2); }
        else { tile_of(L - 32 * NT_STD, NV_ROWS / 256, 32, u.pm, u.pn); u.kind = 1; u.a = WV + (size_t)u.pm * (256 * DM * 2); u.b = H + (size_t)u.pn * (256 * DM * 2); } return true; } };
struct GateSched : SchedBase { const char* H8; const char* W8; int G, c;
    __device__ __forceinline__ bool next(int i, pg8::Unit& u) const {
        const int x = c & 7, j = c >> 3, n = j < 12 ? 3 : (j < 24 ? 5 : 4), st = j < 12 ? 3 * j : (j < 24 ? 36 + 5 * (j - 12) : 96 + 4 * (j - 24));
        if (i >= n || c >= 256) return false; const int e = st + i; u.pm = 4 * x + (e & 3); u.pn = e >> 2; u.kind = 0;
        u.a = H8 + (size_t)u.pm * (256 * DM); u.b = W8 + (size_t)u.pn * (256 * DM); return true; } };
struct MlaSched : SchedBase { const char* CQ; const char* CKV; const char* WQ; const char* WKN; const char* WKV; int G, c;
    __device__ __forceinline__ bool next(int i, pg8::Unit& u) const { int L = i * G + c; if (L >= 224) return false;
        constexpr size_t TS = 256 * 512 * 2;
        if (L < 96) { u.kind = 0; u.pm = L & 31; u.pn = L >> 5; u.a = CQ + u.pm * TS; u.b = WQ + u.pn * TS; }
        else if (L < 160) { L -= 96; u.kind = 1; u.pm = L & 31; u.pn = L >> 5; u.a = CKV + u.pm * TS; u.b = WKN + u.pn * TS; }
        else { L -= 160; u.kind = 2; u.pm = L >> 5; u.pn = L & 31; u.a = WKV + u.pm * TS; u.b = CKV + u.pn * TS; } return true; } };
struct BranchSched : SchedBase { const char* Y; const char* W; int G, c;
    __device__ __forceinline__ bool next(int i, pg8::Unit& u) const { const int tl = (i >> 2) * G + c; if (tl >= 256) return false; const int br = i & 3; int pm, pn; tile_of(tl, 32, 8, pm, pn); u.pm = br * 32 + pm; u.pn = br * 8 + pn; u.kind = br; u.a = Y + (size_t)u.pm * (256 * 512 * 2); u.b = W + (size_t)u.pn * (256 * 512 * 2); return true; } };
struct BranchSchedH : SchedBase { const char* Y; const char* W; int c;
    __device__ __forceinline__ bool next(int i, pg8::Unit& u) const { if (i >= 8 || c >= 256) return false; const int hf = i >> 2, br = i & 3; int pm, pn; tile_of(c, 32, 8, pm, pn);
        u.pm = pm; u.pn = pn; u.kind = br | (hf << 2); u.a = Y + (size_t)(br * 32 + pm) * (256 * 512 * 2); u.b = W + (size_t)(br * 2048 + pn * 256 + hf * 128) * (512 * 2); return true; } };
struct MoeSched : SchedBase { const char* A; const char* Bt; size_t tstep; int NT, G, c; int imax = 1 << 20; int pre[9];
    __device__ __forceinline__ void init(const int* cnt) { pre[0] = 0;
#pragma unroll
        for (int e = 0; e < 8; ++e) pre[e + 1] = pre[e] + ((__builtin_amdgcn_readfirstlane(cnt[e]) + 255) >> 8); }
    __device__ __forceinline__ bool next(int i, pg8::Unit& u) const { const int total = pre[8] * NT, q = (total + 7) >> 3, off = i * (G >> 3) + (c >> 3), L = (c & 7) * q + off; if (i >= imax || off >= q || L >= total) return false;
        int e = 0, base = 0, pe = pre[1];
#pragma unroll
        for (int k = 1; k < 8; ++k) { const int b = pre[k] * NT; if (L >= b) { e = k; base = b; pe = pre[k + 1] - pre[k]; } }
        const int idx = L - base; u.pm = e * 32 + idx % pe; u.pn = e * NT + idx / pe; u.kind = 0; u.a = A + (size_t)u.pm * tstep; u.b = Bt + (size_t)u.pn * tstep; return true; } };

struct MoeSchedTail : SchedBase { const char* A; const char* Bt; size_t tstep; int NT, G, c, fr; int pre[9];
    __device__ __forceinline__ bool next(int i, pg8::Unit& u) const { const int total = pre[8] * NT, q = (total + 7) >> 3, r = q - fr * (G >> 3), h = i * (G >> 3) + (c >> 3), off = fr * (G >> 3) + (h >> 1), L = (c & 7) * q + off;
        if (h >= 2 * r || L >= total) return false;
        int e = 0, base = 0, pe = pre[1];
#pragma unroll
        for (int k = 1; k < 8; ++k) { const int b = pre[k] * NT; if (L >= b) { e = k; base = b; pe = pre[k + 1] - pre[k]; } }
        const int idx = L - base; u.pm = e * 32 + idx % pe; u.pn = e * NT + idx / pe; u.kind = h & 1; u.a = A + (size_t)u.pm * tstep; u.b = Bt + (size_t)u.pn * tstep + (size_t)(h & 1) * (tstep >> 1); return true; } };

__device__ __forceinline__ u32x4 pack8(const f32x4& a, const f32x4& b) { u32x4 w; w.x = pg8::cvt_pk_bf16(a[0], a[1]); w.y = pg8::cvt_pk_bf16(a[2], a[3]); w.z = pg8::cvt_pk_bf16(b[0], b[1]); w.w = pg8::cvt_pk_bf16(b[2], b[3]); return w; }
__device__ __forceinline__ void store4(bf16* p, const f32x4& a) { uint2 w; w.x = pg8::cvt_pk_bf16(a[0], a[1]); w.y = pg8::cvt_pk_bf16(a[2], a[3]); *(uint2*)p = w; }
__device__ __forceinline__ void rope4(const float2* tab, f32x4& v0, f32x4& v1) {
    const f32x4 t0 = *(const f32x4*)tab, t1 = *(const f32x4*)(tab + 2);
    const f32x4 c = {t0[0], t0[2], t1[0], t1[2]}, s = {t0[1], t0[3], t1[1], t1[3]};
    const f32x4 a = v0 * c - v1 * s, b = v0 * s + v1 * c; v0 = a; v1 = b;
}
__device__ __forceinline__ void rope4t(const f32x4& t0, const f32x4& t1, f32x4& v0, f32x4& v1) {
    const f32x4 c = {t0[0], t0[2], t1[0], t1[2]}, sn = {t0[1], t0[3], t1[1], t1[3]};
    const f32x4 a = v0 * c - v1 * sn, b = v0 * sn + v1 * c; v0 = a; v1 = b;
}
__device__ __forceinline__ f32x4 sigmoid4(const f32x4& x) { f32x4 r;
#pragma unroll
    for (int e = 0; e < 4; ++e) r[e] = __builtin_amdgcn_rcpf(1.f + __builtin_amdgcn_exp2f(-1.4426950408889634f * x[e]));
    return r; }
__device__ __forceinline__ void bf8_to_f32(const u32x4& w, f32x4& a, f32x4& b) {
    a[0] = __uint_as_float(w.x << 16); a[1] = __uint_as_float(w.x & 0xffff0000u); a[2] = __uint_as_float(w.y << 16); a[3] = __uint_as_float(w.y & 0xffff0000u);
    b[0] = __uint_as_float(w.z << 16); b[1] = __uint_as_float(w.z & 0xffff0000u); b[2] = __uint_as_float(w.w << 16); b[3] = __uint_as_float(w.w & 0xffff0000u); }

struct EpiInproj { static constexpr bool PERM = true, AFTER_DRAIN = false; unsigned char* ws; float* rsq;
    __device__ __forceinline__ void operator()(const f32x4 (&acc)[2][2][4][2], const pg8::Unit& u, int wr, int wc, int fr, int fq) const {
        const int p0 = wc * 32 + 8 * fq;
        if (u.kind == 1) { bf16* VT = (bf16*)(ws + WS_VT); const int row0 = u.pm * 256 + wr * 64 + fr, col0 = u.pn * 256 + p0;
#pragma unroll
            for (int ai = 0; ai < 2; ++ai)
#pragma unroll
                for (int m = 0; m < 4; ++m) { bf16* rp = VT + (size_t)(row0 + ai * 128 + m * 16) * VTP + col0;
#pragma unroll
                    for (int bj = 0; bj < 2; ++bj) *(u32x4*)(rp + bj * 128) = pack8(acc[ai][bj][m][0], acc[ai][bj][m][1]); }
            return; }
        const int tile = u.pn, row0 = u.pm * 256 + wr * 64 + fr;
        if (tile < 4) { bf16* dst = (bf16*)(ws + (tile < 2 ? WS_QA : WS_KA)) + (tile & 1) * 256 + p0; const float2* tab = (const float2*)(ws + ROPE_A) + 4 * fq;
            const bool rot = ((wc & 1) == 0) && (fq < 2);
#pragma unroll
            for (int ai = 0; ai < 2; ++ai) { f32x4 t0[4], t1[4];
                if (rot) {
#pragma unroll
                    for (int m = 0; m < 4; ++m) { const f32x4* tp = (const f32x4*)(tab + ((row0 + ai * 128 + m * 16) & (SEQ - 1)) * 8); t0[m] = tp[0]; t1[m] = tp[1]; } }
#pragma unroll
                for (int m = 0; m < 4; ++m) { bf16* rp = dst + (size_t)(row0 + ai * 128 + m * 16) * 512;
#pragma unroll
                    for (int bj = 0; bj < 2; ++bj) { f32x4 v0 = acc[ai][bj][m][0], v1 = acc[ai][bj][m][1];
                        if (rot) { rope4t(t0[m], t1[m], v0, v1); bf16* bp = rp + bj * 128 - 8 * fq; store4(bp + 4 * fq, v0); store4(bp + 8 + 4 * fq, v1); }
                        else *(u32x4*)(rp + bj * 128) = pack8(v0, v1); } } }
        } else if (tile < 8) { const int which = (tile - 4) >> 1; bf16* dst = (bf16*)(ws + (which ? WS_CKV : WS_CQ)) + (tile & 1) * 256 + p0;
#pragma unroll
            for (int ai = 0; ai < 2; ++ai)
#pragma unroll
                for (int m = 0; m < 4; ++m) { const int row = row0 + ai * 128 + m * 16; bf16* rp = dst + (size_t)row * 512; float ss = 0.f;
#pragma unroll
                    for (int bj = 0; bj < 2; ++bj) { const f32x4 v0 = acc[ai][bj][m][0], v1 = acc[ai][bj][m][1];
                        ss += v0[0] * v0[0] + v0[1] * v0[1] + v0[2] * v0[2] + v0[3] * v0[3] + v1[0] * v1[0] + v1[1] * v1[1] + v1[2] * v1[2] + v1[3] * v1[3];
                        *(u32x4*)(rp + bj * 128) = pack8(v0, v1); }
                    ss += __shfl_xor(ss, 16); ss += __shfl_xor(ss, 32);
                    if (fq == 0) rsq[((size_t)row * 2 + which) * 8 + (tile & 1) * 4 + wc] = ss; }
        } else if (tile < 20) { const bool isk = tile >= 14; bf16* dst = (bf16*)(ws + (isk ? WS_KC : WS_QC)) + (tile - (isk ? 14 : 8)) * 256 + p0; const float2* tab = (const float2*)(ws + ROPE_C) + 4 * fq;
            const bool rot = (wc == 0);
#pragma unroll
            for (int ai = 0; ai < 2; ++ai) { f32x4 t0[4], t1[4];
                if (rot) {
#pragma unroll
                    for (int m = 0; m < 4; ++m) { const f32x4* tp = (const f32x4*)(tab + ((row0 + ai * 128 + m * 16) & (SEQ - 1)) * 16); t0[m] = tp[0]; t1[m] = tp[1]; } }
#pragma unroll
                for (int m = 0; m < 4; ++m) { bf16* rp = dst + (size_t)(row0 + ai * 128 + m * 16) * 1536;
#pragma unroll
                    for (int bj = 0; bj < 2; ++bj) { f32x4 v0 = acc[ai][bj][m][0], v1 = acc[ai][bj][m][1];
                        if (rot) { rope4t(t0[m], t1[m], v0, v1); bf16* bp = rp + bj * 128 - 8 * fq; store4(bp + 4 * fq, v0); store4(bp + 16 + 4 * fq, v1); }
                        else *(u32x4*)(rp + bj * 128) = pack8(v0, v1); } } }
        } else if (tile < 24) { bf16* dst = (bf16*)(ws + (tile < 22 ? WS_QD : WS_KD)) + (tile & 1) * 256 + p0;
#pragma unroll
            for (int ai = 0; ai < 2; ++ai)
#pragma unroll
                for (int m = 0; m < 4; ++m) { bf16* rp = dst + (size_t)(row0 + ai * 128 + m * 16) * 512;
#pragma unroll
                    for (int bj = 0; bj < 2; ++bj) *(u32x4*)(rp + bj * 128) = pack8(acc[ai][bj][m][0], acc[ai][bj][m][1]); }
        } else { if (wc < 2) { const int j = 4 * wc + fq; bf16* KB = (bf16*)(ws + WS_KB) + 128 + 4 * j; const float2* tab = (const float2*)(ws + ROPE_M) + 4 * j;
#pragma unroll
            for (int ai = 0; ai < 2; ++ai) { f32x4 t0[4], t1[4];
#pragma unroll
                for (int m = 0; m < 4; ++m) { const f32x4* tp = (const f32x4*)(tab + ((row0 + ai * 128 + m * 16) & (SEQ - 1)) * 32); t0[m] = tp[0]; t1[m] = tp[1]; }
#pragma unroll
                for (int m = 0; m < 4; ++m) { bf16* rp = KB + (size_t)(row0 + ai * 128 + m * 16) * 768;
                    f32x4 v0 = acc[ai][0][m][0], v1 = acc[ai][0][m][1]; rope4t(t0[m], t1[m], v0, v1);
#pragma unroll
                    for (int h = 0; h < 4; ++h) { store4(rp + h * 192, v0); store4(rp + h * 192 + 32, v1); } } } } }
    }
};

__device__ __forceinline__ float rsq_scale(const float* rsq, int tok, int which) { const f32x4 a = *(const f32x4*)(rsq + ((size_t)tok * 2 + which) * 8), b = *(const f32x4*)(rsq + ((size_t)tok * 2 + which) * 8 + 4);
    return rsqrtf((((a[0] + a[1]) + (a[2] + a[3])) + ((b[0] + b[1]) + (b[2] + b[3]))) * (1.f / 512) + EPS); }
struct EpiGate { static constexpr bool PERM = true, AFTER_DRAIN = false; bf16* G;
    __device__ __forceinline__ void operator()(const f32x4 (&acc)[2][2][4][2], const pg8::Unit& u, int wr, int wc, int fr, int fq) const {
        bf16* gp = G + ((size_t)(u.pm * 32 + u.pn) << 16) + (wr * 64 + fr) * 256 + wc * 32 + 8 * fq;
#pragma unroll
        for (int ai = 0; ai < 2; ++ai)
#pragma unroll
            for (int m = 0; m < 4; ++m) { bf16* rp = gp + (ai * 128 + m * 16) * 256;
#pragma unroll
                for (int bj = 0; bj < 2; ++bj) *(u32x4*)(rp + bj * 128) = pack8(sigmoid4(acc[ai][bj][m][0] * (1.f / 256)), sigmoid4(acc[ai][bj][m][1] * (1.f / 256))); }
    }
};
struct EpiMla { static constexpr bool PERM = true, AFTER_DRAIN = false; unsigned char* ws; const float* rsq;
    __device__ __forceinline__ void operator()(const f32x4 (&acc)[2][2][4][2], const pg8::Unit& u, int wr, int wc, int fr, int fq) const {
        const int p0 = wc * 32 + 8 * fq;
        if (u.kind == 2) { bf16* VTB = (bf16*)(ws + WS_VTB); const int row0 = u.pm * 256 + wr * 64 + fr, col0 = u.pn * 256 + p0;
#pragma unroll
            for (int bj = 0; bj < 2; ++bj) { const int t0 = col0 + bj * 128;
                const f32x4 sa = {rsq_scale(rsq, t0, 1), rsq_scale(rsq, t0 + 1, 1), rsq_scale(rsq, t0 + 2, 1), rsq_scale(rsq, t0 + 3, 1)};
                const f32x4 sb = {rsq_scale(rsq, t0 + 4, 1), rsq_scale(rsq, t0 + 5, 1), rsq_scale(rsq, t0 + 6, 1), rsq_scale(rsq, t0 + 7, 1)};
#pragma unroll
                for (int ai = 0; ai < 2; ++ai)
#pragma unroll
                    for (int m = 0; m < 4; ++m) *(u32x4*)(VTB + (size_t)(row0 + ai * 128 + m * 16) * VTP + col0 + bj * 128) = pack8(acc[ai][bj][m][0] * sa, acc[ai][bj][m][1] * sb); }
            return; }
        const int row0 = u.pm * 256 + wr * 64 + fr, tile = u.pn;
        bf16* dst = (bf16*)(ws + (u.kind == 0 ? WS_QB : WS_KB));
#pragma unroll
        for (int ai = 0; ai < 2; ++ai)
#pragma unroll
            for (int m = 0; m < 4; ++m) { const int row = row0 + ai * 128 + m * 16, pos = row & (SEQ - 1); const float r = rsq_scale(rsq, row, u.kind); bf16* rp = dst + (size_t)row * 768;
#pragma unroll
                for (int bj = 0; bj < 2; ++bj) { f32x4 v0 = acc[ai][bj][m][0] * r, v1 = acc[ai][bj][m][1] * r;
                    if (u.kind == 0 && tile == 2) { const int hb = 2 * bj + (wc >> 1), j = 4 * (wc & 1) + fq; rope4((const float2*)(ws + ROPE_M) + pos * 32 + 4 * j, v0, v1);
                        store4(rp + hb * 192 + 128 + 4 * j, v0); store4(rp + hb * 192 + 160 + 4 * j, v1); }
                    else *(u32x4*)(rp + (2 * tile + bj) * 192 + p0) = pack8(v0, v1); } }
    }
};
struct EpiBranchF { static constexpr bool PERM = true, AFTER_DRAIN = false; const bf16* G; bf16* MGT; bf16* MGB;
    __device__ __forceinline__ void operator()(const f32x4 (&acc)[2][2][4][2], const pg8::Unit& u, int wr, int wc, int fr, int fq) const {
        const int i = u.kind, pm = u.pm & 31, pn = u.pn & 7, lr = wr * 64 + fr, lc = wc * 32 + 8 * fq;
        const bf16* gt = G + ((size_t)(pm * 32 + i * 8 + pn) << 16) + lr * 256 + lc;
        bf16* mt = MGT + ((size_t)(pm * 8 + pn) << 16) + lr * 256 + lc;
#pragma unroll
        for (int ai = 0; ai < 2; ++ai) {
            u32x4 gw[4][2], ow[4][2];
#pragma unroll
            for (int m = 0; m < 4; ++m)
#pragma unroll
                for (int bj = 0; bj < 2; ++bj) { const int off = (ai * 128 + m * 16) * 256 + bj * 128;
                    gw[m][bj] = *(const u32x4*)(gt + off);
                    if (i > 0) ow[m][bj] = *(const u32x4*)(mt + off); }
#pragma unroll
            for (int m = 0; m < 4; ++m)
#pragma unroll
                for (int bj = 0; bj < 2; ++bj) { const int off = (ai * 128 + m * 16) * 256 + bj * 128;
                    f32x4 g0, g1; bf8_to_f32(gw[m][bj], g0, g1);
                    f32x4 v0 = acc[ai][bj][m][0] * g0, v1 = acc[ai][bj][m][1] * g1;
                    if (i > 0) { f32x4 o0, o1; bf8_to_f32(ow[m][bj], o0, o1); v0 += o0; v1 += o1; }
                    if (i < 3) *(u32x4*)(mt + off) = pack8(v0, v1);
                    else *(u32x4*)(MGB + (size_t)(pm * 256 + lr + ai * 128 + m * 16) * DM + pn * 256 + lc + bj * 128) = pack8(v0, v1); }
            asm volatile("" ::: "memory"); }
    }
};
struct EpiBranchH { static constexpr bool PERM = true, AFTER_DRAIN = false; const bf16* G; bf16* MGB; mutable u32x4 gp[2][4];
    __device__ __forceinline__ void operator()(f32x4 (&acc)[2][2][4][2], const pg8::Unit& u, int wr, int wc, int fr, int fq) const {
        typedef const __attribute__((address_space(1))) u32x4 gv4;
        const int br = u.kind & 3, hf = u.kind >> 2, lr = wr * 64 + fr, lc = hf * 128 + wc * 32 + 8 * fq;
        const __attribute__((address_space(1))) bf16* gb = (const __attribute__((address_space(1))) bf16*)G + ((size_t)(u.pm * 32 + br * 8 + u.pn) << 16);
        const unsigned lo = (unsigned)(lr * 256 + lc);
        if (br == 0) {
#pragma unroll
            for (int ai = 0; ai < 2; ++ai)
#pragma unroll
                for (int m = 0; m < 4; ++m) gp[ai][m] = *(gv4*)(gb + lo + (ai * 128 + m * 16) * 256); }
#pragma unroll
        for (int ai = 0; ai < 2; ++ai)
#pragma unroll
            for (int m = 0; m < 4; ++m) { f32x4 g0, g1; bf8_to_f32(gp[ai][m], g0, g1);
                if (br == 0) { acc[ai][1][m][0] = acc[ai][0][m][0] * g0; acc[ai][1][m][1] = acc[ai][0][m][1] * g1; }
                else { acc[ai][1][m][0] += acc[ai][0][m][0] * g0; acc[ai][1][m][1] += acc[ai][0][m][1] * g1; } }
        if (br < 3) {
#pragma unroll
            for (int ai = 0; ai < 2; ++ai)
#pragma unroll
                for (int m = 0; m < 4; ++m) gp[ai][m] = *(gv4*)(gb + ((size_t)8 << 16) + lo + (ai * 128 + m * 16) * 256);
        } else {
            __attribute__((address_space(1))) bf16* mb = (__attribute__((address_space(1))) bf16*)MGB + (size_t)(u.pm * 256) * DM + u.pn * 256;
            const unsigned mo = (unsigned)(lr * DM + lc);
#pragma unroll
            for (int ai = 0; ai < 2; ++ai)
#pragma unroll
                for (int m = 0; m < 4; ++m) *(__attribute__((address_space(1))) u32x4*)(mb + mo + (ai * 128 + m * 16) * DM) = pack8(acc[ai][1][m][0], acc[ai][1][m][1]); }
    }
};
struct EpiResidF { static constexpr bool PERM = false, AFTER_DRAIN = false; const float* Xin; float* Xout;
    __device__ __forceinline__ void operator()(const f32x4 (&acc)[2][2][4][2], const pg8::Unit& u, int wr, int wc, int fr, int fq) const {
        const int row0 = u.pm * 256 + wr * 64 + fr, col0 = u.pn * 256 + wc * 32 + 4 * fq;
#pragma unroll
        for (int ai = 0; ai < 2; ++ai) {
            f32x4 xi[4][2][2];
#pragma unroll
            for (int m = 0; m < 4; ++m)
#pragma unroll
                for (int bj = 0; bj < 2; ++bj)
#pragma unroll
                    for (int n = 0; n < 2; ++n) xi[m][bj][n] = *(const f32x4*)(Xin + (size_t)(row0 + ai * 128 + m * 16) * DM + col0 + bj * 128 + n * 16);
#pragma unroll
            for (int m = 0; m < 4; ++m)
#pragma unroll
                for (int bj = 0; bj < 2; ++bj)
#pragma unroll
                    for (int n = 0; n < 2; ++n) *(f32x4*)(Xout + (size_t)(row0 + ai * 128 + m * 16) * DM + col0 + bj * 128 + n * 16) = xi[m][bj][n] + acc[ai][bj][m][n];
            asm volatile("" ::: "memory"); }
    }
};
struct EpiSwigluF { static constexpr bool PERM = true, AFTER_DRAIN = false; bf16* ACT; int NT;
    __device__ __forceinline__ void operator()(const f32x4 (&acc)[2][2][4][2], const pg8::Unit& u, int wr, int wc, int fr, int fq) const {
        const int row0 = u.pm * 256 + wr * 64 + fr, col0 = (u.pn % NT) * 128 + wc * 32 + 8 * fq;
#pragma unroll
        for (int ai = 0; ai < 2; ++ai)
#pragma unroll
            for (int m = 0; m < 4; ++m) { const f32x4 g0 = acc[ai][0][m][0], g1 = acc[ai][0][m][1];
                const f32x4 a0 = g0 * sigmoid4(g0) * acc[ai][1][m][0], a1 = g1 * sigmoid4(g1) * acc[ai][1][m][1];
                *(u32x4*)(ACT + (size_t)(row0 + ai * 128 + m * 16) * DFF + col0) = pack8(a0, a1); }
    }
};
struct EpiSwigluF8 { static constexpr bool PERM = true, AFTER_DRAIN = false; unsigned char* ACT; int NT;
    __device__ __forceinline__ void operator()(const f32x4 (&acc)[2][2][4][2], const pg8::Unit& u, int wr, int wc, int fr, int fq) const {
        const int row0 = u.pm * 256 + wr * 64 + fr, col0 = (u.pn % NT) * 128 + wc * 32 + 8 * fq;
#pragma unroll
        for (int ai = 0; ai < 2; ++ai)
#pragma unroll
            for (int m = 0; m < 4; ++m) { const f32x4 g0 = acc[ai][0][m][0] * (1.f / 256), g1 = acc[ai][0][m][1] * (1.f / 256);
                f32x4 a0 = g0 * sigmoid4(g0) * acc[ai][1][m][0] * (4.f / 256), a1 = g1 * sigmoid4(g1) * acc[ai][1][m][1] * (4.f / 256);
#pragma unroll
                for (int e = 0; e < 4; ++e) { a0[e] = fminf(fmaxf(a0[e], -440.f), 440.f); a1[e] = fminf(fmaxf(a1[e], -440.f), 440.f); }
                const uint2 o = {pk4_fp8(a0[0], a0[1], a0[2], a0[3]), pk4_fp8(a1[0], a1[1], a1[2], a1[3])};
                *(uint2*)(ACT + (size_t)(row0 + ai * 128 + m * 16) * DFF + col0) = o; }
    }
};
struct EpiStoreF { static constexpr bool PERM = true, AFTER_DRAIN = false; bf16* O; int NT; float sc;
    __device__ __forceinline__ void operator()(const f32x4 (&acc)[2][2][4][2], const pg8::Unit& u, int wr, int wc, int fr, int fq) const {
        const int row0 = u.pm * 256 + wr * 64 + fr, col0 = (u.pn % NT) * 256 + wc * 32 + 8 * fq;
#pragma unroll
        for (int ai = 0; ai < 2; ++ai)
#pragma unroll
            for (int m = 0; m < 4; ++m) { bf16* rp = O + (size_t)(row0 + ai * 128 + m * 16) * DM + col0;
#pragma unroll
                for (int bj = 0; bj < 2; ++bj) *(u32x4*)(rp + bj * 128) = pack8(acc[ai][bj][m][0] * sc, acc[ai][bj][m][1] * sc); }
    }
};

struct EpiStoreFH { static constexpr bool PERM = true, AFTER_DRAIN = false; bf16* O; int NT; float sc;
    __device__ __forceinline__ void operator()(const f32x4 (&acc)[2][2][4][2], const pg8::Unit& u, int wr, int wc, int fr, int fq) const {
        const int row0 = u.pm * 256 + wr * 64 + fr, col0 = (u.pn % NT) * 256 + u.kind * 128 + wc * 32 + 8 * fq;
#pragma unroll
        for (int ai = 0; ai < 2; ++ai)
#pragma unroll
            for (int m = 0; m < 4; ++m) *(u32x4*)(O + (size_t)(row0 + ai * 128 + m * 16) * DM + col0) = pack8(acc[ai][0][m][0] * sc, acc[ai][0][m][1] * sc);
    }
};

__device__ __forceinline__ void phase_inproj(const FArgs& a, LAS unsigned char* lds, int layer) {
    unsigned char* ws_ = a.ws; asm volatile("" : "+s"(ws_));
    {   InSched S; S.H = (const char*)(ws_ + WS_H); S.W = (const char*)(ws_ + WS_WT + WT_IN) + (size_t)layer * NT_IN * 256 * DM * 2; S.WV = (const char*)(ws_ + WS_WT + WT_INV) + (size_t)layer * NV_ROWS * DM * 2; S.G = gdim_(); S.c = bid_();
        EpiInproj E{ws_, (float*)(ws_ + WS_RSQP) + (size_t)layer * T * 16};
        pg8::gemm_phase<EpiInproj, InSched, true, true>(lds, DM, S, E); }
    {   GateSched S; S.H8 = (const char*)(ws_ + WS_ACT); S.W8 = (const char*)(ws_ + WS_WT + WT_ING) + (size_t)layer * 8192 * DM; S.G = gdim_(); S.c = bid_();
        EpiGate E{(bf16*)(ws_ + WS_G)};
        pg8::gemm_phase<EpiGate, GateSched, true, true, true>(lds, DM / 2, S, E); }
}
__device__ __forceinline__ void phase_mlaup(const FArgs& a, LAS unsigned char* lds, int layer) {
    unsigned char* ws_ = a.ws; asm volatile("" : "+s"(ws_));
    MlaSched S; S.CQ = (const char*)(ws_ + WS_CQ); S.CKV = (const char*)(ws_ + WS_CKV);
    S.WQ = (const char*)(ws_ + WS_WT + WT_UQ) + (size_t)layer * 768 * 512 * 2; S.WKN = (const char*)(ws_ + WS_WT + WT_UKN) + (size_t)layer * 512 * 512 * 2; S.WKV = (const char*)(ws_ + WS_WT + WT_UKV) + (size_t)layer * 512 * 512 * 2; S.G = gdim_(); S.c = bid_();
    EpiMla E{ws_, (const float*)(ws_ + WS_RSQP) + (size_t)layer * T * 16};
    pg8::gemm_phase<EpiMla, MlaSched, true, true>(lds, 512, S, E);
}
__device__ __forceinline__ void phase_branch(const FArgs& a, LAS unsigned char* lds, int layer) {
    unsigned char* ws_ = a.ws; asm volatile("" : "+s"(ws_));
    BranchSchedH S; S.Y = (const char*)(ws_ + WS_Y); S.W = (const char*)(ws_ + WS_WT + WT_BR) + (size_t)layer * 4 * DM * 512 * 2; S.c = bid_();
    EpiBranchH E; E.G = (const bf16*)(ws_ + WS_G); E.MGB = (bf16*)(ws_ + WS_MGB);
    pg8::gemm_phase<EpiBranchH, BranchSchedH, true, true, false, true>(lds, 512, S, E);
}
__device__ __forceinline__ void phase_outproj(const FArgs& a, LAS unsigned char* lds, int layer) {
    unsigned char* ws_ = a.ws; asm volatile("" : "+s"(ws_));
    GenSched S; S.A = (const char*)(ws_ + WS_MGB); S.Bt = (const char*)(ws_ + WS_WT + WT_OUT) + (size_t)layer * DM * DM * 2; S.tstep = (size_t)256 * DM * 2; S.nM = 32; S.nN = 8; S.G = gdim_(); S.c = bid_();
    EpiResidF E{layer == 0 ? a.in[0] : (const float*)(ws_ + WS_XA), (float*)(ws_ + WS_XA)};
    pg8::gemm_phase<EpiResidF, GenSched, true, true>(lds, DM, S, E);
}
__device__ __forceinline__ void phase_ffn_in(const FArgs& a, LAS unsigned char* lds) {
    unsigned char* ws_ = a.ws; asm volatile("" : "+s"(ws_));
    GenSched S; S.A = (const char*)(ws_ + WS_H); S.Bt = (const char*)(ws_ + WS_WT + WT_DI); S.tstep = (size_t)256 * DM * 2; S.nM = 32; S.nN = 44; S.G = gdim_(); S.c = bid_();
    EpiSwigluF E{(bf16*)(ws_ + WS_ACT), 44};
    pg8::gemm_phase<EpiSwigluF, GenSched, true, true>(lds, DM, S, E);
    {   const int c = bid_();
        if (c >= 128) { __syncthreads(); const int lo = CONV_N1 - CONV_TAIL1 + (c - 128) * TAIL_PER_WG; conv_chunk(a, lds, 1, lo, lo + TAIL_PER_WG); } }
}
__device__ __forceinline__ void phase_ffn_out(const FArgs& a, LAS unsigned char* lds) {
    unsigned char* ws_ = a.ws; asm volatile("" : "+s"(ws_));
    GenSched S; S.A = (const char*)(ws_ + WS_ACT); S.Bt = (const char*)(ws_ + WS_WT + WT_DO); S.tstep = (size_t)256 * DFF * 2; S.nM = 32; S.nN = 8; S.G = gdim_(); S.c = bid_();
    EpiResidF E{(const float*)(ws_ + WS_XA), (float*)(ws_ + WS_XA)};
    pg8::gemm_phase<EpiResidF, GenSched, true, true>(lds, DFF, S, E);
}
__device__ __forceinline__ void phase_moe_in(const FArgs& a, LAS unsigned char* lds) {
    unsigned char* ws_ = a.ws; asm volatile("" : "+s"(ws_));
    MoeSched S; S.A = (const char*)(ws_ + WS_HS); S.Bt = (const char*)(ws_ + WS_WT + WT_MI); S.tstep = (size_t)256 * DM; S.NT = 44; S.G = gdim_(); S.c = bid_(); S.init((const int*)(ws_ + WS_CTL + CTL_CNT));
    EpiSwigluF8 E{ws_ + WS_ACTS, 44};
    pg8::gemm_phase<EpiSwigluF8, MoeSched, true, true, true>(lds, DM / 2, S, E);
}
__device__ __forceinline__ void phase_moe_out(const FArgs& a, LAS unsigned char* lds) {
    unsigned char* ws_ = a.ws; asm volatile("" : "+s"(ws_));
    MoeSched S; S.A = (const char*)(ws_ + WS_ACTS); S.Bt = (const char*)(ws_ + WS_WT + WT_MO); S.tstep = (size_t)256 * DFF; S.NT = 8; S.G = gdim_(); S.c = bid_(); S.init((const int*)(ws_ + WS_CTL + CTL_CNT));
    EpiStoreF E{(bf16*)(ws_ + WS_OUTS), 8, 1.f / 256};
    const int q = (S.pre[8] * 8 + 7) >> 3, fr = q >> 5, r = q - (fr << 5);
    const bool split = r > 0 && r <= 16;
    if (split) S.imax = fr;
    pg8::gemm_phase<EpiStoreF, MoeSched, true, true, true>(lds, DFF / 2, S, E);
    if (split) {
        MoeSchedTail Tl; Tl.A = S.A; Tl.Bt = S.Bt; Tl.tstep = S.tstep; Tl.NT = 8; Tl.G = S.G; Tl.c = S.c; Tl.fr = fr;
#pragma unroll
        for (int k = 0; k < 9; ++k) Tl.pre[k] = S.pre[k];
        EpiStoreFH EH{(bf16*)(ws_ + WS_OUTS), 8, 1.f / 256};
        pg8::gemm_phase<EpiStoreFH, MoeSchedTail, true, true, true, true>(lds, DFF / 2, Tl, EH);
    }
}

#ifndef MK_MULTI
#define PHASE_KERNEL(name, call)
#else
#define PHASE_KERNEL(name, call) __global__ void __launch_bounds__(NTHR, 2) name(FArgs a) { extern __shared__ __attribute__((aligned(16))) unsigned char lds_raw[]; LAS unsigned char* lds = (LAS unsigned char*)lds_raw; call; }
#endif
PHASE_KERNEL(kf_convert, phase_convert(a, lds))
PHASE_KERNEL(kf_inproj, phase_inproj(a, lds, a.layer))
PHASE_KERNEL(kf_mlaup, phase_mlaup(a, lds, a.layer))
PHASE_KERNEL(kf_branch, phase_branch(a, lds, a.layer))
PHASE_KERNEL(kf_outproj, phase_outproj(a, lds, a.layer))
PHASE_KERNEL(kf_ffn_in, phase_ffn_in(a, lds))
PHASE_KERNEL(kf_ffn_out, phase_ffn_out(a, lds))
PHASE_KERNEL(kf_moe_in, phase_moe_in(a, lds))
PHASE_KERNEL(kf_moe_out, phase_moe_out(a, lds))
__device__ __forceinline__ f32x16 mfma32(const bf16x8& a, const bf16x8& b, const f32x16& c) { return __builtin_amdgcn_mfma_f32_32x32x16_bf16(a, b, c, 0, 0, 0); }
__device__ __forceinline__ float ex2(float x) { return __builtin_amdgcn_exp2f(x); }
__device__ __forceinline__ float max_xor32(float v) { auto rr = __builtin_amdgcn_permlane32_swap(__float_as_uint(v), __float_as_uint(v), false, false); return fmaxf(__uint_as_float(rr[0]), __uint_as_float(rr[1])); }
__device__ __forceinline__ float lg2(float x) { return __builtin_amdgcn_logf(x); }
__device__ __forceinline__ bf16x8 pack8v(const f32x16& p, int s) {
    u32x4 w; w.x = pg8::cvt_pk_bf16(p[8 * s + 0], p[8 * s + 1]); w.y = pg8::cvt_pk_bf16(p[8 * s + 2], p[8 * s + 3]); w.z = pg8::cvt_pk_bf16(p[8 * s + 4], p[8 * s + 5]); w.w = pg8::cvt_pk_bf16(p[8 * s + 6], p[8 * s + 7]);
    return __builtin_bit_cast(bf16x8, w); }
constexpr int VS = 144;
template <int DQK, int MODE>
__device__ __forceinline__ void attn_pass(LAS unsigned char* lds, const bf16* __restrict__ Qp, int ldq, const bf16* __restrict__ Kp, int ldk, const bf16* __restrict__ VTp,
                                          int q0, int tile_lo, int tile_hi, int win, int dmask, float C, f32x16 (&O)[4], float& m, float& l) {
    constexpr int KS = DQK * 2 + 16, NKC = DQK / 8, CK = NKC / 8, BUFSZ = 64 * KS + 128 * VS, NKS = DQK / 16;
    int tid = threadIdx.x; asm volatile("" : "+v"(tid));
    const int wave = __builtin_amdgcn_readfirstlane(tid >> 6), lane = tid & 63, r = lane & 31, h = lane >> 5;
    const int qpos = q0 + 32 * wave + r, qw_min = q0 + 32 * wave, qw_max = qw_min + 31;
    const int kap = (r & 19) | ((r & 4) << 1) | ((r & 8) >> 1);
    typedef const __attribute__((address_space(1))) bf16 gbf16;
    gbf16* Qg = (gbf16*)Qp; gbf16* Kg = (gbf16*)Kp; gbf16* VTg = (gbf16*)VTp;
    bf16x8 qf[NKS];
#pragma unroll
    for (int ks = 0; ks < NKS; ++ks) qf[ks] = *(const __attribute__((address_space(1))) bf16x8*)(Qg + (size_t)(32 * wave + r) * ldq + 16 * ks + 8 * h);
    int krow[CK], kcc[CK];
#pragma unroll
    for (int i = 0; i < CK; ++i) { const int c = tid + 512 * i; krow[i] = c / NKC; kcc[i] = c % NKC; }
    const int vrow0 = tid >> 3, vcc = tid & 7;
    u32x4 kst[CK], vst[2];
    const int ntile = tile_hi - tile_lo;
    if (ntile <= 0) return;
    float carry = 0.f; bool seen = false;
    f32x16 madd;
#pragma unroll
    for (int e = 0; e < 16; ++e) madd[e] = (MODE == 1 && ((qpos - 8 * h - (e & 7) - 16 * (e >> 3)) & dmask) != 0) ? -__builtin_inff() : 0.f;
    LAS int* dflag = (LAS int*)(lds + 73728);
#define ATT_LOADS(key0_) do { _Pragma("unroll") for (int i = 0; i < CK; ++i) kst[i] = *(const __attribute__((address_space(1))) u32x4*)(Kg + (size_t)((key0_) + krow[i]) * ldk + kcc[i] * 8); \
        _Pragma("unroll") for (int i = 0; i < 2; ++i) vst[i] = *(const __attribute__((address_space(1))) u32x4*)(VTg + (size_t)(vrow0 + 64 * i) * VTP + (key0_) + vcc * 8); } while (0)
#define ATT_WRITE(buf_) do { LAS unsigned char* Kn_ = lds + (buf_) * BUFSZ; _Pragma("unroll") for (int i = 0; i < CK; ++i) *(LAS u32x4*)(Kn_ + krow[i] * KS + kcc[i] * 16) = kst[i]; \
        _Pragma("unroll") for (int i = 0; i < 2; ++i) *(LAS u32x4*)(Kn_ + 64 * KS + (vrow0 + 64 * i) * VS + vcc * 16) = vst[i]; } while (0)
#define ATT_KEY0(step_) ((MODE == 2 ? tile_hi - 1 - (step_) : tile_lo + (step_)) * 64)
    ATT_LOADS(ATT_KEY0(0)); ATT_WRITE(0);
    if (ntile > 1) ATT_LOADS(ATT_KEY0(1));
    __syncthreads();
    for (int step = 0; step < ntile; ++step) {
        const int key0 = ATT_KEY0(step);
        LAS unsigned char* Kb = lds + (step & 1) * BUFSZ; LAS unsigned char* Vb = Kb + 64 * KS;
        if (step + 1 < ntile) { ATT_WRITE((step + 1) & 1); if (step + 2 < ntile) ATT_LOADS(ATT_KEY0(step + 2)); }
        bool active, needmask;
        if (MODE == 0) { active = key0 <= qw_max; needmask = key0 + 63 > qw_min; }
        else if (MODE == 1) { active = key0 <= qw_max && key0 + 63 >= qw_min - win; needmask = true; }
        else { active = key0 < qw_max; needmask = key0 + 63 >= qw_min; }
        if (MODE == 2 && active) seen = true;
        if (active) {
            f32x16 p0, p1;
#pragma unroll
            for (int e = 0; e < 16; ++e) { p0[e] = 0.f; p1[e] = 0.f; }
            {   constexpr int GK = 2, NG = NKS / GK; bf16x8 kf[NKS][2];
#define ATT_LDK(g_) _Pragma("unroll") for (int ks = (g_) * GK; ks < (g_) * GK + GK; ++ks) { kf[ks][0] = *(const LAS bf16x8*)(Kb + kap * KS + ks * 32 + h * 16); kf[ks][1] = *(const LAS bf16x8*)(Kb + (32 + kap) * KS + ks * 32 + h * 16); }
                ATT_LDK(0)
#pragma unroll
                for (int g = 0; g < NG; ++g) { if (g + 1 < NG) { ATT_LDK(g + 1) }
                    __builtin_amdgcn_sched_barrier(0);
#pragma unroll
                    for (int ks = g * GK; ks < g * GK + GK; ++ks) { p0 = mfma32(kf[ks][0], qf[ks], p0); p1 = mfma32(kf[ks][1], qf[ks], p1); }
                    __builtin_amdgcn_sched_barrier(0); }
#undef ATT_LDK
            }
            const int d0 = qpos - key0 - 8 * h;
            if (MODE != 2) {
                bool bnd = key0 + 63 > qw_min; if (MODE == 1) bnd = bnd || (qw_max - key0 > win);
                if (bnd) {
                    asm volatile("" ::: "memory");
#pragma unroll
                    for (int e = 0; e < 16; ++e) { const int dl0 = d0 - (e & 7) - 16 * (e >> 3), dl1 = dl0 - 32; bool v0, v1;
                        if (MODE == 0) { v0 = dl0 >= 0; v1 = dl1 >= 0; } else { v0 = (unsigned)dl0 <= (unsigned)win && (dl0 & dmask) == 0; v1 = (unsigned)dl1 <= (unsigned)win && (dl1 & dmask) == 0; }
                        p0[e] = v0 ? p0[e] : -__builtin_inff(); p1[e] = v1 ? p1[e] : -__builtin_inff(); }
                    p0 = p0 * C; p1 = p1 * C;
                } else if (MODE == 1) { p0 = p0 * C + madd; p1 = p1 * C + madd; }
                else { p0 = p0 * C; p1 = p1 * C; }
                float mc[4];
#pragma unroll
                for (int c = 0; c < 4; ++c) mc[c] = fmaxf(fmaxf(p0[c], p1[c]), fmaxf(p0[c + 4], p1[c + 4]));
#pragma unroll
                for (int c = 0; c < 4; ++c) { mc[c] = fmaxf(fmaxf(p0[c + 8], p1[c + 8]), mc[c]); mc[c] = fmaxf(fmaxf(p0[c + 12], p1[c + 12]), mc[c]); }
                const float mt = max_xor32(fmaxf(fmaxf(mc[0], mc[1]), fmaxf(mc[2], mc[3])));
                float mn = m, alpha = 1.f; const bool resc = !__all(mt - m <= 11.5f);
                if (resc) { mn = fmaxf(m, mt); alpha = ex2(m - mn); m = mn; }
                p0 = p0 - mn; p1 = p1 - mn;
#pragma unroll
                for (int e = 0; e < 16; ++e) { p0[e] = ex2(p0[e]); p1[e] = ex2(p1[e]); }
                const f32x16 t16 = p0 + p1; const f32x8v t8 = t16.lo + t16.hi; const f32x4 t4 = t8.lo + t8.hi; const f32x2v t2 = t4.lo + t4.hi;
                const float ps = t2.x + t2.y;
                l = l * alpha + ps;
                if (resc) {
#pragma unroll
                    for (int d = 0; d < 4; ++d) O[d] = O[d] * alpha; }
            } else {
                float R[4];
#pragma unroll
                for (int rr = 0; rr < 4; ++rr) { float suf = 0.f;
#pragma unroll
                    for (int j = 7; j >= 0; --j) { const int e = 8 * (rr & 1) + j; const int dl = d0 - j - 16 * (rr & 1) - 32 * (rr >> 1);
                        const float z = (rr < 2 ? p0[e] : p1[e]) * C; const bool v = !needmask || dl > 0;
                        const float sp = lg2(1.f + ex2(-fabsf(z))), lsig = fminf(z, 0.f) - sp, lnot = v ? lsig - z : 0.f;
                        const float val = v ? lsig + suf : -__builtin_inff();
                        if (rr < 2) p0[e] = val; else p1[e] = val;
                        suf += lnot; }
                    R[rr] = suf; }
                float Rp[4];
#pragma unroll
                for (int rr = 0; rr < 4; ++rr) Rp[rr] = __shfl_xor(R[rr], 32);
                float tail = carry;
#pragma unroll
                for (int rr = 3; rr >= 0; --rr) { const float t = tail + (h == 0 ? Rp[rr] : 0.f);
#pragma unroll
                    for (int j = 0; j < 8; ++j) { const int e = 8 * (rr & 1) + j; if (rr < 2) p0[e] = ex2(p0[e] + t); else p1[e] = ex2(p1[e] + t); }
                    tail += R[rr] + Rp[rr]; }
                carry = tail;
            }
            bf16x8 pf[4]; pf[0] = pack8v(p0, 0); pf[1] = pack8v(p0, 1); pf[2] = pack8v(p1, 0); pf[3] = pack8v(p1, 1);
            {   bf16x8 vf[4][4];
#define ATT_LDV(d_) _Pragma("unroll") for (int ks = 0; ks < 4; ++ks) vf[d_][ks] = *(const LAS bf16x8*)(Vb + (32 * (d_) + r) * VS + ks * 32 + h * 16);
                ATT_LDV(0)
#pragma unroll
                for (int d = 0; d < 4; ++d) { if (d + 1 < 4) { ATT_LDV(d + 1) }
                    __builtin_amdgcn_sched_barrier(0);
#pragma unroll
                    for (int ks = 0; ks < 4; ++ks) O[d] = mfma32(vf[d][ks], pf[ks], O[d]);
                    __builtin_amdgcn_sched_barrier(0); }
#undef ATT_LDV
            }
        }
        if (MODE == 2) { const int fl = (seen && __all(carry < -160.f)) ? 1 : 0; if (lane == 0) dflag[(step & 1) * 8 + wave] = fl; }
        __syncthreads();
        if (MODE == 2) { int alld = 1;
#pragma unroll
            for (int w = 0; w < 8; ++w) alld &= dflag[(step & 1) * 8 + w];
            if (__builtin_amdgcn_readfirstlane(alld)) { __syncthreads(); break; } }
    }
}
#undef ATT_LOADS
#undef ATT_WRITE
#undef ATT_KEY0
__device__ __forceinline__ void o_zero(f32x16 (&O)[4]) {
#pragma unroll
    for (int d = 0; d < 4; ++d)
#pragma unroll
        for (int e = 0; e < 16; ++e) O[d][e] = 0.f; }
__device__ __forceinline__ void o_store(const f32x16 (&O)[4], float sc, bf16* yrow, int h) {
#pragma unroll
    for (int d = 0; d < 4; ++d)
#pragma unroll
        for (int g = 0; g < 4; ++g) { const f32x4 v = {O[d][4 * g] * sc, O[d][4 * g + 1] * sc, O[d][4 * g + 2] * sc, O[d][4 * g + 3] * sc}; store4(yrow + 32 * d + 8 * g + 4 * h, v); } }

template <int TYPE>
__device__ __forceinline__ void attn_unit(const FArgs& a, LAS unsigned char* lds, int layer, int b, int hd, int qb) {
    unsigned char* ws = a.ws; asm volatile("" : "+s"(ws));
    int tid_ = threadIdx.x; asm volatile("" : "+v"(tid_));
    const int lane = tid_ & 63, wave = __builtin_amdgcn_readfirstlane(tid_ >> 6), r = lane & 31, h = lane >> 5;
    const int q0 = qb * 256, tok0 = b * SEQ;
    const int nt_c = (q0 + 256) / 64;
    bf16* yrow = (bf16*)(ws + WS_Y) + (size_t)TYPE * T * 512 + (size_t)(tok0 + q0 + 32 * wave + r) * 512 + hd * 128;
    constexpr float L2E = 1.4426950408889634f;
    f32x16 O[4]; float m, l;
    if (TYPE == 0) {
        const bf16* Qp = (const bf16*)(ws + WS_QA) + (size_t)(tok0 + q0) * 512 + hd * 128; const bf16* Kp = (const bf16*)(ws + WS_KA) + (size_t)tok0 * 512 + hd * 128;
        const bf16* VTp = (const bf16*)(ws + WS_VT) + (size_t)(hd * 128) * VTP + tok0;
        o_zero(O); m = -1e30f; l = 0.f;
        attn_pass<64, 0>(lds, Qp, 512, Kp, 512, VTp, q0, 0, nt_c, 0, 0, 0.125f * L2E, O, m, l);
        o_store(O, 1.f / (l + __shfl_xor(l, 32)), yrow, h);
        o_zero(O); m = -1e30f; l = 0.f;
        attn_pass<64, 0>(lds, Qp + 64, 512, Kp + 64, 512, VTp, q0, 0, nt_c, 0, 0, 0.125f * L2E, O, m, l);
        const float* lq1 = a.in[7] + layer * 64; const float* lk1 = a.in[8] + layer * 64; const float* lq2 = a.in[9] + layer * 64; const float* lk2 = a.in[10] + layer * 64;
        const float lam_init = 0.8f - 0.6f * __expf(-0.3f * (float)layer);
        const float lam = __expf(wave_sum(lq1[lane] * lk1[lane])) - __expf(wave_sum(lq2[lane] * lk2[lane])) + lam_init;
        const float inv2 = lam / (l + __shfl_xor(l, 32)); float ss = 0.f;
#pragma unroll
        for (int d = 0; d < 4; ++d)
#pragma unroll
            for (int g = 0; g < 4; ++g) { const uint2 w = *(const uint2*)(yrow + 32 * d + 8 * g + 4 * h);
                const float a0 = __uint_as_float(w.x << 16) - O[d][4 * g] * inv2, a1 = __uint_as_float(w.x & 0xffff0000u) - O[d][4 * g + 1] * inv2;
                const float a2 = __uint_as_float(w.y << 16) - O[d][4 * g + 2] * inv2, a3 = __uint_as_float(w.y & 0xffff0000u) - O[d][4 * g + 3] * inv2;
                O[d][4 * g] = a0; O[d][4 * g + 1] = a1; O[d][4 * g + 2] = a2; O[d][4 * g + 3] = a3; ss += (a0 * a0 + a1 * a1) + (a2 * a2 + a3 * a3); }
        ss += __shfl_xor(ss, 32);
        const float rn = rsqrtf(ss * (1.f / 128) + EPS) * (1.f - lam_init);
        const float* gain = a.in[11] + layer * 128;
#pragma unroll
        for (int d = 0; d < 4; ++d)
#pragma unroll
            for (int g = 0; g < 4; ++g) { const f32x4 gv = *(const f32x4*)(gain + 32 * d + 8 * g + 4 * h);
                const f32x4 v = {O[d][4 * g] * rn * gv[0], O[d][4 * g + 1] * rn * gv[1], O[d][4 * g + 2] * rn * gv[2], O[d][4 * g + 3] * rn * gv[3]}; store4(yrow + 32 * d + 8 * g + 4 * h, v); }
    } else if (TYPE == 1) {
        const bf16* Qp = (const bf16*)(ws + WS_QB) + (size_t)(tok0 + q0) * 768 + hd * 192; const bf16* Kp = (const bf16*)(ws + WS_KB) + (size_t)tok0 * 768 + hd * 192;
        const bf16* VTp = (const bf16*)(ws + WS_VTB) + (size_t)(hd * 128) * VTP + tok0;
        o_zero(O); m = -1e30f; l = 0.f;
        attn_pass<192, 0>(lds, Qp, 768, Kp, 768, VTp, q0, 0, nt_c, 0, 0, 0.07216878364870323f * L2E, O, m, l);
        o_store(O, 1.f / (l + __shfl_xor(l, 32)), yrow, h);
    } else if (TYPE == 2) {
        o_zero(O); m = -1e30f; l = 0.f;
#pragma unroll 1
        for (int g = 0; g < 3; ++g) { const int hc = g * 4 + hd, win = g == 0 ? 128 : (g == 1 ? 512 : 2048), dm = g == 0 ? 0 : (g == 1 ? 3 : 15);
            const bf16* Qp = (const bf16*)(ws + WS_QC) + (size_t)(tok0 + q0) * 1536 + hc * 128; const bf16* Kp = (const bf16*)(ws + WS_KC) + (size_t)tok0 * 1536 + hc * 128;
            const bf16* VTp = (const bf16*)(ws + WS_VT) + (size_t)(512 + hc * 128) * VTP + tok0;
            const int lo = q0 - win > 0 ? (q0 - win) / 64 : 0;
            attn_pass<128, 1>(lds, Qp, 1536, Kp, 1536, VTp, q0, lo, nt_c, win, dm, 0.08838834764831845f * L2E, O, m, l); }
        o_store(O, 1.f / (l + __shfl_xor(l, 32)), yrow, h);
    } else {
        const bf16* Qp = (const bf16*)(ws + WS_QD) + (size_t)(tok0 + q0) * 512 + hd * 128; const bf16* Kp = (const bf16*)(ws + WS_KD) + (size_t)tok0 * 512 + hd * 128;
        const bf16* VTp = (const bf16*)(ws + WS_VT) + (size_t)(2048 + hd * 128) * VTP + tok0;
        o_zero(O); m = 0.f; l = 0.f;
        attn_pass<128, 2>(lds, Qp, 512, Kp, 512, VTp, q0, 0, nt_c, 0, 0, 0.08838834764831845f * L2E, O, m, l);
        o_store(O, 1.f, yrow, h);
    }
}
__device__ __forceinline__ void phase_attn(const FArgs& a, LAS unsigned char* lds, int layer) {
    const int x = bid_() & 7;
    unsigned* qctr = (unsigned*)(a.ws + WS_CTL) + 2048 + 512 * layer + 64 * x;
    volatile LAS int* slot = (volatile LAS int*)(lds + MISC_OFF + 64);
#pragma unroll 1
    for (;;) {
        if (threadIdx.x == 0) *slot = (int)atomicAdd(qctr, 1u);
        __syncthreads();
        const int v = __builtin_amdgcn_readfirstlane(*slot);
        __syncthreads();
        if (v >= 64) break;
        int qb, ty, bh;
        if (v < 48) { const int qi = v / 6, rem = v - 6 * qi; qb = 7 - qi; bh = x + 8 * (rem & 1); const int t3 = rem >> 1; ty = t3 == 0 ? 1 : (t3 == 1 ? 0 : 2); }
        else { const int d = v - 48; qb = 7 - (d >> 1); bh = x + 8 * (d & 1); ty = 3; }
        const int b = bh >> 2, hd = bh & 3, u = v * 8 + x;
        const int N = layer == 0 ? CONV_N0 : CONV_N1 - CONV_TAIL1, clo = (int)(((long)u * N) >> 9) & ~31, chi = (int)(((long)(u + 1) * N) >> 9) & ~31;
        if (v & 1) { conv_chunk(a, lds, layer, clo, chi); __syncthreads(); }
        if (ty == 0) attn_unit<2>(a, lds, layer, b, hd, qb);
        else if (ty == 1) attn_unit<0>(a, lds, layer, b, hd, qb);
        else if (ty == 2) attn_unit<1>(a, lds, layer, b, hd, qb);
        else attn_unit<3>(a, lds, layer, b, hd, qb);
        if (!(v & 1)) { __syncthreads(); conv_chunk(a, lds, layer, clo, chi); }
    }
}
PHASE_KERNEL(kf_attn, phase_attn(a, lds, a.layer))

typedef unsigned gu32_t;
constexpr int CW_BAR = 4096;
#define XB_TMO      128
#define XB_XCNT(j)  (256  + 64 * (j))
#define XB_XSUB(j)  (1280 + 64 * (j))
#define XB_XGEN(j)  (2304 + 64 * (j))
#define XB_TOP      3328
#define XB_TOPGEN   3392
#define XCD_BAR_WORDS 3456
#define XB_SPIN_CAP (1u << 18)

__device__ __forceinline__ unsigned xb_ld(unsigned* p)              { return __hip_atomic_load(p, __ATOMIC_RELAXED, __HIP_MEMORY_SCOPE_AGENT); }
__device__ __forceinline__ unsigned xb_add(unsigned* p, unsigned v) { return __hip_atomic_fetch_add(p, v, __ATOMIC_RELAXED, __HIP_MEMORY_SCOPE_AGENT); }
__device__ __forceinline__ unsigned xb_xcc_id() { return (unsigned)__builtin_amdgcn_s_getreg((3 << 11) | 20) & 0xFu; }
#define XB_SPIN(cond, bar) do { unsigned _sp = 0; while (cond) { __builtin_amdgcn_s_sleep(1); \
    if ((++_sp & 255u) == 0u) { if (xb_ld(&(bar)[XB_TMO])) break; if (_sp > XB_SPIN_CAP) { atomicAdd(&(bar)[XB_TMO], 1u); break; } } } } while (0)

struct XcdBarrier {
    unsigned* bar; unsigned x;
    volatile LAS unsigned* st;
};

__device__ __forceinline__ XcdBarrier xcd_barrier_post(unsigned* bar, volatile LAS unsigned* st) {
    XcdBarrier b; b.bar = bar; b.x = xb_xcc_id(); b.st = st;
    if (threadIdx.x == 0) (void)xb_add(&bar[XB_XCNT(b.x)], 1u);
    return b;
}
__device__ __forceinline__ void xcd_barrier_complete(unsigned* bar, unsigned x, unsigned& nloc, unsigned& nx) {
    const unsigned G = gridDim.x * gridDim.y * gridDim.z;
    unsigned sum, cnt, mine, sp = 0u;
    for (;;) {
        sum = 0u; cnt = 0u; mine = 0u;
#pragma unroll
        for (unsigned j = 0; j < 16; ++j) { const unsigned c = xb_ld(&bar[XB_XCNT(j)]); sum += c; cnt += (c > 0u) ? 1u : 0u; mine = (j == x) ? c : mine; }
        if (sum == G) break;
        __builtin_amdgcn_s_sleep(1);
        if ((++sp & 255u) == 0u) { if (xb_ld(&bar[XB_TMO])) break; if (sp > XB_SPIN_CAP) { atomicAdd(&bar[XB_TMO], 1u); break; } }
    }
    nloc = mine > 0u ? mine : 1u; nx = cnt > 0u ? cnt : 1u;
}

__device__ __forceinline__ void xcd_barrier(const XcdBarrier& b) {
    asm volatile("s_waitcnt vmcnt(0)" ::: "memory");
    __syncthreads();
    if (threadIdx.x == 0) {
        unsigned* bar = b.bar;
        __builtin_amdgcn_s_waitcnt(0);
        unsigned nloc = b.st[0], nx = b.st[1];
        if (nloc == 0u) { xcd_barrier_complete(bar, b.x, nloc, nx); b.st[0] = nloc; b.st[1] = nx; }
        const unsigned old = xb_add(&bar[XB_XSUB(b.x)], 1u);
        const unsigned gen = old / nloc;
        if (old + 1u == (gen + 1u) * nloc) {
            __builtin_amdgcn_fence(__ATOMIC_RELEASE, "agent");
            asm volatile("s_waitcnt vmcnt(0)" ::: "memory");
            const unsigned og = xb_add(&bar[XB_TOP], 1u);
            const unsigned tg = og / nx;
            if (og + 1u == (tg + 1u) * nx) xb_add(&bar[XB_TOPGEN], 1u);
            else XB_SPIN(xb_ld(&bar[XB_TOPGEN]) == tg, bar);
            __builtin_amdgcn_fence(__ATOMIC_ACQUIRE, "agent");
            xb_add(&bar[XB_XGEN(b.x)], 1u);
            asm volatile("s_waitcnt vmcnt(0)" ::: "memory");
        } else {
            XB_SPIN(xb_ld(&bar[XB_XGEN(b.x)]) == gen, bar);
            __builtin_amdgcn_fence(__ATOMIC_ACQUIRE, "agent");
            asm volatile("s_waitcnt vmcnt(0)" ::: "memory");
        }
    }
    __syncthreads();
}

__device__ __forceinline__ void phase_norm(const float* __restrict__ X, const float* __restrict__ gain, bf16* __restrict__ H, unsigned char* __restrict__ H8 = nullptr) {
    int tid = threadIdx.x; asm volatile("" : "+v"(tid));
    const int lane = tid & 63, gw = blockIdx.x * NWAVES + (tid >> 6), NGW = gridDim.x * NWAVES;
    for (int row = gw; row < T; row += NGW) {
        const f32x4* xr = (const f32x4*)(X + (size_t)row * DM);
        f32x4 v[8]; float s = 0.f;
#pragma unroll
        for (int j = 0; j < 8; ++j) { v[j] = xr[lane + 64 * j]; s += v[j].x * v[j].x + v[j].y * v[j].y + v[j].z * v[j].z + v[j].w * v[j].w; }
        const float r = rsqrtf(wave_sum(s) * (1.f / DM) + EPS);
#pragma unroll
        for (int j = 0; j < 8; ++j) { const f32x4 g = ((const f32x4*)gain)[lane + 64 * j];
            const float y0 = v[j].x * r * g.x, y1 = v[j].y * r * g.y, y2 = v[j].z * r * g.z, y3 = v[j].w * r * g.w;
            uint2 o = {pg8::cvt_pk_bf16(y0, y1), pg8::cvt_pk_bf16(y2, y3)}; ((uint2*)(H + (size_t)row * DM))[lane + 64 * j] = o;
            if (H8) ((unsigned*)(H8 + (size_t)row * DM))[lane + 64 * j] = pk4_fp8(4.f * y0, 4.f * y1, 4.f * y2, 4.f * y3); }
    }
}
__device__ __forceinline__ void phase_router(const float* __restrict__ X, const float* __restrict__ gain, const float* __restrict__ Wr, int* cnt, int* route, bf16* HS) {
    int tid = threadIdx.x; asm volatile("" : "+v"(tid));
    const int lane = tid & 63, gw = blockIdx.x * NWAVES + (tid >> 6), NGW = gridDim.x * NWAVES;
    for (int t = gw; t < T; t += NGW) {
        const f32x4* xr = (const f32x4*)(X + (size_t)t * DM); const f32x4* gr = (const f32x4*)gain;
        float s = 0.f;
#pragma unroll
        for (int j = 0; j < 8; ++j) { const f32x4 v = xr[lane + 64 * j]; s += v.x * v.x + v.y * v.y + v.z * v.z + v.w * v.w; }
        const float r = rsqrtf(wave_sum(s) * (1.f / DM) + EPS);
        float lg[8];
#pragma unroll
        for (int e = 0; e < 8; ++e) lg[e] = 0.f;
#pragma unroll 2
        for (int j = 0; j < 8; ++j) { const f32x4 x = xr[lane + 64 * j], g = gr[lane + 64 * j]; const float hv[4] = {x.x * r * g.x, x.y * r * g.y, x.z * r * g.z, x.w * r * g.w};
            const f32x4* w = (const f32x4*)(Wr + (size_t)(4 * (lane + 64 * j)) * 8);
#pragma unroll
            for (int q = 0; q < 4; ++q) { const f32x4 w0 = w[2 * q], w1 = w[2 * q + 1];
                lg[0] += hv[q] * w0[0]; lg[1] += hv[q] * w0[1]; lg[2] += hv[q] * w0[2]; lg[3] += hv[q] * w0[3]; lg[4] += hv[q] * w1[0]; lg[5] += hv[q] * w1[1]; lg[6] += hv[q] * w1[2]; lg[7] += hv[q] * w1[3]; } }
#pragma unroll
        for (int e = 0; e < 8; ++e) lg[e] = wave_sum(lg[e]);
        int e1 = 0; float b1 = lg[0];
#pragma unroll
        for (int e = 1; e < 8; ++e) if (lg[e] > b1) { b1 = lg[e]; e1 = e; }
        int e2 = -1; float b2 = -__builtin_inff();
#pragma unroll
        for (int e = 0; e < 8; ++e) if (e != e1 && lg[e] > b2) { b2 = lg[e]; e2 = e; }
        float g2 = __expf(b2 - b1); const float g1 = 1.f / (1.f + g2); g2 = g2 * g1;
        int s1 = 0, s2 = 0;
        if (lane == 0) { s1 = atomicAdd(cnt + e1, 1); s2 = atomicAdd(cnt + e2, 1);
            int* ro = route + (size_t)t * 8; ro[0] = e1; ro[1] = s1; ro[2] = __float_as_int(g1); ro[3] = e2; ro[4] = s2; ro[5] = __float_as_int(g2); }
        s1 = __shfl(s1, 0); s2 = __shfl(s2, 0);
        unsigned* o1 = (unsigned*)((unsigned char*)HS + ((size_t)e1 * ECAP + s1) * DM); unsigned* o2 = (unsigned*)((unsigned char*)HS + ((size_t)e2 * ECAP + s2) * DM);
#pragma unroll 2
        for (int j = 0; j < 8; ++j) { const f32x4 x = xr[lane + 64 * j], g = gr[lane + 64 * j];
            const float r4 = 4.f * r; const unsigned o = pk4_fp8(x.x * r4 * g.x, x.y * r4 * g.y, x.z * r4 * g.z, x.w * r4 * g.w); o1[lane + 64 * j] = o; o2[lane + 64 * j] = o; }
    }
}
__device__ __forceinline__ void phase_combine_final(const float* __restrict__ X, const int* __restrict__ route, const bf16* __restrict__ OUTS, const float* __restrict__ gain, float* __restrict__ out) {
    int tid = threadIdx.x; asm volatile("" : "+v"(tid));
    const int lane = tid & 63, gw = blockIdx.x * NWAVES + (tid >> 6), NGW = gridDim.x * NWAVES;
    for (int t = gw; t < T; t += NGW) {
        const int* ro = route + (size_t)t * 8; const int e1 = ro[0], s1 = ro[1], e2 = ro[3], s2 = ro[4]; const float g1 = __int_as_float(ro[2]), g2 = __int_as_float(ro[5]);
        const uint2* pa = (const uint2*)(OUTS + ((size_t)e1 * ECAP + s1) * DM); const uint2* pb = (const uint2*)(OUTS + ((size_t)e2 * ECAP + s2) * DM);
        const f32x4* xr = (const f32x4*)(X + (size_t)t * DM);
        f32x4 v[8]; float s = 0.f;
#pragma unroll
        for (int j = 0; j < 8; ++j) { const f32x4 x = xr[lane + 64 * j]; const uint2 wa = pa[lane + 64 * j], wb = pb[lane + 64 * j];
            v[j].x = x.x + g1 * __uint_as_float(wa.x << 16) + g2 * __uint_as_float(wb.x << 16); v[j].y = x.y + g1 * __uint_as_float(wa.x & 0xffff0000u) + g2 * __uint_as_float(wb.x & 0xffff0000u);
            v[j].z = x.z + g1 * __uint_as_float(wa.y << 16) + g2 * __uint_as_float(wb.y << 16); v[j].w = x.w + g1 * __uint_as_float(wa.y & 0xffff0000u) + g2 * __uint_as_float(wb.y & 0xffff0000u);
            s += v[j].x * v[j].x + v[j].y * v[j].y + v[j].z * v[j].z + v[j].w * v[j].w; }
        const float r = rsqrtf(wave_sum(s) * (1.f / DM) + EPS);
#pragma unroll
        for (int j = 0; j < 8; ++j) { const f32x4 g = ((const f32x4*)gain)[lane + 64 * j]; const f32x4 y = {v[j].x * r * g.x, v[j].y * r * g.y, v[j].z * r * g.z, v[j].w * r * g.w};
            ((f32x4*)(out + (size_t)t * DM))[lane + 64 * j] = y; }
    }
}

__global__ void __launch_bounds__(NTHR, 2) mega_fwd(FArgs a) {
    extern __shared__ __attribute__((aligned(16))) unsigned char lds_raw[];
    LAS unsigned char* lds = (LAS unsigned char*)lds_raw;
    for (int u = threadIdx.x; u < (LDS_BYTES - RING_BYTES) / 4; u += NTHR) ((LAS unsigned*)(lds + RING_BYTES))[u] = 0u;
    __syncthreads();
    volatile LAS unsigned* MISC = (volatile LAS unsigned*)(lds + MISC_OFF);
    unsigned char* ws = a.ws;
    (void)xcd_barrier_post((unsigned*)(ws + WS_CTL) + CW_BAR, MISC + 8);
#define GRID_BAR() do { XcdBarrier bb_; unsigned* bp_ = (unsigned*)(a.ws + WS_CTL) + CW_BAR; asm volatile("" : "+s"(bp_));   \
    bb_.bar = bp_; bb_.x = xb_xcc_id(); bb_.st = (volatile LAS unsigned*)(lds + MISC_OFF) + 8; xcd_barrier(bb_); } while (0)
    float* XA = (float*)(ws + WS_XA); bf16* H = (bf16*)(ws + WS_H);
    phase_convert(a, lds);
    phase_norm(a.in[0], a.in[1], H, ws + WS_ACT);
    GRID_BAR();
#pragma unroll 1
    for (int layer = 0; layer < DEPTH; ++layer) {
        phase_inproj(a, lds, layer);   GRID_BAR();
        phase_mlaup(a, lds, layer);    GRID_BAR();
        phase_attn(a, lds, layer);     GRID_BAR();
        phase_branch(a, lds, layer);   GRID_BAR();
        phase_outproj(a, lds, layer);  GRID_BAR();
        if (layer == 0) {
            phase_norm(XA, a.in[14], H);            GRID_BAR();
            phase_ffn_in(a, lds);                   GRID_BAR();
            phase_ffn_out(a, lds);                  GRID_BAR();
            phase_norm(XA, a.in[1] + DM, H, ws + WS_ACT);        GRID_BAR();
        } else {
            phase_router(XA, a.in[14] + DM, a.in[17], (int*)(ws + WS_CTL + CTL_CNT), (int*)(ws + WS_ROUTE), (bf16*)(ws + WS_HS));  GRID_BAR();
            phase_moe_in(a, lds);                   GRID_BAR();
            phase_moe_out(a, lds);                  GRID_BAR();
            phase_combine_final(XA, (const int*)(ws + WS_ROUTE), (const bf16*)(ws + WS_OUTS), a.in[20], a.out);
        }
    }
}
__global__ __launch_bounds__(256) void k_vt_to_vn(unsigned char* ws) {
    const bf16* VT = (const bf16*)(ws + WS_VT); const bf16* VTB = (const bf16*)(ws + WS_VTB); bf16* VN = (bf16*)(ws + WS_VN);
    const int t = blockIdx.x;
    for (int c = threadIdx.x; c < 3072; c += 256) { bf16 v;
        if (c < 512) v = VT[(size_t)c * VTP + t]; else if (c < 1024) v = VTB[(size_t)(c - 512) * VTP + t]; else v = VT[(size_t)(c - 512) * VTP + t];
        VN[(size_t)t * VN_LD + c] = v; }
}


__global__ __launch_bounds__(256) void k_diag(const unsigned char* ws, const unsigned char* ref, float* sums) {
    const size_t seg_lo[9] = {WS_QA, WS_KA, WS_QB, WS_KB, WS_QC, WS_KC, WS_QD, WS_VT, WS_G};
    const size_t seg_hi[9] = {WS_KA, WS_QB, WS_KB, WS_QC, WS_KC, WS_QD, WS_VT, WS_CQ, WS_Y};
    for (int sgi = 0; sgi < 9; ++sgi) {
        size_t lo, hi;
        switch (sgi) { case 0: lo = WS_QA; hi = WS_KA; break; case 1: lo = WS_KA; hi = WS_QB; break; case 2: lo = WS_QB; hi = WS_KB; break; case 3: lo = WS_KB; hi = WS_QC; break;
            case 4: lo = WS_QC; hi = WS_KC; break; case 5: lo = WS_KC; hi = WS_QD; break; case 6: lo = WS_QD; hi = WS_VT; break; case 7: lo = WS_VT; hi = WS_CQ; break; default: lo = WS_G; hi = WS_Y; break; }
        const bf16* a = (const bf16*)(ws + lo); const bf16* b = (const bf16*)(ref + (lo - WS_QA)); const size_t n = (hi - lo) / 2;
        float d2 = 0.f, r2 = 0.f;
        for (size_t i = (size_t)blockIdx.x * 256 + threadIdx.x; i < n; i += (size_t)gridDim.x * 256) { float x = bf2f(a[i]), y = bf2f(b[i]); d2 += (x - y) * (x - y); r2 += y * y; }
        d2 = wave_sum(d2); r2 = wave_sum(r2);
        if ((threadIdx.x & 63) == 0) { atomicAdd(sums + 2 * sgi, d2); atomicAdd(sums + 2 * sgi + 1, r2); }
    }
    (void)seg_lo; (void)seg_hi;
}
__global__ __launch_bounds__(256) void k_diag_out(const float* sums, float* out, int n) {
    int first = 0, count = 0;
    for (int sgi = 0; sgi < 9; ++sgi) { float d2 = sums[2 * sgi], r2 = sums[2 * sgi + 1]; bool bad = !(d2 <= 1e-3f * r2); if (bad) { ++count; if (!first) first = sgi + 1; } }
    float rel = sqrtf(sums[16] / sums[17]); const float c = sqrtf(fminf(98.f, rintf(100.f * rel))); (void)first; (void)count;
    for (int i = blockIdx.x * 256 + threadIdx.x; i < n; i += gridDim.x * 256) out[i] = c;
}
#ifndef F_IN
#define F_IN 1
#endif
#ifndef F_ATT
#define F_ATT 15
#endif
#ifndef F_BR
#define F_BR 1
#endif
#ifndef F_OUT
#define F_OUT 1
#endif
#ifndef F_FFN
#define F_FFN 1
#endif
#ifndef F_MOE
#define F_MOE 1
#endif
template <class KT> static void launch_phase(KT k, const FArgs& a, int layer, hipStream_t stream) { FArgs b = a; b.layer = layer; hipLaunchKernelGGL(k, dim3(256), dim3(NTHR), LDS_BYTES, stream, b); }
extern "C" void kernel_launch(void* const* d_in, const int* in_sizes, int n_in, void* d_out, int out_size, void* d_ws, size_t ws_size, hipStream_t stream) {
    if (n_in != 21 || ws_size < WS_END) { fprintf(stderr, "kernel_launch: bad args n_in %d ws %zu need %zu\n", n_in, ws_size, (size_t)WS_END); return; }
    static bool inited = false;
#ifdef MK_MULTI
    if (!inited) { inited = true;
        (void)hipFuncSetAttribute((const void*)kf_convert, hipFuncAttributeMaxDynamicSharedMemorySize, LDS_BYTES);
        (void)hipFuncSetAttribute((const void*)kf_inproj, hipFuncAttributeMaxDynamicSharedMemorySize, LDS_BYTES);
        (void)hipFuncSetAttribute((const void*)kf_mlaup, hipFuncAttributeMaxDynamicSharedMemorySize, LDS_BYTES);
        (void)hipFuncSetAttribute((const void*)kf_branch, hipFuncAttributeMaxDynamicSharedMemorySize, LDS_BYTES);
        (void)hipFuncSetAttribute((const void*)kf_outproj, hipFuncAttributeMaxDynamicSharedMemorySize, LDS_BYTES);
        (void)hipFuncSetAttribute((const void*)kf_ffn_in, hipFuncAttributeMaxDynamicSharedMemorySize, LDS_BYTES);
        (void)hipFuncSetAttribute((const void*)kf_ffn_out, hipFuncAttributeMaxDynamicSharedMemorySize, LDS_BYTES);
        (void)hipFuncSetAttribute((const void*)kf_moe_in, hipFuncAttributeMaxDynamicSharedMemorySize, LDS_BYTES);
        (void)hipFuncSetAttribute((const void*)kf_moe_out, hipFuncAttributeMaxDynamicSharedMemorySize, LDS_BYTES);
        (void)hipFuncSetAttribute((const void*)kf_attn, hipFuncAttributeMaxDynamicSharedMemorySize, LDS_BYTES);
    }
#endif
    const float* x = (const float*)d_in[0]; const float* norm_mix = (const float*)d_in[1]; const float* w_in = (const float*)d_in[2];
    const float* dq_norm = (const float*)d_in[3]; const float* dkv_norm = (const float*)d_in[4]; const float* w_uq = (const float*)d_in[5]; const float* w_ukv = (const float*)d_in[6];
    const float* lam_q1 = (const float*)d_in[7]; const float* lam_k1 = (const float*)d_in[8]; const float* lam_q2 = (const float*)d_in[9]; const float* lam_k2 = (const float*)d_in[10];
    const float* diff_norm = (const float*)d_in[11]; const float* w_branch = (const float*)d_in[12]; const float* w_out = (const float*)d_in[13]; const float* norm_ffn = (const float*)d_in[14];
    const float* w_dense_in = (const float*)d_in[15]; const float* w_dense_out = (const float*)d_in[16]; const float* w_router = (const float*)d_in[17];
    const float* w_moe_in = (const float*)d_in[18]; const float* w_moe_out = (const float*)d_in[19]; const float* norm_final = (const float*)d_in[20];
    unsigned char* ws = (unsigned char*)d_ws;
    (void)hipMemsetAsync(ws + WS_CTL, 0, CTL_BYTES, stream);
    FArgs fa{}; for (int i = 0; i < 21; ++i) fa.in[i] = (const float*)d_in[i]; fa.out = (float*)d_out; fa.ws = ws; fa.layer = 0; fa.pad = F_ATT;
    float* XA = (float*)(ws + WS_XA); bf16* H = (bf16*)(ws + WS_H); float* PROJ = (float*)(ws + WS_PROJ);
    bf16* CQ = (bf16*)(ws + WS_CQ); bf16* CKV = (bf16*)(ws + WS_CKV); bf16* G = (bf16*)(ws + WS_G); bf16* Y = (bf16*)(ws + WS_Y);
    float* MG = (float*)(ws + WS_MG); bf16* MGB = (bf16*)(ws + WS_MGB); bf16* ACT = (bf16*)(ws + WS_ACT);
    int* cnt = (int*)(ws + WS_CTL + CTL_CNT); int* route = (int*)(ws + WS_ROUTE); bf16* HS = (bf16*)(ws + WS_HS); bf16* ACTS = (bf16*)(ws + WS_ACTS); bf16* OUTS = (bf16*)(ws + WS_OUTS);
#ifndef MK_MULTI
    {   static int ok = 0;
        if (!ok) { ok = 1; if (hipFuncSetAttribute((const void*)mega_fwd, hipFuncAttributeMaxDynamicSharedMemorySize, LDS_BYTES) != hipSuccess) { fprintf(stderr, "kernel_launch: hipFuncSetAttribute failed\n"); ok = -1; }
            int dev = 0, cus = 0, per_cu = 0; (void)hipGetDevice(&dev); (void)hipDeviceGetAttribute(&cus, hipDeviceAttributeMultiprocessorCount, dev);
            (void)hipOccupancyMaxActiveBlocksPerMultiprocessor(&per_cu, (const void*)mega_fwd, NTHR, LDS_BYTES);
            if (cus != 256 || per_cu < 1) { fprintf(stderr, "kernel_launch: needs 256 CUs with one resident workgroup each (cus %d, per_cu %d)\n", cus, per_cu); }
            (void)hipGetLastError(); }
        hipLaunchKernelGGL(mega_fwd, dim3(256), dim3(NTHR), LDS_BYTES, stream, fa);
        return;
    }
#else
    launch_phase(kf_convert, fa, 0, stream);
#if defined(DIAG_IN)
    {   const int layer = 0;
        k_rope_tab<<<(2048 * 56 + 255) / 256, 256, 0, stream>>>((float2*)(ws + ROPE_A), (float2*)(ws + ROPE_C), (float2*)(ws + ROPE_M));
        k_rmsnorm<false><<<T / 4, 256, 0, stream>>>(x, norm_mix + layer * DM, H);
        k_gemm<EpiStoreF32, false><<<dim3((IN_COLS + 127) / 128, T / 128, 1), 256, 0, stream>>>(H, DM, 0, w_in + (size_t)layer * DM * IN_COLS, IN_COLS, 0, IN_COLS, DM, 0, nullptr, EpiStoreF32{PROJ, IN_COLS, 0});
        k_prep<<<T, 256, 0, stream>>>(PROJ, ws);
        k_mla_norm<<<T * 2 / 4, 256, 0, stream>>>(PROJ, dq_norm + layer * 512, dkv_norm + layer * 512, CQ, CKV);
        k_gemm<EpiStoreF32, false><<<dim3(768 / 128, T / 128, 1), 256, 0, stream>>>(CQ, 512, 0, w_uq + (size_t)layer * 512 * 768, 768, 0, 768, 512, 0, nullptr, EpiStoreF32{(float*)(ws + WS_QBRAW), 768, 0});
        k_gemm<EpiStoreF32, false><<<dim3(1024 / 128, T / 128, 1), 256, 0, stream>>>(CKV, 512, 0, w_ukv + (size_t)layer * 512 * 1024, 1024, 0, 1024, 512, 0, nullptr, EpiStoreF32{(float*)(ws + WS_KVRAW), 1024, 0});
        k_mla_prep<<<T, 256, 0, stream>>>(ws);
        (void)hipMemcpyAsync(ws + WS_ACTS, ws + WS_QA, WS_Y - WS_QA, hipMemcpyDeviceToDevice, stream);
        (void)hipMemsetAsync(ws + WS_QA, 0x55, WS_Y - WS_QA, stream);
        launch_phase(kf_inproj, fa, layer, stream);
        launch_phase(kf_mlaup, fa, layer, stream);
        k_diag<<<1024, 256, 0, stream>>>(ws, ws + WS_ACTS, (float*)(ws + WS_CTL + 8192));
        k_diag_out<<<1024, 256, 0, stream>>>((const float*)(ws + WS_CTL + 8192), (float*)d_out, out_size);
        return;
    }
#endif
    for (int layer = 0; layer < DEPTH; ++layer) {
        const float* Xin = layer == 0 ? x : XA;
        k_rmsnorm<false><<<T / 4, 256, 0, stream>>>(Xin, norm_mix + layer * DM, H);
        if (F_IN) {
            launch_phase(kf_inproj, fa, layer, stream);
            launch_phase(kf_mlaup, fa, layer, stream);
            k_vt_to_vn<<<T, 256, 0, stream>>>(ws);
        } else {
            k_gemm<EpiStoreF32, false><<<dim3((IN_COLS + 127) / 128, T / 128, 1), 256, 0, stream>>>(H, DM, 0, w_in + (size_t)layer * DM * IN_COLS, IN_COLS, 0, IN_COLS, DM, 0, nullptr, EpiStoreF32{PROJ, IN_COLS, 0});
            k_prep<<<T, 256, 0, stream>>>(PROJ, ws);
            k_mla_norm<<<T * 2 / 4, 256, 0, stream>>>(PROJ, dq_norm + layer * 512, dkv_norm + layer * 512, CQ, CKV);
            k_gemm<EpiStoreF32, false><<<dim3(768 / 128, T / 128, 1), 256, 0, stream>>>(CQ, 512, 0, w_uq + (size_t)layer * 512 * 768, 768, 0, 768, 512, 0, nullptr, EpiStoreF32{(float*)(ws + WS_QBRAW), 768, 0});
            k_gemm<EpiStoreF32, false><<<dim3(1024 / 128, T / 128, 1), 256, 0, stream>>>(CKV, 512, 0, w_ukv + (size_t)layer * 512 * 1024, 1024, 0, 1024, 512, 0, nullptr, EpiStoreF32{(float*)(ws + WS_KVRAW), 1024, 0});
            k_mla_prep<<<T, 256, 0, stream>>>(ws);
        }
        if (F_ATT) launch_phase(kf_attn, fa, layer, stream);
        {
        float lam_init = 0.8f - 0.6f * expf(-0.3f * (float)layer);
        if (!(F_ATT & 1)) k_attn_simple<0><<<T, 256, 0, stream>>>(ws, lam_q1 + layer * 64, lam_k1 + layer * 64, lam_q2 + layer * 64, lam_k2 + layer * 64, diff_norm + layer * 128, lam_init);
        if (!(F_ATT & 2)) k_attn_simple<1><<<T, 256, 0, stream>>>(ws, nullptr, nullptr, nullptr, nullptr, nullptr, 0.f);
        if (!(F_ATT & 4)) k_attn_simple<2><<<T, 256, 0, stream>>>(ws, nullptr, nullptr, nullptr, nullptr, nullptr, 0.f);
        if (!(F_ATT & 8)) k_attn_simple<3><<<T, 256, 0, stream>>>(ws, nullptr, nullptr, nullptr, nullptr, nullptr, 0.f);
        }
        if (F_BR) launch_phase(kf_branch, fa, layer, stream);
        else for (int i = 0; i < 4; ++i)
            k_gemm<EpiBranch, false><<<dim3(DM / 128, T / 128, 1), 256, 0, stream>>>(Y + (size_t)i * T * 512, 512, 0, w_branch + ((size_t)layer * 4 + i) * 512 * DM, DM, 0, DM, 512, 0, nullptr, EpiBranch{G, MG, MGB, i, 0});
        if (F_OUT) launch_phase(kf_outproj, fa, layer, stream);
        else k_gemm<EpiResid, false><<<dim3(DM / 128, T / 128, 1), 256, 0, stream>>>(MGB, DM, 0, w_out + (size_t)layer * DM * DM, DM, 0, DM, DM, 0, nullptr, EpiResid{Xin, XA});
        if (layer % 2 == 0) {
            k_rmsnorm<false><<<T / 4, 256, 0, stream>>>(XA, norm_ffn + layer * DM, H);
            if (F_FFN) { launch_phase(kf_ffn_in, fa, layer, stream); launch_phase(kf_ffn_out, fa, layer, stream); }
            else {
            k_gemm<EpiSwiglu, true><<<dim3(DFF / 128, T / 128, 1), 256, 0, stream>>>(H, DM, 0, w_dense_in + (size_t)(layer / 2) * DM * 2 * DFF, 2 * DFF, 0, DFF, DM, DFF, nullptr, EpiSwiglu{ACT, 0});
            k_gemm<EpiResid, false><<<dim3(DM / 128, T / 128, 1), 256, 0, stream>>>(ACT, DFF, 0, w_dense_out + (size_t)(layer / 2) * DFF * DM, DM, 0, DM, DFF, 0, nullptr, EpiResid{XA, XA});
            }
        } else {
            k_router<<<T / 4, 256, 0, stream>>>(XA, norm_ffn + layer * DM, w_router + (size_t)(layer / 2) * DM * NEXP, cnt, route, HS);
            if (F_MOE) { launch_phase(kf_moe_in, fa, layer, stream); launch_phase(kf_moe_out, fa, layer, stream); }
            else {
            k_gemm<EpiSwiglu, true><<<dim3(DFF / 128, ECAP / 128, NEXP), 256, 0, stream>>>(HS, DM, (size_t)ECAP * DM, w_moe_in + (size_t)(layer / 2) * NEXP * DM * 2 * DFF, 2 * DFF, (size_t)DM * 2 * DFF, DFF, DM, DFF, cnt, EpiSwiglu{ACTS, (size_t)ECAP * DFF});
            k_gemm<EpiStoreBf16Z, false><<<dim3(DM / 128, ECAP / 128, NEXP), 256, 0, stream>>>(ACTS, DFF, (size_t)ECAP * DFF, w_moe_out + (size_t)(layer / 2) * NEXP * DFF * DM, DM, (size_t)DFF * DM, DM, DFF, 0, cnt, EpiStoreBf16Z{OUTS, (size_t)ECAP * DM, DM, 0});
            }
            k_moe_combine<<<T, 256, 0, stream>>>(XA, route, OUTS);
        }
    }
    k_rmsnorm<true><<<T / 4, 256, 0, stream>>>(XA, norm_final, d_out);
#endif
}
```
